# Optimizing an MI355X kernel written in HIP

```python
import jax, jax.numpy as jnp
from jax import lax
import numpy as np

D_MODEL = 2048
BATCH = 8
SEQ = 4096
DEPTH = 2

N_EVEN = (DEPTH + 1) // 2
N_ODD = DEPTH // 2
RMS_EPS = 1e-6
NEG_BIG = -1e30

MLSTM_WIDTH = D_MODEL // 2
MLSTM_HEADS = 4
MLSTM_DV = MLSTM_WIDTH // MLSTM_HEADS
MLSTM_DK = MLSTM_DV // 2
MLSTM_CHUNK = 64
F_BIAS_INIT = 3.0

RNN_WIDTH = D_MODEL // 2
RNN_BLOCKS = 8
RNN_BLOCK = RNN_WIDTH // RNN_BLOCKS
CONV_WIDTH = 4
CONV_LEFT = 2
RGLRU_C = 8.0

IN_SIZES = (MLSTM_HEADS * MLSTM_DK,
            MLSTM_HEADS * MLSTM_DK,
            MLSTM_WIDTH,
            MLSTM_WIDTH,
            4 * MLSTM_HEADS,
            RNN_WIDTH,
            RNN_WIDTH)
IN_SPLITS = tuple(sum(IN_SIZES[:i + 1]) for i in range(len(IN_SIZES) - 1))
D_IN = sum(IN_SIZES)

ATTN_HEADS = 16
ATTN_DH = D_MODEL // ATTN_HEADS
DILATED_PATTERNS = ((128, 1), (512, 4), (2048, 16))
ATTN_BLOCK = 64
ALIBI_MAX_BIAS = 8.0

D_FF = ((8 * D_MODEL + 3 * 256 - 1) // (3 * 256)) * 256

kernel_name = 'hybrid_mlstm_rglru_dilated_encoder'


def rmsnorm(x, g):
    xf = x.astype(jnp.float32)
    y = xf * lax.rsqrt(jnp.mean(jnp.square(xf), axis=-1, keepdims=True) + RMS_EPS)
    return (y * g.astype(jnp.float32)).astype(x.dtype)


def mlstm_chunkwise(q, k, v, log_i, log_f):
    B, H, S, dk = q.shape
    dv = v.shape[-1]
    L = MLSTM_CHUNK
    nc = S // L

    def to_chunks(a):
        return jnp.moveaxis(a.reshape(a.shape[:2] + (nc, L) + a.shape[3:]), 2, 0)

    xs = tuple(to_chunks(a) for a in (q, k, v, log_i, log_f))
    lower = jnp.tril(jnp.ones((L, L), dtype=bool))

    def step(carry, chunk):
        C, n, m = carry
        qj, kj, vj, ij, fj = chunk
        b = jnp.cumsum(fj, axis=-1)
        D = b[..., :, None] - b[..., None, :] + ij[..., None, :]
        D = jnp.where(lower, D, NEG_BIG)
        inter = b + m[..., None]
        m_out = jnp.maximum(inter, jnp.max(D, axis=-1))
        w_intra = jnp.exp(D - m_out[..., None])
        w_inter = jnp.exp(inter - m_out)
        s = jnp.einsum('bhld,bhsd->bhls', qj, kj) * w_intra
        num = (jnp.einsum('bhls,bhsv->bhlv', s, vj)
               + w_inter[..., None] * jnp.einsum('bhvd,bhld->bhlv', C, qj))
        den = jnp.sum(s, axis=-1) + w_inter * jnp.einsum('bhd,bhld->bhl', n, qj)
        h = num / jnp.maximum(jnp.abs(den), jnp.exp(-m_out))[..., None]
        bL = b[..., -1]
        src = bL[..., None] - b + ij
        m_new = jnp.maximum(bL + m, jnp.max(src, axis=-1))
        w_src = jnp.exp(src - m_new[..., None])
        decay = jnp.exp(bL + m - m_new)
        C_new = decay[..., None, None] * C + jnp.einsum('bhl,bhlv,bhld->bhvd', w_src, vj, kj)
        n_new = decay[..., None] * n + jnp.einsum('bhl,bhld->bhd', w_src, kj)
        return (C_new, n_new, m_new), h

    init = (jnp.zeros((B, H, dv, dk), jnp.float32),
            jnp.zeros((B, H, dk), jnp.float32),
            jnp.full((B, H), NEG_BIG, jnp.float32))
    _, hc = lax.scan(step, init, xs)
    return jnp.moveaxis(hc, 0, 2).reshape(B, H, S, dv)


def bidirectional_mlstm(q, k, v, gates):
    g = jnp.transpose(gates, (2, 0, 3, 1))
    fwd = mlstm_chunkwise(q, k, v, g[0], jax.nn.log_sigmoid(g[1]))
    flip = lambda a: jnp.flip(a, axis=2)
    bwd = flip(mlstm_chunkwise(flip(q), flip(k), flip(v), flip(g[2]),
                               flip(jax.nn.log_sigmoid(g[3]))))
    return fwd + bwd


def centred_depthwise_conv(x, w, b):
    S = x.shape[1]
    xp = jnp.pad(x, ((0, 0), (CONV_LEFT, CONV_WIDTH - 1 - CONV_LEFT), (0, 0)))
    return sum(xp[:, j:j + S, :] * w[j] for j in range(CONV_WIDTH)) + b


def rglru_scan(x, w_a, b_a, w_x, b_x, lam, reverse):
    B, S, _ = x.shape
    xf = x.astype(jnp.float32)
    xb = xf.reshape(B, S, RNN_BLOCKS, RNN_BLOCK)
    pre_a = jnp.einsum('bsni,nij->bsnj', xb, w_a.astype(jnp.float32)).reshape(B, S, RNN_WIDTH)
    pre_x = jnp.einsum('bsni,nij->bsnj', xb, w_x.astype(jnp.float32)).reshape(B, S, RNN_WIDTH)
    r = jax.nn.sigmoid(pre_a + b_a.astype(jnp.float32))
    i = jax.nn.sigmoid(pre_x + b_x.astype(jnp.float32))
    log_a = -RGLRU_C * r * jax.nn.softplus(-lam.astype(jnp.float32))
    a = jnp.exp(log_a)
    u = jnp.sqrt(-jnp.expm1(2.0 * log_a)) * (i * xf)

    def combine(left, right):
        a_l, u_l = left
        a_r, u_r = right
        return a_l * a_r, a_r * u_l + u_r

    _, h = lax.associative_scan(combine, (a, u), axis=1, reverse=reverse)
    return h


def even_mixer(h, w_in, gate_b, conv_w, conv_b, rg_wa, rg_ba, rg_wx, rg_bx, rg_lam,
               head_g, w_out):
    B, S, _ = h.shape
    z = h @ w_in
    q, k, v, o, g, xr, gr = jnp.split(z, IN_SPLITS, axis=-1)
    heads = lambda a, d: jnp.transpose(a.reshape(B, S, MLSTM_HEADS, d), (0, 2, 1, 3)).astype(jnp.float32)
    qh = heads(q, MLSTM_DK) * (MLSTM_DK ** -0.5)
    kh = heads(k, MLSTM_DK)
    vh = heads(v, MLSTM_DV)
    gates = (g.astype(jnp.float32) + gate_b.astype(jnp.float32)).reshape(B, S, 4, MLSTM_HEADS)
    hm = bidirectional_mlstm(qh, kh, vh, gates)
    hm = hm * lax.rsqrt(jnp.mean(jnp.square(hm), axis=-1, keepdims=True) + RMS_EPS)
    hm = jnp.transpose(hm, (0, 2, 1, 3)).reshape(B, S, MLSTM_WIDTH) * head_g.astype(jnp.float32)
    y_a = hm * jax.nn.sigmoid(o.astype(jnp.float32))
    xc = centred_depthwise_conv(xr, conv_w, conv_b)
    hr = (rglru_scan(xc, rg_wa[0], rg_ba[0], rg_wx[0], rg_bx[0], rg_lam[0], False)
          + rglru_scan(xc, rg_wa[1], rg_ba[1], rg_wx[1], rg_bx[1], rg_lam[1], True))
    y_b = hr * jax.nn.gelu(gr.astype(jnp.float32))
    y = jnp.concatenate([y_a, y_b], axis=-1).astype(h.dtype)
    return y @ w_out


def dilated_branch(q, k, v, dil, half, slopes):
    B, S, H, dh = q.shape
    sp = S // dil
    nb = -(-sp // ATTN_BLOCK)
    sq = nb * ATTN_BLOCK
    kw = ATTN_BLOCK + 2 * half

    def by_residue(a):
        return jnp.transpose(a.reshape(B, sp, dil, H, dh), (0, 2, 3, 1, 4))

    qr = jnp.pad(by_residue(q), ((0, 0), (0, 0), (0, 0), (0, sq - sp), (0, 0)))
    kv_pad = ((0, 0), (0, 0), (0, 0), (half, half + sq - sp), (0, 0))
    kr = jnp.pad(by_residue(k), kv_pad)
    vr = jnp.pad(by_residue(v), kv_pad)
    idx = jnp.arange(nb)[:, None] * ATTN_BLOCK + jnp.arange(kw)[None, :]
    kb = kr[:, :, :, idx, :]
    vb = vr[:, :, :, idx, :]
    qb = qr.reshape(B, dil, H, nb, ATTN_BLOCK, dh)
    qpos = jnp.arange(sq).reshape(nb, ATTN_BLOCK)
    kpos = idx - half
    rel = kpos[:, None, :] - qpos[:, :, None]
    valid = (jnp.abs(rel) <= half) & (kpos[:, None, :] >= 0) & (kpos[:, None, :] < sp)
    penalty = slopes[:, None, None, None] * (jnp.abs(rel) * dil).astype(jnp.float32)
    s = jnp.einsum('bdhnqc,bdhnkc->bdhnqk', qb.astype(jnp.float32), kb.astype(jnp.float32)) - penalty
    s = jnp.where(valid, s, NEG_BIG)
    m = jnp.max(s, axis=-1, keepdims=True)
    p = jnp.exp(s - m)
    denom = jnp.sum(p, axis=-1)
    o = jnp.einsum('bdhnqk,bdhnkc->bdhnqc', p, vb.astype(jnp.float32)) / denom[..., None]
    lse = m[..., 0] + jnp.log(denom)
    o = o.reshape(B, dil, H, sq, dh)[:, :, :, :sp]
    lse = lse.reshape(B, dil, H, sq)[:, :, :, :sp]
    o = jnp.transpose(o, (0, 3, 1, 2, 4)).reshape(B, S, H, dh)
    lse = jnp.transpose(lse, (0, 3, 1, 2)).reshape(B, S, H)
    return o, lse


def dilated_attention(h, w_qkv, w_o):
    B, S, _ = h.shape
    qkv = (h @ w_qkv).reshape(B, S, 3, ATTN_HEADS, ATTN_DH)
    q = qkv[:, :, 0] * (ATTN_DH ** -0.5)
    k = qkv[:, :, 1]
    v = qkv[:, :, 2]
    slopes = jnp.exp2(-ALIBI_MAX_BIAS * jnp.arange(1, ATTN_HEADS + 1, dtype=jnp.float32) / ATTN_HEADS)
    outs, lses = [], []
    for window, dil in DILATED_PATTERNS:
        o_g, lse_g = dilated_branch(q, k, v, dil, window // (2 * dil), slopes)
        outs.append(o_g)
        lses.append(lse_g)
    wts = jax.nn.softmax(jnp.stack(lses, axis=0), axis=0)
    o = jnp.sum(wts[..., None] * jnp.stack(outs, axis=0), axis=0)
    return o.reshape(B, S, D_MODEL).astype(h.dtype) @ w_o


def swiglu(h, w1, w3, w2):
    return (jax.nn.silu(h @ w1) * (h @ w3)) @ w2


def setup_inputs(seed: int = 0) -> dict:
    key = jax.random.key(seed)
    ks = jax.random.split(key, 24)
    f32 = jnp.float32
    nrm = lambda k, shape, scale: scale * jax.random.normal(k, shape, f32)
    gain = lambda k, shape: 1.0 + nrm(k, shape, 0.02)
    gate_offset = jnp.repeat(jnp.array([0.0, F_BIAS_INIT, 0.0, F_BIAS_INIT], f32), MLSTM_HEADS)
    u = jax.random.uniform(ks[10], (N_EVEN, 2, RNN_WIDTH), f32, minval=0.9, maxval=0.999)
    a0 = u ** (1.0 / RGLRU_C)
    lam = jnp.log(a0) - jnp.log1p(-a0)
    return {
        'x': nrm(ks[0], (BATCH, SEQ, D_MODEL), 1.0),
        'e_norm': gain(ks[1], (N_EVEN, D_MODEL)),
        'e_w_in': nrm(ks[2], (N_EVEN, D_MODEL, D_IN), D_MODEL ** -0.5),
        'e_gate_b': gate_offset + nrm(ks[3], (N_EVEN, 4 * MLSTM_HEADS), 0.5),
        'e_conv_w': nrm(ks[4], (N_EVEN, CONV_WIDTH, RNN_WIDTH), 0.5),
        'e_conv_b': nrm(ks[5], (N_EVEN, RNN_WIDTH), 0.02),
        'e_rg_wa': nrm(ks[6], (N_EVEN, 2, RNN_BLOCKS, RNN_BLOCK, RNN_BLOCK), RNN_BLOCK ** -0.5),
        'e_rg_ba': nrm(ks[7], (N_EVEN, 2, RNN_WIDTH), 0.02),
        'e_rg_wx': nrm(ks[8], (N_EVEN, 2, RNN_BLOCKS, RNN_BLOCK, RNN_BLOCK), RNN_BLOCK ** -0.5),
        'e_rg_bx': nrm(ks[9], (N_EVEN, 2, RNN_WIDTH), 0.02),
        'e_rg_lam': lam,
        'e_head_g': gain(ks[11], (N_EVEN, MLSTM_WIDTH)),
        'e_w_out': nrm(ks[12], (N_EVEN, D_MODEL, D_MODEL), D_MODEL ** -0.5),
        'o_norm': gain(ks[13], (N_ODD, D_MODEL)),
        'o_w_qkv': nrm(ks[14], (N_ODD, D_MODEL, 3 * D_MODEL), D_MODEL ** -0.5),
        'o_w_o': nrm(ks[15], (N_ODD, D_MODEL, D_MODEL), D_MODEL ** -0.5),
        'f_norm': gain(ks[16], (DEPTH, D_MODEL)),
        'f_w1': nrm(ks[17], (DEPTH, D_MODEL, D_FF), D_MODEL ** -0.5),
        'f_w3': nrm(ks[18], (DEPTH, D_MODEL, D_FF), D_MODEL ** -0.5),
        'f_w2': nrm(ks[19], (DEPTH, D_FF, D_MODEL), D_FF ** -0.5),
        'final_norm': gain(ks[20], (D_MODEL,)),
    }


def reference(x, e_norm, e_w_in, e_gate_b, e_conv_w, e_conv_b, e_rg_wa, e_rg_ba, e_rg_wx,
              e_rg_bx, e_rg_lam, e_head_g, e_w_out, o_norm, o_w_qkv, o_w_o, f_norm, f_w1,
              f_w3, f_w2, final_norm):
    for l in range(DEPTH):
        if l % 2 == 0:
            e = l // 2
            h = rmsnorm(x, e_norm[e])
            x = x + even_mixer(h, e_w_in[e], e_gate_b[e], e_conv_w[e], e_conv_b[e], e_rg_wa[e],
                               e_rg_ba[e], e_rg_wx[e], e_rg_bx[e], e_rg_lam[e], e_head_g[e],
                               e_w_out[e]).astype(x.dtype)
        else:
            o = l // 2
            h = rmsnorm(x, o_norm[o])
            x = x + dilated_attention(h, o_w_qkv[o], o_w_o[o]).astype(x.dtype)
        h = rmsnorm(x, f_norm[l])
        x = x + swiglu(h, f_w1[l], f_w3[l], f_w2[l]).astype(x.dtype)
    return rmsnorm(x, final_norm)
```

```cpp
#include <hip/hip_runtime.h>
#include <hip/hip_cooperative_groups.h>
#include <cstdio>
#include <cstring>
namespace cg = cooperative_groups;
namespace pg8 {
#define PG8_LAS __attribute__((address_space(3)))
typedef unsigned short bf16_t;
typedef short bf16x8 __attribute__((ext_vector_type(8)));
typedef float f32x4 __attribute__((ext_vector_type(4)));
typedef unsigned u32x4 __attribute__((ext_vector_type(4)));
constexpr int BM = 256, BK = 64, HALF = 128, HTB = HALF * BK * 2  , STAGE_BYTES = 8 * HTB, NXCD = 8, WGM = 8;

__host__ __device__ __forceinline__ int lds_byte(int r, int c) { const int st = (r >> 4) * 2 + (c >> 5), rr = r & 15, cc = c & 31, ob = rr * 64 + cc * 2; return st * 1024 + (ob ^ (((ob >> 9) & 1) << 5)); }
__host__ __device__ __forceinline__ void stage_rc(int b, int& R, int& C) { const int st = b / 1024, sb = b % 1024, swz = sb ^ (((sb >> 9) & 1) << 5); R = (st >> 1) * 16 + swz / 64; C = (st & 1) * 32 + (swz % 64) / 2; }
__host__ __device__ __forceinline__ int perm32(int rho) { const int n = rho >> 4, i = rho & 15; return 8 * (i >> 2) + 4 * n + (i & 3); }

struct Unit { int pm, pn; };
struct Gemm { const bf16_t* A; const bf16_t* Bt; int M, N, K; };

struct StaticOrder {
    int nM, nN, nwg, G, c;
    __host__ __device__ void init(int M, int N, int G_, int c_) { nM = M / BM; nN = N / BM; nwg = nM * nN; G = G_; c = c_; }
    __host__ __device__ bool next(int i, Unit& u) const {
        const long L = (long)i * G + c; if (L >= nwg) return false;
        int wgid = (int)L; { const int q = nwg / NXCD, r = nwg % NXCD, xcd = wgid % NXCD, off = wgid / NXCD; wgid = (xcd < r ? xcd * (q + 1) : r * (q + 1) + (xcd - r) * q) + off; }
        const int nig = WGM * nN, gid = wgid / nig, fm = gid * WGM, gsz = (nM - fm) < WGM ? (nM - fm) : WGM;
        u.pm = fm + ((wgid % nig) % gsz); u.pn = (wgid % nig) / gsz; return true;
    }
    __device__ __forceinline__ void a_ready(const Unit&) const {}
    __device__ __forceinline__ void done(const Unit&) const {}
};
__device__ __forceinline__ unsigned cvt_pk_bf16(float lo, float hi) { unsigned r; asm volatile("v_cvt_pk_bf16_f32 %0, %1, %2" : "=v"(r) : "v"(lo), "v"(hi)); return r; }
typedef float f32x2 __attribute__((ext_vector_type(2)));
typedef unsigned u32x4 __attribute__((ext_vector_type(4)));
typedef unsigned u32x2 __attribute__((ext_vector_type(2)));
struct EpiStoreBf16 {
    static constexpr bool PERM = true, AFTER_DRAIN = false;
    bf16_t* O; int ldc;
    __device__ __forceinline__ void operator()(const f32x4 (&acc)[2][2][4][2], const Unit& u, int wr, int wc, int fr, int fq) const {
        const int row0 = u.pm * BM + wr * 64 + fr, col0 = u.pn * BM + wc * 32 + 8 * fq;
#pragma unroll
        for (int ai = 0; ai < 2; ++ai)
#pragma unroll
            for (int m = 0; m < 4; ++m) { bf16_t* rowp = O + (size_t)(row0 + ai * HALF + m * 16) * ldc + col0;
#pragma unroll
                for (int bj = 0; bj < 2; ++bj) { const f32x4 v0 = acc[ai][bj][m][0], v1 = acc[ai][bj][m][1];
                    u32x4 w; w.x = cvt_pk_bf16(v0[0], v0[1]); w.y = cvt_pk_bf16(v0[2], v0[3]); w.z = cvt_pk_bf16(v1[0], v1[1]); w.w = cvt_pk_bf16(v1[2], v1[3]);
                    *(u32x4*)(rowp + bj * HALF) = w; } }
    }
};
struct EpiResF32 {
    static constexpr bool PERM = false, AFTER_DRAIN = false;
    float* C; const float* base; int ldc;
    __device__ __forceinline__ void operator()(const f32x4 (&acc)[2][2][4][2], const Unit& u, int wr, int wc, int fr, int fq) const {
        const int row0 = u.pm * BM + wr * 64 + fr, col0 = u.pn * BM + wc * 32 + 4 * fq;
#pragma unroll
        for (int ai = 0; ai < 2; ++ai)
#pragma unroll
            for (int m = 0; m < 4; ++m) { const size_t off = (size_t)(row0 + ai * HALF + m * 16) * ldc + col0;
#pragma unroll
                for (int bj = 0; bj < 2; ++bj)
#pragma unroll
                    for (int n = 0; n < 2; ++n) { const f32x4 bv = *(const f32x4*)(base + off + bj * HALF + n * 16);
                        *(f32x4*)(C + off + bj * HALF + n * 16) = acc[ai][bj][m][n] + bv; } }
    }
};
__device__ __forceinline__ float silu_mul(float a, float b) { return a * __builtin_amdgcn_rcpf(1.0f + __expf(-a)) * b; }
struct EpiSwiGLU {
    static constexpr bool PERM = true, AFTER_DRAIN = false;
    bf16_t* O; int ldc;
    __device__ __forceinline__ void operator()(const f32x4 (&acc)[2][2][4][2], const Unit& u, int wr, int wc, int fr, int fq) const {
        const int row0 = u.pm * BM + wr * 64 + fr, col0 = u.pn * HALF + wc * 32 + 8 * fq;
#pragma unroll
        for (int ai = 0; ai < 2; ++ai)
#pragma unroll
            for (int m = 0; m < 4; ++m) { bf16_t* rowp = O + (size_t)(row0 + ai * HALF + m * 16) * ldc + col0;
                const f32x4 a0 = acc[ai][0][m][0], a1 = acc[ai][0][m][1], b0 = acc[ai][1][m][0], b1 = acc[ai][1][m][1];
                u32x4 w; w.x = cvt_pk_bf16(silu_mul(a0[0], b0[0]), silu_mul(a0[1], b0[1])); w.y = cvt_pk_bf16(silu_mul(a0[2], b0[2]), silu_mul(a0[3], b0[3]));
                w.z = cvt_pk_bf16(silu_mul(a1[0], b1[0]), silu_mul(a1[1], b1[1])); w.w = cvt_pk_bf16(silu_mul(a1[2], b1[2]), silu_mul(a1[3], b1[3]));
                *(u32x4*)rowp = w; }
    }
};
template <class Epi, class Sched, bool STAMP = false>
__device__ __forceinline__ void gemm_phase(PG8_LAS unsigned char* lds, const Gemm g, const Sched& S, const Epi& E, unsigned long long* stamps) {
    int tid_ = threadIdx.x; asm volatile("" : "+v"(tid_)); const int tid = tid_, wid = __builtin_amdgcn_readfirstlane(tid >> 6), lane = tid & 63, wr = wid >> 2, wc = wid & 3, fr = lane & 15, fq = lane >> 4;
    const int K = g.K, nt = K / BK;
    int ts_lo = 0, ts_hi = 0, nts = 0; const unsigned long long rt_entry = STAMP ? (unsigned long long)wall_clock64() : 0ull;
#define PG8_STAMP() do { if (STAMP && wid == 0 && nts < 64) { const unsigned long long _c = (unsigned long long)clock64(); \
        ts_lo = (lane == nts) ? (int)(unsigned)_c : ts_lo; ts_hi = (lane == nts) ? (int)(unsigned)(_c >> 32) : ts_hi; ++nts; } } while (0)
    PG8_STAMP();
    unsigned voffA[2], voffB[2];
#pragma unroll
    for (int i = 0; i < 2; ++i) { int R, C; stage_rc(tid * 16 + i * 8192, R, C); const int Rb = Epi::PERM ? ((R & ~31) + perm32(R & 31)) : R;
        voffA[i] = (unsigned)(R * K + C) * 2u; voffB[i] = (unsigned)(Rb * K + C) * 2u; }
    const size_t kstep = (size_t)(BK * 2);
    const size_t hstep = (size_t)HALF * K * 2;
    const size_t tstep = 2 * hstep;
    const unsigned ldsw = (unsigned)wid * 1024u;
    const int aoff = lds_byte(wr * 64 + fr, fq * 8), boff = lds_byte(wc * 32 + fr, fq * 8);
#define PG8_SA(b, h) (((b) * 2 + (h)) * HTB)
#define PG8_SB(b, h) ((4 + (b) * 2 + (h)) * HTB)
#define PG8_STAGE(bufoff, gbase, voff) do { _Pragma("unroll") for (int _i = 0; _i < 2; ++_i) \
        __builtin_amdgcn_global_load_lds((const unsigned*)((const char*)(gbase) + (voff)[_i]), (PG8_LAS unsigned*)(lds + (bufoff) + ldsw + _i * 8192), 16, 0, 0); } while (0)
#define PG8_LDA(dst, b, h) do { _Pragma("unroll") for (int m = 0; m < 4; ++m) _Pragma("unroll") for (int k = 0; k < 2; ++k) dst[m][k] = *(const PG8_LAS bf16x8*)(lds + PG8_SA(b, h) + aoff + m * 2048 + k * 1024); } while (0)
#define PG8_LDB(dst, b, h) do { _Pragma("unroll") for (int n = 0; n < 2; ++n) _Pragma("unroll") for (int k = 0; k < 2; ++k) dst[n][k] = *(const PG8_LAS bf16x8*)(lds + PG8_SB(b, h) + boff + n * 2048 + k * 1024); } while (0)
#define PG8_MMA(ai, bj, At, Bt) do { __builtin_amdgcn_s_setprio(1); _Pragma("unroll") for (int m = 0; m < 4; ++m) _Pragma("unroll") for (int n = 0; n < 2; ++n) _Pragma("unroll") for (int k = 0; k < 2; ++k) \
        acc[ai][bj][m][n] = __builtin_amdgcn_mfma_f32_16x16x32_bf16(Bt[n][k], At[m][k], acc[ai][bj][m][n], 0, 0, 0); __builtin_amdgcn_s_setprio(0); } while (0)
#define PG8_WAIT_V(n) asm volatile("s_waitcnt vmcnt(" #n ")" ::: "memory")
#define PG8_WAIT_L(n) asm volatile("s_waitcnt lgkmcnt(" #n ")" ::: "memory")
#define PG8_BAR __builtin_amdgcn_s_barrier()
#define PG8_SCHED __builtin_amdgcn_sched_barrier(0)
    Unit cur, nxt; int ui = 0;
    if (!S.next(0, cur)) return;
    f32x4 acc[2][2][4][2];
#pragma unroll
    for (int a = 0; a < 2; ++a)
#pragma unroll
        for (int b = 0; b < 2; ++b)
#pragma unroll
            for (int m = 0; m < 4; ++m)
#pragma unroll
                for (int n = 0; n < 2; ++n) acc[a][b][m][n] = (f32x4){0.f, 0.f, 0.f, 0.f};
    bf16x8 At[4][2], B0[2][2], B1[2][2];
    const char* cA = (const char*)g.A + (size_t)cur.pm * tstep; const char* cB = (const char*)g.Bt + (size_t)cur.pn * tstep;
    S.a_ready(cur);
    PG8_STAGE(PG8_SB(0, 0), cB, voffB); PG8_STAGE(PG8_SA(0, 0), cA, voffA); PG8_STAGE(PG8_SB(0, 1), cB + hstep, voffB); PG8_STAGE(PG8_SA(0, 1), cA + hstep, voffA);
    if (wr == 1) PG8_BAR;
    PG8_WAIT_V(4); PG8_BAR;
    PG8_STAGE(PG8_SB(1, 0), cB + kstep, voffB); PG8_STAGE(PG8_SA(1, 0), cA + kstep, voffA); PG8_STAGE(PG8_SB(1, 1), cB + hstep + kstep, voffB);
    PG8_WAIT_V(6); PG8_BAR;
    PG8_STAMP();
    for (;;) {
        const bool has_next = S.next(ui + 1, nxt);
        const char* nA = has_next ? (const char*)g.A + (size_t)nxt.pm * tstep : cA; const char* nB = has_next ? (const char*)g.Bt + (size_t)nxt.pn * tstep : cB;
        for (int t = 0; t < nt; t += 2) {
            const bool last = (t == nt - 2);
            const char* a1 = cA + (size_t)(t + 1) * kstep;
            const char* a2 = last ? nA : cA + (size_t)(t + 2) * kstep; const char* b2 = last ? nB : cB + (size_t)(t + 2) * kstep;
            const char* a3 = a2 + kstep; const char* b3 = b2 + kstep;
            if (last && has_next) S.a_ready(nxt);
            PG8_LDB(B0, 0, 0); PG8_SCHED; PG8_LDA(At, 0, 0); PG8_STAGE(PG8_SA(1, 1), a1 + hstep, voffA);
            PG8_WAIT_L(8); PG8_BAR; PG8_WAIT_L(0); PG8_MMA(0, 0, At, B0); PG8_BAR; PG8_SCHED;
            PG8_LDB(B1, 0, 1); PG8_STAGE(PG8_SB(0, 0), b2, voffB);
            PG8_BAR; PG8_WAIT_L(0); PG8_MMA(0, 1, At, B1); PG8_BAR;
            PG8_LDA(At, 0, 1); PG8_STAGE(PG8_SA(0, 0), a2, voffA);
            PG8_BAR; PG8_WAIT_L(0); PG8_MMA(1, 0, At, B0); PG8_BAR; PG8_SCHED;
            PG8_STAGE(PG8_SB(0, 1), b2 + hstep, voffB);
            PG8_WAIT_V(6); PG8_BAR; PG8_MMA(1, 1, At, B1); PG8_BAR;
            PG8_LDB(B0, 1, 0); PG8_SCHED; PG8_LDA(At, 1, 0); PG8_STAGE(PG8_SA(0, 1), a2 + hstep, voffA);
            PG8_WAIT_L(8); PG8_BAR; PG8_WAIT_L(0); PG8_MMA(0, 0, At, B0); PG8_BAR; PG8_SCHED;
            PG8_LDB(B1, 1, 1); PG8_STAGE(PG8_SB(1, 0), b3, voffB);
            PG8_BAR; PG8_WAIT_L(0); PG8_MMA(0, 1, At, B1); PG8_BAR;
            PG8_LDA(At, 1, 1); PG8_STAGE(PG8_SA(1, 0), a3, voffA);
            PG8_BAR; PG8_WAIT_L(0); PG8_MMA(1, 0, At, B0); PG8_BAR; PG8_SCHED;
            PG8_STAGE(PG8_SB(1, 1), b3 + hstep, voffB);
            PG8_WAIT_V(6); PG8_BAR; PG8_MMA(1, 1, At, B1); PG8_BAR;
        }
        PG8_STAMP();
        if constexpr (!Epi::AFTER_DRAIN) { E(acc, cur, wr, wc, fr, fq); S.done(cur); }
        PG8_STAMP();
        if (!has_next) break;
#pragma unroll
        for (int a = 0; a < 2; ++a)
#pragma unroll
            for (int b = 0; b < 2; ++b)
#pragma unroll
                for (int m = 0; m < 4; ++m)
#pragma unroll
                    for (int n = 0; n < 2; ++n) acc[a][b][m][n] = (f32x4){0.f, 0.f, 0.f, 0.f};
        cur = nxt; cA = nA; cB = nB; ++ui;
    }
    PG8_WAIT_V(0);
    if (wr == 0) PG8_BAR;
    PG8_BAR;
    if constexpr (Epi::AFTER_DRAIN) { E.fused(acc, cur, wr, wc, fr, fq, lds, wid, lane); S.done(cur); }
    PG8_STAMP();
    if (STAMP && wid == 0) { stamps[lane] = lane < nts ? (((unsigned long long)(unsigned)ts_hi << 32) | (unsigned)ts_lo) : 0ull;
        if (lane == 62) stamps[62] = rt_entry; if (lane == 63) stamps[63] = (unsigned long long)wall_clock64(); }
#undef PG8_STAMP
#undef PG8_SA
#undef PG8_SB
#undef PG8_STAGE
#undef PG8_LDA
#undef PG8_LDB
#undef PG8_MMA
#undef PG8_WAIT_V
#undef PG8_WAIT_L
#undef PG8_BAR
#undef PG8_SCHED
}
}

#define LAS __attribute__((address_space(3)))
typedef unsigned short u16;
typedef short bf16x8 __attribute__((ext_vector_type(8)));
typedef short bf16x4 __attribute__((ext_vector_type(4)));
typedef float f32x4 __attribute__((ext_vector_type(4)));
typedef unsigned u32x4 __attribute__((ext_vector_type(4)));
typedef unsigned u32x2 __attribute__((ext_vector_type(2)));

constexpr int T_ = 32768, S_ = 4096, D_ = 2048, DFF_ = 5632, DIN_ = 5136, ZC_ = 5120, QC_ = 6144;
constexpr int LDS_BYTES = 139264;
constexpr size_t SZ_WIN = (size_t)ZC_ * D_ * 2, SZ_WSQ = (size_t)D_ * D_ * 2, SZ_WQKV = (size_t)QC_ * D_ * 2, SZ_W13 = (size_t)2 * DFF_ * D_ * 2, SZ_W2 = (size_t)D_ * DFF_ * 2;
constexpr size_t OFF_WIN = 0, OFF_WOUT = OFF_WIN + SZ_WIN, OFF_WQKV = OFF_WOUT + SZ_WSQ, OFF_WO = OFF_WQKV + SZ_WQKV, OFF_W13 = OFF_WO + SZ_WSQ, OFF_W2 = OFF_W13 + 2 * SZ_W13,
                 OFF_WRG = OFF_W2 + 2 * SZ_W2, OFF_XN = OFF_WRG + (size_t)64 * 16384 * 2, OFF_BIG = OFF_XN + (size_t)T_ * D_ * 2, OFF_MIX = OFF_BIG + (size_t)T_ * QC_ * 2,
                 OFF_GATES = OFF_MIX + (size_t)T_ * D_ * 4, OFF_RGSUM = OFF_GATES + (size_t)T_ * 16 * 4, OFF_RGCAR = OFF_RGSUM + (size_t)8 * 64 * 2 * 1024 * 8,
                 OFF_LSE = OFF_RGCAR + (size_t)8 * 64 * 2 * 1024 * 4, WS_END = OFF_LSE + (size_t)3 * T_ * 16 * 4;

struct Seg { const float* src; u16* dst; int ld, K, nN32, mode, rowoff, ntiles; };
struct Params {
    const float *x, *e_norm, *e_w_in, *e_gate_b, *e_conv_w, *e_conv_b, *e_rg_wa, *e_rg_ba, *e_rg_wx, *e_rg_bx, *e_rg_lam, *e_head_g, *e_w_out, *o_norm, *o_w_qkv, *o_w_o, *f_norm, *f_w1, *f_w3, *f_w2, *final_norm;
    float* out; unsigned char* ws;
    Seg seg[12]; int nseg, total_tiles;
};


typedef const __attribute__((address_space(4))) Params* PP;
__device__ __forceinline__ PP get_params() { auto k = __builtin_amdgcn_kernarg_segment_ptr(); asm volatile("" : "+s"(k)); return (PP)k; }
__device__ __forceinline__ int l_tid() { int t = threadIdx.x; asm volatile("" : "+v"(t)); return t; }
__device__ __forceinline__ int l_bid() { int t = blockIdx.x; asm volatile("" : "+s"(t)); return t; }
__device__ __forceinline__ int l_nblk() { int t = gridDim.x; asm volatile("" : "+s"(t)); return t; }
__device__ __forceinline__ unsigned pk2(float lo, float hi) { return pg8::cvt_pk_bf16(lo, hi); }
__device__ __forceinline__ float bflo(unsigned w) { return __uint_as_float(w << 16); }
__device__ __forceinline__ float bfhi(unsigned w) { return __uint_as_float(w & 0xffff0000u); }
__device__ __forceinline__ float wave_sum(float v) {
#pragma unroll
    for (int o = 1; o < 64; o <<= 1) v += __shfl_xor(v, o);
    return v;
}
__device__ __forceinline__ bf16x8 cat8(bf16x4 a, bf16x4 b) { return __builtin_shufflevector(a, b, 0, 1, 2, 3, 4, 5, 6, 7); }
__device__ __forceinline__ bf16x4 lds_tr(LAS unsigned char* p) { return __builtin_amdgcn_ds_read_tr16_b64_v4i16((LAS bf16x4*)p); }
__device__ __forceinline__ bf16x8 lds_r8(LAS unsigned char* p) { return *(LAS bf16x8*)p; }
__device__ __forceinline__ bf16x8 as_bf16x8(u32x4 v) { union { u32x4 u; bf16x8 b; } c; c.u = v; return c.b; }
#define MFMA16(a, b, c) __builtin_amdgcn_mfma_f32_16x16x32_bf16((a), (b), (c), 0, 0, 0)
#define LDSWAIT() asm volatile("s_waitcnt lgkmcnt(0)" ::: "memory")
__device__ __forceinline__ float sigmoidf_(float v) { return __builtin_amdgcn_rcpf(1.0f + __expf(-v)); }

__device__ __forceinline__ void transpose_item(const float* src, int ld, u16* dst, int K, int nN32, int mode, int rowoff, int item, LAS float* scr, int lane) {
    const int nb = item % nN32, kb = item / nN32, k0 = 64 * kb, n0 = 32 * nb;
#pragma unroll 8
    for (int i = 0; i < 32; ++i) { const int kk = 2 * i + (lane >> 5); scr[kk * 33 + (lane & 31)] = src[(size_t)(k0 + kk) * ld + n0 + (lane & 31)]; }
    LDSWAIT();
    const int R0 = mode ? (((n0 >> 7) << 8) + (n0 & 127) + rowoff) : (n0 + rowoff);
    const int c = lane & 7;
#pragma unroll
    for (int j = 0; j < 4; ++j) { const int n = (lane >> 3) + 8 * j; const LAS float* s = scr + (8 * c) * 33 + n;
        u32x4 o; o.x = pk2(s[0 * 33], s[1 * 33]); o.y = pk2(s[2 * 33], s[3 * 33]); o.z = pk2(s[4 * 33], s[5 * 33]); o.w = pk2(s[6 * 33], s[7 * 33]);
        *(u32x4*)(dst + (size_t)(R0 + n) * K + k0 + 8 * c) = o; }
    LDSWAIT();
}

__device__ __forceinline__ void phase0(LAS unsigned char* L) { PP p = get_params();
    const int tid = l_tid(), lane = tid & 63, wid = tid >> 6;
    const int gw = l_bid() * 8 + wid, NGW = l_nblk() * 8;
    LAS float* scr = (LAS float*)(L + wid * 8704);
    for (int it = gw; it < p->total_tiles; it += NGW) {
        int r = it, si = 0;
        while (r >= p->seg[si].ntiles) { r -= p->seg[si].ntiles; ++si; }
        transpose_item(p->seg[si].src, p->seg[si].ld, p->seg[si].dst, p->seg[si].K, p->seg[si].nN32, p->seg[si].mode, p->seg[si].rowoff, r, scr, lane);
    }
    for (int it = gw; it < 256; it += NGW) {
        const int mi = it >> 3, sub = it & 7, mat = mi >> 4, dn = mi & 15;
        const float* src = (mat ? p->e_rg_wx : p->e_rg_wa) + (size_t)dn * 16384;
        u16* dst = (u16*)(p->ws + OFF_WRG) + (size_t)((((dn >> 3) * 2 + mat) * 8) + (dn & 7)) * 16384;
        transpose_item(src, 128, dst, 128, 4, 0, 0, sub, scr, lane);
    }
    __syncthreads();
    LAS float* WgT = (LAS float*)L;
    for (int k = tid; k < D_; k += 512) {
        const float* s = p->e_w_in + (size_t)k * DIN_ + 3072;
#pragma unroll
        for (int c = 0; c < 4; ++c) { const f32x4 v = *(const f32x4*)(s + 4 * c);
            WgT[(4 * c + 0) * D_ + k] = v.x; WgT[(4 * c + 1) * D_ + k] = v.y; WgT[(4 * c + 2) * D_ + k] = v.z; WgT[(4 * c + 3) * D_ + k] = v.w; }
    }
    __syncthreads();
    u16* XN = (u16*)(p->ws + OFF_XN);
    float* GT = (float*)(p->ws + OFF_GATES);
    f32x4 gk[8];
#pragma unroll
    for (int i = 0; i < 8; ++i) gk[i] = *(const f32x4*)(p->e_norm + 256 * i + 4 * lane);
    const float gb = p->e_gate_b[(lane >> 1) & 15];
    for (int rp = gw; rp < T_ / 2; rp += NGW) {
        const float* x0 = p->x + (size_t)(2 * rp) * D_; const float* x1 = x0 + D_;
        f32x4 a[8], b[8]; float s0 = 0.f, s1 = 0.f;
#pragma unroll
        for (int i = 0; i < 8; ++i) { a[i] = *(const f32x4*)(x0 + 256 * i + 4 * lane); b[i] = *(const f32x4*)(x1 + 256 * i + 4 * lane);
            s0 += a[i].x * a[i].x + a[i].y * a[i].y + a[i].z * a[i].z + a[i].w * a[i].w; s1 += b[i].x * b[i].x + b[i].y * b[i].y + b[i].z * b[i].z + b[i].w * b[i].w; }
        const float r0 = rsqrtf(wave_sum(s0) * (1.0f / D_) + 1e-6f), r1 = rsqrtf(wave_sum(s1) * (1.0f / D_) + 1e-6f);
        u16* o0 = XN + (size_t)(2 * rp) * D_; u16* o1 = o0 + D_;
#pragma unroll
        for (int i = 0; i < 8; ++i) { a[i] = a[i] * r0 * gk[i]; b[i] = b[i] * r1 * gk[i];
            u32x2 w0, w1; w0.x = pk2(a[i].x, a[i].y); w0.y = pk2(a[i].z, a[i].w); w1.x = pk2(b[i].x, b[i].y); w1.y = pk2(b[i].z, b[i].w);
            *(u32x2*)(o0 + 256 * i + 4 * lane) = w0; *(u32x2*)(o1 + 256 * i + 4 * lane) = w1; }
        float v[32];
#pragma unroll
        for (int j = 0; j < 16; ++j) { float c0 = 0.f, c1 = 0.f;
#pragma unroll
            for (int i = 0; i < 8; ++i) { const f32x4 w = *(LAS f32x4*)(WgT + j * D_ + 256 * i + 4 * lane);
                c0 += a[i].x * w.x + a[i].y * w.y + a[i].z * w.z + a[i].w * w.w; c1 += b[i].x * w.x + b[i].y * w.y + b[i].z * w.z + b[i].w * w.w; }
            v[j] = c0; v[16 + j] = c1; }
#pragma unroll
        for (int j = 0; j < 16; ++j) { const bool hi = lane & 32; const float keep = hi ? v[j + 16] : v[j], send = hi ? v[j] : v[j + 16]; v[j] = keep + __shfl_xor(send, 32); }
#pragma unroll
        for (int j = 0; j < 8; ++j) { const bool hi = lane & 16; const float keep = hi ? v[j + 8] : v[j], send = hi ? v[j] : v[j + 8]; v[j] = keep + __shfl_xor(send, 16); }
#pragma unroll
        for (int j = 0; j < 4; ++j) { const bool hi = lane & 8; const float keep = hi ? v[j + 4] : v[j], send = hi ? v[j] : v[j + 4]; v[j] = keep + __shfl_xor(send, 8); }
#pragma unroll
        for (int j = 0; j < 2; ++j) { const bool hi = lane & 4; const float keep = hi ? v[j + 2] : v[j], send = hi ? v[j] : v[j + 2]; v[j] = keep + __shfl_xor(send, 4); }
        { const bool hi = lane & 2; const float keep = hi ? v[1] : v[0], send = hi ? v[0] : v[1]; v[0] = keep + __shfl_xor(send, 2); }
        v[0] += __shfl_xor(v[0], 1);
        if ((lane & 1) == 0) { const int idx = lane >> 1; GT[(size_t)(2 * rp + (idx >> 4)) * 16 + (idx & 15)] = v[0] + gb; }
    }
}

template <bool TO_F32>
__device__ __forceinline__ void norm_phase(const float* X, const float* g, u16* O, float* OF) {
    const int tid = l_tid(), lane = tid & 63, wid = tid >> 6;
    const int gw = l_bid() * 8 + wid, NGW = l_nblk() * 8;
    f32x4 gk[8];
#pragma unroll
    for (int i = 0; i < 8; ++i) gk[i] = *(const f32x4*)(g + 256 * i + 4 * lane);
    for (int row = gw; row < T_; row += NGW) {
        const float* x0 = X + (size_t)row * D_;
        f32x4 a[8]; float s0 = 0.f;
#pragma unroll
        for (int i = 0; i < 8; ++i) { a[i] = *(const f32x4*)(x0 + 256 * i + 4 * lane); s0 += a[i].x * a[i].x + a[i].y * a[i].y + a[i].z * a[i].z + a[i].w * a[i].w; }
        const float r0 = rsqrtf(wave_sum(s0) * (1.0f / D_) + 1e-6f);
#pragma unroll
        for (int i = 0; i < 8; ++i) { a[i] = a[i] * r0 * gk[i];
            if (TO_F32) *(f32x4*)(OF + (size_t)row * D_ + 256 * i + 4 * lane) = a[i];
            else { u32x2 w0; w0.x = pk2(a[i].x, a[i].y); w0.y = pk2(a[i].z, a[i].w); *(u32x2*)(O + (size_t)row * D_ + 256 * i + 4 * lane) = w0; } }
    }
}

__device__ __forceinline__ float scan_add64(float v, int lane) {
#pragma unroll
    for (int d = 1; d < 64; d <<= 1) { const float t = __shfl_up(v, d); if (lane >= d) v += t; }
    return v;
}
__device__ __forceinline__ float scan_max64(float v, int lane) {
#pragma unroll
    for (int d = 1; d < 64; d <<= 1) { const float t = __shfl_up(v, d); if (lane >= d) v = fmaxf(v, t); }
    return v;
}
struct GateV { float a, g, wsrc, winter, mout, decay, mnext; };
__device__ __forceinline__ GateV gate_math(float gi, float gf, float m_carry, int lane) {
    GateV o;
    const float lf = (gf >= 0.f) ? -log1pf(__expf(-gf)) : (gf - log1pf(__expf(gf)));
    const float b = scan_add64(lf, lane);
    o.a = gi - b;
    const float M = scan_max64(o.a, lane);
    o.g = fmaxf(m_carry, M);
    const float bL = __shfl(b, 63), g63 = __shfl(o.g, 63);
    o.wsrc = __expf(o.a - g63); o.decay = __expf(m_carry - g63); o.winter = __expf(m_carry - o.g); o.mout = b + o.g; o.mnext = bL + g63;
    return o;
}

__device__ __forceinline__ void mlstm_phase(LAS unsigned char* L) { PP p = get_params();
    const int tid = l_tid(), lane = tid & 63, wid = __builtin_amdgcn_readfirstlane(tid >> 6), l15 = lane & 15, quad = lane >> 4;
    const u16* Z = (const u16*)(p->ws + OFF_BIG);
    const float* GT = (const float*)(p->ws + OFF_GATES);
    float* HB = (float*)(p->ws + OFF_MIX);
    constexpr int QS = 0, KS = 17408, VS = 34816, VW = 46080, CB = 57344;
    constexpr float QSCALE = 0.08838834764831845f;
    const int r = tid >> 3, pc = tid & 7;
    const int lt = wid & 3, dvh = wid >> 2, lidx = 16 * lt + l15;
    for (int item = l_bid(); item < 256; item += l_nblk()) {
        const int dvq = item & 3, dir = (item >> 2) & 1, hh = (item >> 3) & 3, b = item >> 5;
        const size_t tok0 = (size_t)b * S_;
        u32x4 nq0, nq1, nk0, nk1, nv; float ngi, ngf;
        {   const int pp = r; const int t = dir ? (S_ - 1 - pp) : pp; const u16* zr = Z + (tok0 + t) * ZC_;
            nq0 = *(const u32x4*)(zr + hh * 128 + 8 * pc); nq1 = *(const u32x4*)(zr + hh * 128 + 64 + 8 * pc);
            nk0 = *(const u32x4*)(zr + 512 + hh * 128 + 8 * pc); nk1 = *(const u32x4*)(zr + 512 + hh * 128 + 64 + 8 * pc);
            nv = *(const u32x4*)(zr + 1024 + hh * 256 + dvq * 64 + 8 * pc);
            const int tl = dir ? (S_ - 1 - lane) : lane; const float* gr = GT + (tok0 + tl) * 16;
            ngi = gr[(2 * dir) * 4 + hh]; ngf = gr[(2 * dir + 1) * 4 + hh]; }
        float m_carry = -1e30f;
        f32x4 Cacc[5];
#pragma unroll
        for (int i = 0; i < 5; ++i) Cacc[i] = (f32x4){0.f, 0.f, 0.f, 0.f};
        for (int i = tid; i < 1360; i += 512) *(LAS u32x4*)(L + CB + i * 16) = (u32x4){0u, 0u, 0u, 0u};
        GateV gv = gate_math(ngi, ngf, m_carry, lane);
#define MLSTM_STAGE() do { \
            *(LAS u32x4*)(L + QS + r * 272 + pc * 16) = nq0; *(LAS u32x4*)(L + QS + r * 272 + 128 + pc * 16) = nq1; \
            *(LAS u32x4*)(L + KS + r * 272 + pc * 16) = nk0; *(LAS u32x4*)(L + KS + r * 272 + 128 + pc * 16) = nk1; \
            *(LAS u32x4*)(L + VS + r * 176 + pc * 16) = nv; \
            const float wr_ = __shfl(gv.wsrc, r); u32x4 sv; \
            sv.x = pk2(bflo(nv.x) * wr_, bfhi(nv.x) * wr_); sv.y = pk2(bflo(nv.y) * wr_, bfhi(nv.y) * wr_); sv.z = pk2(bflo(nv.z) * wr_, bfhi(nv.z) * wr_); sv.w = pk2(bflo(nv.w) * wr_, bfhi(nv.w) * wr_); \
            *(LAS u32x4*)(L + VW + r * 176 + pc * 16) = sv; \
            if (pc < 2) { u32x4 one = (u32x4){pc == 0 ? 0x3F80u : 0u, 0u, 0u, 0u}; u32x4 ws_ = (u32x4){pc == 0 ? (pk2(wr_, 0.f) & 0xffffu) : 0u, 0u, 0u, 0u}; \
                *(LAS u32x4*)(L + VS + r * 176 + 128 + pc * 16) = one; *(LAS u32x4*)(L + VW + r * 176 + 128 + pc * 16) = ws_; } \
        } while (0)
        MLSTM_STAGE();
        for (int c = 0; c < 64; ++c) {
            if (c + 1 < 64) {
                const int pp = 64 * (c + 1) + r; const int t = dir ? (S_ - 1 - pp) : pp; const u16* zr = Z + (tok0 + t) * ZC_;
                nq0 = *(const u32x4*)(zr + hh * 128 + 8 * pc); nq1 = *(const u32x4*)(zr + hh * 128 + 64 + 8 * pc);
                nk0 = *(const u32x4*)(zr + 512 + hh * 128 + 8 * pc); nk1 = *(const u32x4*)(zr + 512 + hh * 128 + 64 + 8 * pc);
                nv = *(const u32x4*)(zr + 1024 + hh * 256 + dvq * 64 + 8 * pc);
                const int pl = 64 * (c + 1) + lane; const int tl = dir ? (S_ - 1 - pl) : pl; const float* gr = GT + (tok0 + tl) * 16;
                ngi = gr[(2 * dir) * 4 + hh]; ngf = gr[(2 * dir + 1) * 4 + hh];
            }
            __syncthreads();
            bf16x8 qf[4];
#pragma unroll
            for (int ks = 0; ks < 4; ++ks) qf[ks] = lds_r8(L + QS + (16 * lt + l15) * 272 + (32 * ks + 8 * quad) * 2);
            f32x4 sacc[4];
#pragma unroll
            for (int st = 0; st < 4; ++st) { sacc[st] = (f32x4){0.f, 0.f, 0.f, 0.f};
                if (st <= lt) {
#pragma unroll
                    for (int ks = 0; ks < 4; ++ks) { const bf16x8 kf = lds_r8(L + KS + (16 * st + l15) * 272 + (32 * ks + 8 * quad) * 2); sacc[st] = MFMA16(kf, qf[ks], sacc[st]); } } }
            const float g_l = __shfl(gv.g, lidx), winter_l = __shfl(gv.winter, lidx), mout_l = __shfl(gv.mout, lidx);
            float pw[4][4];
#pragma unroll
            for (int st = 0; st < 4; ++st)
#pragma unroll
                for (int jj = 0; jj < 4; ++jj) { const int sidx = 16 * st + 4 * quad + jj; const float a_s = __shfl(gv.a, sidx);
                    const float w = (sidx <= lidx) ? __expf(a_s - g_l) * QSCALE : 0.f; pw[st][jj] = sacc[st][jj] * w; }
            bf16x8 pf[2];
#pragma unroll
            for (int i = 0; i < 2; ++i) { u32x4 t; t.x = pk2(pw[2 * i][0], pw[2 * i][1]); t.y = pk2(pw[2 * i][2], pw[2 * i][3]); t.z = pk2(pw[2 * i + 1][0], pw[2 * i + 1][1]); t.w = pk2(pw[2 * i + 1][2], pw[2 * i + 1][3]); pf[i] = as_bf16x8(t); }
            f32x4 nacc[3];
#pragma unroll
            for (int x = 0; x < 3; ++x) { const int dt = (x < 2) ? (2 * dvh + x) : 4; nacc[x] = (f32x4){0.f, 0.f, 0.f, 0.f};
#pragma unroll
                for (int ks = 0; ks < 4; ++ks) { const bf16x8 cf = lds_r8(L + CB + (16 * dt + l15) * 272 + (32 * ks + 8 * quad) * 2); nacc[x] = MFMA16(cf, qf[ks], nacc[x]); }
                nacc[x] = nacc[x] * (winter_l * QSCALE);
#pragma unroll
                for (int i = 0; i < 2; ++i) {
                    const bf16x4 lo = lds_tr(L + VS + (32 * i + 4 * quad + (l15 >> 2)) * 176 + (16 * dt + 4 * (l15 & 3)) * 2);
                    const bf16x4 hi = lds_tr(L + VS + (32 * i + 16 + 4 * quad + (l15 >> 2)) * 176 + (16 * dt + 4 * (l15 & 3)) * 2);
                    nacc[x] = MFMA16(cat8(lo, hi), pf[i], nacc[x]); } }
            const float den = __shfl(nacc[2][0], l15);
            const float inv = 1.0f / fmaxf(fabsf(den), __expf(-mout_l));
            {   const int pp = 64 * c + lidx; const int t = dir ? (S_ - 1 - pp) : pp;
                float* hrow = HB + ((size_t)dir * T_ + tok0 + t) * 1024 + hh * 256 + dvq * 64 + 4 * quad;
#pragma unroll
                for (int x = 0; x < 2; ++x) *(f32x4*)(hrow + 16 * (2 * dvh + x)) = nacc[x] * inv; }
            const float decay = gv.decay;
#pragma unroll
            for (int dt = 0; dt < 5; ++dt) Cacc[dt] = Cacc[dt] * decay;
#pragma unroll
            for (int i = 0; i < 2; ++i) {
                const bf16x4 alo = lds_tr(L + KS + (32 * i + 8 * quad + (l15 >> 2)) * 272 + (16 * wid + 4 * (l15 & 3)) * 2);
                const bf16x4 ahi = lds_tr(L + KS + (32 * i + 8 * quad + 4 + (l15 >> 2)) * 272 + (16 * wid + 4 * (l15 & 3)) * 2);
                const bf16x8 kf = cat8(alo, ahi);
#pragma unroll
                for (int dt = 0; dt < 5; ++dt) {
                    const bf16x4 blo = lds_tr(L + VW + (32 * i + 8 * quad + (l15 >> 2)) * 176 + (16 * dt + 4 * (l15 & 3)) * 2);
                    const bf16x4 bhi = lds_tr(L + VW + (32 * i + 8 * quad + 4 + (l15 >> 2)) * 176 + (16 * dt + 4 * (l15 & 3)) * 2);
                    Cacc[dt] = MFMA16(kf, cat8(blo, bhi), Cacc[dt]); } }
            __syncthreads();
#pragma unroll
            for (int dt = 0; dt < 5; ++dt) { u32x2 w; w.x = pk2(Cacc[dt][0], Cacc[dt][1]); w.y = pk2(Cacc[dt][2], Cacc[dt][3]);
                *(LAS u32x2*)(L + CB + (16 * dt + l15) * 272 + (16 * wid + 4 * quad) * 2) = w; }
            m_carry = gv.mnext;
            if (c + 1 < 64) { gv = gate_math(ngi, ngf, m_carry, lane); MLSTM_STAGE(); }
        }
        __syncthreads();
    }
#undef MLSTM_STAGE
}

__device__ __forceinline__ void mlstm_combine_phase() { PP p = get_params();
    const int tid = l_tid(), lane = tid & 63, wid = tid >> 6;
    const int gw = l_bid() * 8 + wid, NGW = l_nblk() * 8;
    const u16* Z = (const u16*)(p->ws + OFF_BIG);
    const float* HB = (const float*)(p->ws + OFF_MIX);
    u16* Y = (u16*)(p->ws + OFF_XN);
    for (int it = gw; it < T_ * 4; it += NGW) {
        const int t = it >> 2, hh = it & 3;
        const f32x4 f = *(const f32x4*)(HB + (size_t)t * 1024 + hh * 256 + 4 * lane), bw = *(const f32x4*)(HB + ((size_t)T_ + t) * 1024 + hh * 256 + 4 * lane);
        const f32x4 hm = f + bw;
        const float ss = wave_sum(hm.x * hm.x + hm.y * hm.y + hm.z * hm.z + hm.w * hm.w);
        const float rs = rsqrtf(ss * (1.0f / 256.f) + 1e-6f);
        const f32x4 hg = *(const f32x4*)(p->e_head_g + hh * 256 + 4 * lane);
        const u32x2 ob = *(const u32x2*)(Z + (size_t)t * ZC_ + 2048 + hh * 256 + 4 * lane);
        u32x2 w; w.x = pk2(hm.x * rs * hg.x * sigmoidf_(bflo(ob.x)), hm.y * rs * hg.y * sigmoidf_(bfhi(ob.x)));
        w.y = pk2(hm.z * rs * hg.z * sigmoidf_(bflo(ob.y)), hm.w * rs * hg.w * sigmoidf_(bfhi(ob.y)));
        *(u32x2*)(Y + (size_t)t * D_ + hh * 256 + 4 * lane) = w;
    }
}

__device__ __forceinline__ float gelu_tanh(float v) { const float u = 0.7978845608028654f * (v + 0.044715f * v * v * v); const float e = __expf(2.0f * u); return 0.5f * v * (1.0f + (1.0f - 2.0f * __builtin_amdgcn_rcpf(e + 1.0f))); }

template <bool FINAL>
__device__ __forceinline__ void rglru_phase(LAS unsigned char* L) { PP p = get_params();
    const int tid = l_tid(), lane = tid & 63, wid = __builtin_amdgcn_readfirstlane(tid >> 6), l15 = lane & 15, quad = lane >> 4;
    const u16* Z = (const u16*)(p->ws + OFF_BIG);
    const u16* WRG = (const u16*)(p->ws + OFF_WRG);
    float2* SUM = (float2*)(p->ws + OFF_RGSUM);
    const float* CAR = (const float*)(p->ws + OFF_RGCAR);
    u16* Y = (u16*)(p->ws + OFF_XN);
    for (int item = l_bid(); item < 4096; item += l_nblk()) {
        const int tile = item & 63, n = (item >> 6) & 7, b = item >> 9;
        const size_t tok0 = (size_t)b * S_;
        __syncthreads();
        {
            const int cgp = tid & 15, tq = tid >> 4; const int chb = n * 128 + 8 * cgp;
            float cw[4][8], cb[8];
#pragma unroll
            for (int j = 0; j < 4; ++j) { const f32x4 w0 = *(const f32x4*)(p->e_conv_w + j * 1024 + chb), w1 = *(const f32x4*)(p->e_conv_w + j * 1024 + chb + 4);
                cw[j][0] = w0.x; cw[j][1] = w0.y; cw[j][2] = w0.z; cw[j][3] = w0.w; cw[j][4] = w1.x; cw[j][5] = w1.y; cw[j][6] = w1.z; cw[j][7] = w1.w; }
            { const f32x4 w0 = *(const f32x4*)(p->e_conv_b + chb), w1 = *(const f32x4*)(p->e_conv_b + chb + 4);
                cb[0] = w0.x; cb[1] = w0.y; cb[2] = w0.z; cb[3] = w0.w; cb[4] = w1.x; cb[5] = w1.y; cb[6] = w1.z; cb[7] = w1.w; }
#pragma unroll
            for (int half = 0; half < 2; ++half) { const int tl = tq + 32 * half, t = 64 * tile + tl;
                float acc[8];
#pragma unroll
                for (int e = 0; e < 8; ++e) acc[e] = cb[e];
#pragma unroll
                for (int j = 0; j < 4; ++j) { const int pos = t + j - 2;
                    if (pos >= 0 && pos < S_) { const u32x4 v = *(const u32x4*)(Z + (tok0 + pos) * ZC_ + 3072 + chb);
                        acc[0] += bflo(v.x) * cw[j][0]; acc[1] += bfhi(v.x) * cw[j][1]; acc[2] += bflo(v.y) * cw[j][2]; acc[3] += bfhi(v.y) * cw[j][3];
                        acc[4] += bflo(v.z) * cw[j][4]; acc[5] += bfhi(v.z) * cw[j][5]; acc[6] += bflo(v.w) * cw[j][6]; acc[7] += bfhi(v.w) * cw[j][7]; } }
                u32x4 o; o.x = pk2(acc[0], acc[1]); o.y = pk2(acc[2], acc[3]); o.z = pk2(acc[4], acc[5]); o.w = pk2(acc[6], acc[7]);
                *(LAS u32x4*)(L + tl * 272 + cgp * 16) = o; }
        }
        __syncthreads();
        const int ch0 = n * 128 + 16 * wid + 4 * quad;
        float hsum[4][4];
#pragma unroll
        for (int tt = 0; tt < 4; ++tt)
#pragma unroll
            for (int jj = 0; jj < 4; ++jj) hsum[tt][jj] = 0.f;
#pragma unroll
        for (int dir = 0; dir < 2; ++dir) {
            bf16x8 wa[4], wx[4];
            {   const u16* wb = WRG + (size_t)(((dir * 2 + 0) * 8) + n) * 16384 + (16 * wid + l15) * 128 + 8 * quad;
#pragma unroll
                for (int ks = 0; ks < 4; ++ks) { wa[ks] = *(const bf16x8*)(wb + 32 * ks); wx[ks] = *(const bf16x8*)(wb + (size_t)8 * 16384 + 32 * ks); } }
            const f32x4 ba4 = *(const f32x4*)(p->e_rg_ba + dir * 1024 + ch0), bx4 = *(const f32x4*)(p->e_rg_bx + dir * 1024 + ch0), lm4 = *(const f32x4*)(p->e_rg_lam + dir * 1024 + ch0);
            float coef[4];
#pragma unroll
            for (int jj = 0; jj < 4; ++jj) coef[jj] = -8.0f * log1pf(__expf(-lm4[jj]));
            float av[4][4], uv[4][4];
#pragma unroll
            for (int tt = 0; tt < 4; ++tt) {
                f32x4 pa = (f32x4){0.f, 0.f, 0.f, 0.f}, px = (f32x4){0.f, 0.f, 0.f, 0.f};
#pragma unroll
                for (int ks = 0; ks < 4; ++ks) { const bf16x8 xf = lds_r8(L + (16 * tt + l15) * 272 + (32 * ks + 8 * quad) * 2); pa = MFMA16(wa[ks], xf, pa); px = MFMA16(wx[ks], xf, px); }
                const u32x2 xc = *(LAS u32x2*)(L + (16 * tt + l15) * 272 + (16 * wid + 4 * quad) * 2);
                const float xv[4] = {bflo(xc.x), bfhi(xc.x), bflo(xc.y), bfhi(xc.y)};
#pragma unroll
                for (int jj = 0; jj < 4; ++jj) { const float rr = sigmoidf_(pa[jj] + ba4[jj]), ii = sigmoidf_(px[jj] + bx4[jj]); const float la = coef[jj] * rr;
                    av[tt][jj] = __expf(la); uv[tt][jj] = sqrtf(fmaxf(-expm1f(2.0f * la), 0.f)) * ii * xv[jj]; }
            }
            float carry[4], aprod[4];
#pragma unroll
            for (int jj = 0; jj < 4; ++jj) { carry[jj] = FINAL ? CAR[((size_t)((b * 64 + tile) * 2 + dir)) * 1024 + ch0 + jj] : 0.f; aprod[jj] = 1.f; }
#pragma unroll
            for (int k = 0; k < 4; ++k) { const int tt = dir ? (3 - k) : k;
#pragma unroll
                for (int jj = 0; jj < 4; ++jj) { float A = av[tt][jj], U = uv[tt][jj];
#pragma unroll
                    for (int d = 1; d < 16; d <<= 1) {
                        const float Ap = dir ? __shfl_down(A, d, 16) : __shfl_up(A, d, 16), Up = dir ? __shfl_down(U, d, 16) : __shfl_up(U, d, 16);
                        const bool ok = dir ? (l15 + d < 16) : (l15 >= d);
                        if (ok) { U = A * Up + U; A = A * Ap; } }
                    const float h = A * carry[jj] + U;
                    if (FINAL) hsum[tt][jj] += h;
                    carry[jj] = __shfl(h, dir ? 0 : 15, 16);
                    aprod[jj] *= __shfl(A, dir ? 0 : 15, 16); } }
            if (!FINAL && l15 == 0) {
#pragma unroll
                for (int jj = 0; jj < 4; ++jj) SUM[((size_t)((b * 64 + tile) * 2 + dir)) * 1024 + ch0 + jj] = make_float2(aprod[jj], carry[jj]); }
        }
        if (FINAL) {
#pragma unroll
            for (int tt = 0; tt < 4; ++tt) { const int t = 64 * tile + 16 * tt + l15;
                const u32x2 gr = *(const u32x2*)(Z + (tok0 + t) * ZC_ + 4096 + ch0);
                u32x2 w; w.x = pk2(hsum[tt][0] * gelu_tanh(bflo(gr.x)), hsum[tt][1] * gelu_tanh(bfhi(gr.x))); w.y = pk2(hsum[tt][2] * gelu_tanh(bflo(gr.y)), hsum[tt][3] * gelu_tanh(bfhi(gr.y)));
                *(u32x2*)(Y + (tok0 + t) * D_ + 1024 + ch0) = w; }
        }
    }
}

__device__ __forceinline__ void rglru_carry_phase() { PP p = get_params();
    const int tid = l_tid(), lane = tid & 63, wid = tid >> 6;
    const float2* SUM = (const float2*)(p->ws + OFF_RGSUM);
    float* CAR = (float*)(p->ws + OFF_RGCAR);
    if (wid == 0) {
        for (int chain = l_bid() * 64 + lane; chain < 16384; chain += l_nblk() * 64) {
            const int ch = chain & 1023, dir = (chain >> 10) & 1, b = chain >> 11;
            float h = 0.f;
#pragma unroll 8
            for (int k = 0; k < 64; ++k) { const int tile = dir ? (63 - k) : k; const size_t idx = ((size_t)((b * 64 + tile) * 2 + dir)) * 1024 + ch;
                const float2 s = SUM[idx]; CAR[idx] = h; h = s.x * h + s.y; }
        }
    }
}

__device__ __forceinline__ void attn_phase(LAS unsigned char* L) { PP p = get_params();
    const int tid = l_tid(), lane = tid & 63, wid = __builtin_amdgcn_readfirstlane(tid >> 6), l15 = lane & 15, quad = lane >> 4;
    const u16* QKV = (const u16*)(p->ws + OFF_BIG);
    float* LSE = (float*)(p->ws + OFF_LSE);
    constexpr int KS = 0, VS = 69632;
    constexpr float SCALE = 0.08838834764831845f;
    for (int item = l_bid(); item < 12288; item += l_nblk()) {
        const int blk32 = item & 31, g = (item >> 5) % 3, bh = item / 96, head = bh & 15, b = bh >> 4;
        const int lg = 2 * g, dil = 1 << lg, sp = S_ >> lg, r = blk32 & (dil - 1), nb = blk32 >> lg;
        const size_t tok0 = (size_t)b * S_;
        __syncthreads();
        {   const int pc = tid & 15;
#pragma unroll
            for (int it = 0; it < 8; ++it) { const int lr = (tid >> 4) + 32 * it, i = 128 * nb - 64 + lr;
                u32x4 kv = (u32x4){0u, 0u, 0u, 0u}, vv = (u32x4){0u, 0u, 0u, 0u};
                if (i >= 0 && i < sp) { const u16* row = QKV + (tok0 + r + (size_t)i * dil) * QC_ + head * 128 + 8 * pc; kv = *(const u32x4*)(row + 2048); vv = *(const u32x4*)(row + 4096); }
                *(LAS u32x4*)(L + KS + lr * 272 + pc * 16) = kv; *(LAS u32x4*)(L + VS + lr * 272 + pc * 16) = vv; }
        }
        const int qi = 128 * nb + 16 * wid + l15;
        const size_t qrow = tok0 + r + (size_t)qi * dil;
        bf16x8 qf[4];
#pragma unroll
        for (int ks = 0; ks < 4; ++ks) qf[ks] = *(const bf16x8*)(QKV + qrow * QC_ + head * 128 + 32 * ks + 8 * quad);
        __syncthreads();
        f32x4 sacc[9];
#pragma unroll
        for (int kt = 0; kt < 9; ++kt) { sacc[kt] = (f32x4){0.f, 0.f, 0.f, 0.f};
#pragma unroll
            for (int ks = 0; ks < 4; ++ks) { const bf16x8 kf = lds_r8(L + KS + (16 * wid + 16 * kt + l15) * 272 + (32 * ks + 8 * quad) * 2); sacc[kt] = MFMA16(kf, qf[ks], sacc[kt]); } }
        const float pen = exp2f(-0.5f * (float)(head + 1)) * (float)dil;
        float mx = -1e30f;
#pragma unroll
        for (int kt = 0; kt < 9; ++kt)
#pragma unroll
            for (int jj = 0; jj < 4; ++jj) { const int rel = 16 * kt + 4 * quad + jj - 64 - l15, ki = qi + rel; const int arel = rel < 0 ? -rel : rel;
                const bool valid = (arel <= 64) && (ki >= 0) && (ki < sp);
                const float s = valid ? (sacc[kt][jj] * SCALE - pen * (float)arel) : -1e30f; sacc[kt][jj] = s; mx = fmaxf(mx, s); }
        mx = fmaxf(mx, __shfl_xor(mx, 16)); mx = fmaxf(mx, __shfl_xor(mx, 32));
        float lsum = 0.f;
#pragma unroll
        for (int kt = 0; kt < 9; ++kt)
#pragma unroll
            for (int jj = 0; jj < 4; ++jj) { const float pv = __expf(sacc[kt][jj] - mx); sacc[kt][jj] = pv; lsum += pv; }
        lsum += __shfl_xor(lsum, 16); lsum += __shfl_xor(lsum, 32);
        bf16x8 pf[5];
#pragma unroll
        for (int i = 0; i < 5; ++i) { u32x4 t; t.x = pk2(sacc[2 * i][0], sacc[2 * i][1]); t.y = pk2(sacc[2 * i][2], sacc[2 * i][3]);
            if (i < 4) { t.z = pk2(sacc[2 * i + 1][0], sacc[2 * i + 1][1]); t.w = pk2(sacc[2 * i + 1][2], sacc[2 * i + 1][3]); } else { t.z = 0u; t.w = 0u; }
            pf[i] = as_bf16x8(t); }
        f32x4 oacc[8];
#pragma unroll
        for (int dt = 0; dt < 8; ++dt) { oacc[dt] = (f32x4){0.f, 0.f, 0.f, 0.f};
#pragma unroll
            for (int i = 0; i < 5; ++i) {
                const bf16x4 lo = lds_tr(L + VS + (16 * wid + 32 * i + 4 * quad + (l15 >> 2)) * 272 + (16 * dt + 4 * (l15 & 3)) * 2);
                bf16x4 hi = (bf16x4){0, 0, 0, 0};
                if (i < 4) hi = lds_tr(L + VS + (16 * wid + 32 * i + 16 + 4 * quad + (l15 >> 2)) * 272 + (16 * dt + 4 * (l15 & 3)) * 2);
                oacc[dt] = MFMA16(cat8(lo, hi), pf[i], oacc[dt]); } }
        const float inv = 1.0f / lsum;
        u16* OB = (g < 2) ? ((u16*)(p->ws + OFF_MIX) + (size_t)g * T_ * D_) : (u16*)(p->ws + OFF_XN);
        u16* orow = OB + qrow * D_ + head * 128 + 4 * quad;
#pragma unroll
        for (int dt = 0; dt < 8; ++dt) { u32x2 w; w.x = pk2(oacc[dt][0] * inv, oacc[dt][1] * inv); w.y = pk2(oacc[dt][2] * inv, oacc[dt][3] * inv); *(u32x2*)(orow + 16 * dt) = w; }
        if (quad == 0) LSE[((size_t)g * T_ + qrow) * 16 + head] = mx + __logf(lsum);
    }
}

__device__ __forceinline__ void attn_merge_phase() { PP p = get_params();
    const u16* O0 = (const u16*)(p->ws + OFF_MIX); const u16* O1 = O0 + (size_t)T_ * D_; u16* O2 = (u16*)(p->ws + OFF_XN);
    const float* LSE = (const float*)(p->ws + OFF_LSE);
    for (size_t gi = (size_t)l_bid() * 512 + l_tid(); gi < (size_t)T_ * 256; gi += (size_t)l_nblk() * 512) {
        const size_t t = gi >> 8; const int c8 = (int)(gi & 255), head = c8 >> 4;
        const float l0 = LSE[t * 16 + head], l1 = LSE[((size_t)T_ + t) * 16 + head], l2 = LSE[((size_t)2 * T_ + t) * 16 + head];
        const float mx = fmaxf(l0, fmaxf(l1, l2));
        float w0 = __expf(l0 - mx), w1 = __expf(l1 - mx), w2 = __expf(l2 - mx); const float inv = 1.0f / (w0 + w1 + w2); w0 *= inv; w1 *= inv; w2 *= inv;
        const u32x4 a = *(const u32x4*)(O0 + t * D_ + 8 * c8), bq = *(const u32x4*)(O1 + t * D_ + 8 * c8), c = *(const u32x4*)(O2 + t * D_ + 8 * c8);
        u32x4 o;
        o.x = pk2(w0 * bflo(a.x) + w1 * bflo(bq.x) + w2 * bflo(c.x), w0 * bfhi(a.x) + w1 * bfhi(bq.x) + w2 * bfhi(c.x));
        o.y = pk2(w0 * bflo(a.y) + w1 * bflo(bq.y) + w2 * bflo(c.y), w0 * bfhi(a.y) + w1 * bfhi(bq.y) + w2 * bfhi(c.y));
        o.z = pk2(w0 * bflo(a.z) + w1 * bflo(bq.z) + w2 * bflo(c.z), w0 * bfhi(a.z) + w1 * bfhi(bq.z) + w2 * bfhi(c.z));
        o.w = pk2(w0 * bflo(a.w) + w1 * bflo(bq.w) + w2 * bflo(c.w), w0 * bfhi(a.w) + w1 * bfhi(bq.w) + w2 * bfhi(c.w));
        *(u32x4*)(O2 + t * D_ + 8 * c8) = o;
    }
}

template <class Epi>
__device__ __forceinline__ void run_gemm(LAS unsigned char* L, const u16* A, const u16* Bt, int N, int K, const Epi& E) {
    pg8::Gemm g; g.A = A; g.Bt = Bt; g.M = T_; g.N = N; g.K = K;
    pg8::StaticOrder S; S.init(T_, N, l_nblk(), l_bid());
    pg8::gemm_phase<Epi, pg8::StaticOrder, false>(L, g, S, E, nullptr);
}
__device__ __forceinline__ void gemm_zin(LAS unsigned char* L) { PP p = get_params(); unsigned char* ws = p->ws;
    run_gemm(L, (const u16*)(ws + OFF_XN), (const u16*)(ws + OFF_WIN), ZC_, D_, pg8::EpiStoreBf16{(u16*)(ws + OFF_BIG), ZC_}); }
__device__ __forceinline__ void gemm_qkv(LAS unsigned char* L) { PP p = get_params(); unsigned char* ws = p->ws;
    run_gemm(L, (const u16*)(ws + OFF_XN), (const u16*)(ws + OFF_WQKV), QC_, D_, pg8::EpiStoreBf16{(u16*)(ws + OFF_BIG), QC_}); }
__device__ __forceinline__ void gemm_res(LAS unsigned char* L, int which) { PP p = get_params(); unsigned char* ws = p->ws;
    run_gemm(L, (const u16*)(ws + OFF_XN), (const u16*)(ws + (which ? OFF_WO : OFF_WOUT)), D_, D_, pg8::EpiResF32{p->out, which ? (const float*)p->out : p->x, D_}); }
__device__ __forceinline__ void gemm_up(LAS unsigned char* L, int l) { PP p = get_params(); unsigned char* ws = p->ws;
    run_gemm(L, (const u16*)(ws + OFF_XN), (const u16*)(ws + OFF_W13) + (size_t)l * 2 * DFF_ * D_, 2 * DFF_, D_, pg8::EpiSwiGLU{(u16*)(ws + OFF_BIG), DFF_}); }
__device__ __forceinline__ void gemm_down(LAS unsigned char* L, int l) { PP p = get_params(); unsigned char* ws = p->ws;
    run_gemm(L, (const u16*)(ws + OFF_BIG), (const u16*)(ws + OFF_W2) + (size_t)l * D_ * DFF_, D_, DFF_, pg8::EpiResF32{p->out, (const float*)p->out, D_}); }
__device__ __forceinline__ void norm_to_xn(int which) { PP p = get_params();
    const float* g = which == 1 ? p->o_norm : (p->f_norm + (which == 2 ? D_ : 0));
    norm_phase<false>(p->out, g, (u16*)(p->ws + OFF_XN), nullptr); }
__device__ __forceinline__ void norm_final() { PP p = get_params(); norm_phase<true>(p->out, p->final_norm, nullptr, p->out); }

__global__ __launch_bounds__(512, 2) void mega_fwd(Params pdummy) {
    extern __shared__ __attribute__((aligned(16))) unsigned char lds_raw[];
    LAS unsigned char* L = (LAS unsigned char*)lds_raw;
    cg::grid_group grid = cg::this_grid();
    phase0(L);
    grid.sync();
    gemm_zin(L);
    grid.sync();
    mlstm_phase(L);
    rglru_phase<false>(L);
    grid.sync();
    rglru_carry_phase();
    mlstm_combine_phase();
    grid.sync();
    rglru_phase<true>(L);
    grid.sync();
    gemm_res(L, 0);
    grid.sync();
    norm_to_xn(0);
    grid.sync();
    gemm_up(L, 0);
    grid.sync();
    gemm_down(L, 0);
    grid.sync();
    norm_to_xn(1);
    grid.sync();
    gemm_qkv(L);
    grid.sync();
    attn_phase(L);
    grid.sync();
    attn_merge_phase();
    grid.sync();
    gemm_res(L, 1);
    grid.sync();
    norm_to_xn(2);
    grid.sync();
    gemm_up(L, 1);
    grid.sync();
    gemm_down(L, 1);
    grid.sync();
    norm_final();
}

extern "C" void kernel_launch(void* const* d_in, const int* in_sizes, int n_in, void* d_out, int out_size, void* d_ws, size_t ws_size, hipStream_t stream) {
    static int grid_blocks = 0;
    if (!grid_blocks) {
        int dev = 0, cus = 0, per_cu = 0;
        hipGetDevice(&dev);
        hipDeviceGetAttribute(&cus, hipDeviceAttributeMultiprocessorCount, dev);
        hipFuncSetAttribute((const void*)mega_fwd, hipFuncAttributeMaxDynamicSharedMemorySize, LDS_BYTES);
        hipOccupancyMaxActiveBlocksPerMultiprocessor(&per_cu, (const void*)mega_fwd, 512, LDS_BYTES);
        if (per_cu < 1) per_cu = 1;
        grid_blocks = cus * per_cu;
        if (ws_size < WS_END) fprintf(stderr, "workspace too small: %zu < %zu\n", ws_size, (size_t)WS_END);
    }
    Params p; memset(&p, 0, sizeof(p));
    const float** ptrs = (const float**)&p;
    for (int i = 0; i < 21; ++i) ptrs[i] = (const float*)d_in[i];
    p.out = (float*)d_out; p.ws = (unsigned char*)d_ws;
    unsigned char* ws = (unsigned char*)d_ws;
    int ns = 0, tot = 0;
    auto add = [&](const float* src, size_t dst_off, int ld, int K, int N, int mode, int rowoff) {
        Seg& s = p.seg[ns++]; s.src = src; s.dst = (u16*)(ws + dst_off); s.ld = ld; s.K = K; s.nN32 = N / 32; s.mode = mode; s.rowoff = rowoff; s.ntiles = (K / 64) * (N / 32); tot += s.ntiles; };
    add(p.e_w_in, OFF_WIN, DIN_, D_, 3072, 0, 0);
    add(p.e_w_in + 3088, OFF_WIN, DIN_, D_, 2048, 0, 3072);
    add(p.e_w_out, OFF_WOUT, D_, D_, D_, 0, 0);
    add(p.o_w_qkv, OFF_WQKV, QC_, D_, QC_, 0, 0);
    add(p.o_w_o, OFF_WO, D_, D_, D_, 0, 0);
    for (int l = 0; l < 2; ++l) {
        add(p.f_w1 + (size_t)l * D_ * DFF_, OFF_W13 + l * SZ_W13, DFF_, D_, DFF_, 1, 0);
        add(p.f_w3 + (size_t)l * D_ * DFF_, OFF_W13 + l * SZ_W13, DFF_, D_, DFF_, 1, 128);
        add(p.f_w2 + (size_t)l * DFF_ * D_, OFF_W2 + l * SZ_W2, D_, DFF_, D_, 0, 0);
    }
    p.nseg = ns; p.total_tiles = tot;
    void* args[] = {&p};
    hipError_t e = hipLaunchCooperativeKernel((const void*)mega_fwd, dim3(grid_blocks), dim3(512), args, LDS_BYTES, stream);
    if (e != hipSuccess) fprintf(stderr, "cooperative launch failed: %s (grid %d)\n", hipGetErrorString(e), grid_blocks);
}
```

```cpp
#include <hip/hip_runtime.h>
#include <hip/hip_cooperative_groups.h>
#include <cstdio>
#include <cstring>
namespace cg = cooperative_groups;
namespace pg8 {
#define PG8_LAS __attribute__((address_space(3)))
typedef unsigned short bf16_t;
typedef short bf16x8 __attribute__((ext_vector_type(8)));
typedef float f32x4 __attribute__((ext_vector_type(4)));
typedef unsigned u32x4 __attribute__((ext_vector_type(4)));
constexpr int BM = 256, BK = 64, HALF = 128, HTB = HALF * BK * 2  , STAGE_BYTES = 8 * HTB, NXCD = 8, WGM = 4;

__host__ __device__ __forceinline__ int lds_byte(int r, int c) { const int st = (r >> 4) * 2 + (c >> 5), rr = r & 15, cc = c & 31, ob = rr * 64 + cc * 2; return st * 1024 + (ob ^ (((ob >> 9) & 1) << 5)); }
__host__ __device__ __forceinline__ void stage_rc(int b, int& R, int& C) { const int st = b / 1024, sb = b % 1024, swz = sb ^ (((sb >> 9) & 1) << 5); R = (st >> 1) * 16 + swz / 64; C = (st & 1) * 32 + (swz % 64) / 2; }
__host__ __device__ __forceinline__ int perm32(int rho) { const int n = rho >> 4, i = rho & 15; return 8 * (i >> 2) + 4 * n + (i & 3); }

struct Unit { int pm, pn; };
struct Gemm { const bf16_t* A; const bf16_t* Bt; int M, N, K; };

struct StaticOrder {
    int nM, nN, nwg, G, c;
    __host__ __device__ void init(int M, int N, int G_, int c_) { nM = M / BM; nN = N / BM; nwg = nM * nN; G = G_; c = c_; }
    __host__ __device__ bool next(int i, Unit& u) const {
        const long L = (long)i * G + c; if (L >= nwg) return false;
        int wgid = (int)L; { const int q = nwg / NXCD, r = nwg % NXCD, xcd = wgid % NXCD, off = wgid / NXCD; wgid = (xcd < r ? xcd * (q + 1) : r * (q + 1) + (xcd - r) * q) + off; }
        const int nig = WGM * nN, gid = wgid / nig, fm = gid * WGM, gsz = (nM - fm) < WGM ? (nM - fm) : WGM;
        u.pm = fm + ((wgid % nig) % gsz); u.pn = (wgid % nig) / gsz; return true;
    }
    __device__ __forceinline__ void a_ready(const Unit&) const {}
    __device__ __forceinline__ void done(const Unit&) const {}
};
__device__ __forceinline__ unsigned cvt_pk_bf16(float lo, float hi) { unsigned r; asm volatile("v_cvt_pk_bf16_f32 %0, %1, %2" : "=v"(r) : "v"(lo), "v"(hi)); return r; }
typedef float f32x2 __attribute__((ext_vector_type(2)));
typedef unsigned u32x4 __attribute__((ext_vector_type(4)));
typedef unsigned u32x2 __attribute__((ext_vector_type(2)));
struct EpiStoreBf16 {
    static constexpr bool PERM = true, AFTER_DRAIN = false;
    bf16_t* O; int ldc; const float* ss; int headmajor;
    __device__ __forceinline__ void operator()(const f32x4 (&acc)[2][2][4][2], const Unit& u, int wr, int wc, int fr, int fq) const {
        const int row0 = u.pm * BM + wr * 64 + fr, col0 = u.pn * BM + wc * 32 + 8 * fq;
        float rs[2][4];
#pragma unroll
        for (int ai = 0; ai < 2; ++ai)
#pragma unroll
            for (int m = 0; m < 4; ++m) rs[ai][m] = ss ? ss[row0 + ai * HALF + m * 16] : 0.f;
#pragma unroll
        for (int ai = 0; ai < 2; ++ai)
#pragma unroll
            for (int m = 0; m < 4; ++m) rs[ai][m] = ss ? rsqrtf(rs[ai][m] * (1.0f / 2048.0f) + 1e-6f) : 1.0f;
#pragma unroll
        for (int ai = 0; ai < 2; ++ai)
#pragma unroll
            for (int m = 0; m < 4; ++m) { const int row = row0 + ai * HALF + m * 16;
                bf16_t* rowp = headmajor ? O + ((size_t)((col0 >> 11) * 128 + (row >> 12) * 16 + ((col0 >> 7) & 15)) * 4096 + (row & 4095)) * 128 + (col0 & 127)
                                         : O + (size_t)row * ldc + col0;
                const size_t bjstep = headmajor ? (size_t)4096 * 128 : (size_t)HALF;
#pragma unroll
                for (int bj = 0; bj < 2; ++bj) { const f32x4 v0 = acc[ai][bj][m][0] * rs[ai][m], v1 = acc[ai][bj][m][1] * rs[ai][m];
                    u32x4 w; w.x = cvt_pk_bf16(v0[0], v0[1]); w.y = cvt_pk_bf16(v0[2], v0[3]); w.z = cvt_pk_bf16(v1[0], v1[1]); w.w = cvt_pk_bf16(v1[2], v1[3]);
                    *(u32x4*)(rowp + bj * bjstep) = w; } }
    }
};
struct EpiResF32 {
    static constexpr bool PERM = false, AFTER_DRAIN = false;
    float* C; const float* base; int ldc; bf16_t* XB; float* ss;
    __device__ __forceinline__ void operator()(const f32x4 (&acc)[2][2][4][2], const Unit& u, int wr, int wc, int fr, int fq) const {
        const int row0 = u.pm * BM + wr * 64 + fr, col0 = u.pn * BM + wc * 32 + 4 * fq;
        float sq[2][4];
#pragma unroll
        for (int ai = 0; ai < 2; ++ai)
#pragma unroll
            for (int m = 0; m < 4; ++m) sq[ai][m] = 0.f;
#pragma unroll
        for (int bj = 0; bj < 2; ++bj)
#pragma unroll
          for (int ai = 0; ai < 2; ++ai) {
            f32x4 bv[4][2];
#pragma unroll
            for (int m = 0; m < 4; ++m)
#pragma unroll
                for (int n = 0; n < 2; ++n) bv[m][n] = *(const f32x4*)(base + (size_t)(row0 + ai * HALF + m * 16) * ldc + col0 + bj * HALF + n * 16);
#pragma unroll
            for (int m = 0; m < 4; ++m)
#pragma unroll
                for (int n = 0; n < 2; ++n) { const size_t off = (size_t)(row0 + ai * HALF + m * 16) * ldc + col0 + bj * HALF + n * 16;
                    const f32x4 r = acc[ai][bj][m][n] + bv[m][n];
                    *(f32x4*)(C + off) = r;
                    if (XB) { sq[ai][m] += r[0] * r[0] + r[1] * r[1] + r[2] * r[2] + r[3] * r[3]; u32x2 w; w.x = cvt_pk_bf16(r[0], r[1]); w.y = cvt_pk_bf16(r[2], r[3]); *(u32x2*)(XB + off) = w; } }
          }
        if (XB) {
#pragma unroll
            for (int ai = 0; ai < 2; ++ai)
#pragma unroll
                for (int m = 0; m < 4; ++m) { float s = sq[ai][m]; s += __shfl_xor(s, 16); s += __shfl_xor(s, 32); if (fq == 0) unsafeAtomicAdd(ss + row0 + ai * HALF + m * 16, s); } }
    }
};
__device__ __forceinline__ float silu_mul(float a, float b) { return a * __builtin_amdgcn_rcpf(1.0f + __expf(-a)) * b; }
struct EpiSwiGLU {
    static constexpr bool PERM = true, AFTER_DRAIN = false;
    bf16_t* O; int ldc; const float* ss;
    __device__ __forceinline__ void operator()(const f32x4 (&acc)[2][2][4][2], const Unit& u, int wr, int wc, int fr, int fq) const {
        const int row0 = u.pm * BM + wr * 64 + fr, col0 = u.pn * HALF + wc * 32 + 8 * fq;
        float rs[2][4];
#pragma unroll
        for (int ai = 0; ai < 2; ++ai)
#pragma unroll
            for (int m = 0; m < 4; ++m) rs[ai][m] = ss[row0 + ai * HALF + m * 16];
#pragma unroll
        for (int ai = 0; ai < 2; ++ai)
#pragma unroll
            for (int m = 0; m < 4; ++m) rs[ai][m] = rsqrtf(rs[ai][m] * (1.0f / 2048.0f) + 1e-6f);
#pragma unroll
        for (int ai = 0; ai < 2; ++ai)
#pragma unroll
            for (int m = 0; m < 4; ++m) { bf16_t* rowp = O + (size_t)(row0 + ai * HALF + m * 16) * ldc + col0;
                const f32x4 a0 = acc[ai][0][m][0] * rs[ai][m], a1 = acc[ai][0][m][1] * rs[ai][m], b0 = acc[ai][1][m][0] * rs[ai][m], b1 = acc[ai][1][m][1] * rs[ai][m];
                u32x4 w; w.x = cvt_pk_bf16(silu_mul(a0[0], b0[0]), silu_mul(a0[1], b0[1])); w.y = cvt_pk_bf16(silu_mul(a0[2], b0[2]), silu_mul(a0[3], b0[3]));
                w.z = cvt_pk_bf16(silu_mul(a1[0], b1[0]), silu_mul(a1[1], b1[1])); w.w = cvt_pk_bf16(silu_mul(a1[2], b1[2]), silu_mul(a1[3], b1[3]));
                *(u32x4*)rowp = w; }
    }
};

template <bool BASE_BF16, bool OUT_F32, bool OUT_BF16>
struct EpiRes {
    static constexpr bool PERM = true, AFTER_DRAIN = false;
    const void* base; float* C; bf16_t* XB; float* ss; int ldc;
    __device__ __forceinline__ void operator()(const f32x4 (&acc)[2][2][4][2], const Unit& u, int wr, int wc, int fr, int fq) const {
        const int row0 = u.pm * BM + wr * 64 + fr, col0 = u.pn * BM + wc * 32 + 8 * fq;
        constexpr int NA = BASE_BF16 ? 2 : 1;
        float sq[2][4];
#pragma unroll
        for (int ai = 0; ai < 2; ++ai)
#pragma unroll
            for (int m = 0; m < 4; ++m) sq[ai][m] = 0.f;
#pragma unroll
        for (int bj = 0; bj < 2; ++bj)
#pragma unroll
          for (int a0 = 0; a0 < 2; a0 += NA) {
            u32x4 raw[NA][4]; f32x4 f0[NA][4], f1[NA][4];
#pragma unroll
            for (int da = 0; da < NA; ++da)
#pragma unroll
                for (int m = 0; m < 4; ++m) { const size_t off = (size_t)(row0 + (a0 + da) * HALF + m * 16) * ldc + col0 + bj * HALF;
                    if (BASE_BF16) raw[da][m] = *(const u32x4*)((const bf16_t*)base + off);
                    else { f0[da][m] = *(const f32x4*)((const float*)base + off); f1[da][m] = *(const f32x4*)((const float*)base + off + 4); } }
#pragma unroll
            for (int da = 0; da < NA; ++da)
#pragma unroll
                for (int m = 0; m < 4; ++m) { const int ai = a0 + da; const size_t off = (size_t)(row0 + ai * HALF + m * 16) * ldc + col0 + bj * HALF;
                    f32x4 b0, b1;
                    if (BASE_BF16) { const u32x4 w = raw[da][m];
                        b0 = (f32x4){__uint_as_float(w.x << 16), __uint_as_float(w.x & 0xffff0000u), __uint_as_float(w.y << 16), __uint_as_float(w.y & 0xffff0000u)};
                        b1 = (f32x4){__uint_as_float(w.z << 16), __uint_as_float(w.z & 0xffff0000u), __uint_as_float(w.w << 16), __uint_as_float(w.w & 0xffff0000u)}; }
                    else { b0 = f0[da][m]; b1 = f1[da][m]; }
                    const f32x4 r0 = acc[ai][bj][m][0] + b0, r1 = acc[ai][bj][m][1] + b1;
                    if (OUT_F32) { *(f32x4*)(C + off) = r0; *(f32x4*)(C + off + 4) = r1; }
                    if (OUT_BF16) { sq[ai][m] += (r0[0] * r0[0] + r0[1] * r0[1] + r0[2] * r0[2] + r0[3] * r0[3]) + (r1[0] * r1[0] + r1[1] * r1[1] + r1[2] * r1[2] + r1[3] * r1[3]);
                        u32x4 w; w.x = cvt_pk_bf16(r0[0], r0[1]); w.y = cvt_pk_bf16(r0[2], r0[3]); w.z = cvt_pk_bf16(r1[0], r1[1]); w.w = cvt_pk_bf16(r1[2], r1[3]);
                        *(u32x4*)(XB + off) = w; } }
          }
        if (OUT_BF16) {
#pragma unroll
            for (int ai = 0; ai < 2; ++ai)
#pragma unroll
                for (int m = 0; m < 4; ++m) { float s = sq[ai][m]; s += __shfl_xor(s, 16); s += __shfl_xor(s, 32); if (fq == 0) unsafeAtomicAdd(ss + row0 + ai * HALF + m * 16, s); } }
    }
};
template <class Epi, class Sched, bool STAMP = false>
__device__ __forceinline__ void gemm_phase(PG8_LAS unsigned char* lds, const Gemm g, const Sched& S, const Epi& E, unsigned long long* stamps) {
    int tid_ = threadIdx.x; asm volatile("" : "+v"(tid_)); const int tid = tid_, wid = __builtin_amdgcn_readfirstlane(tid >> 6), lane = tid & 63, wr = wid >> 2, wc = wid & 3, fr = lane & 15, fq = lane >> 4;
    const int K = g.K, nt = K / BK;
    int ts_lo = 0, ts_hi = 0, nts = 0; const unsigned long long rt_entry = STAMP ? (unsigned long long)wall_clock64() : 0ull;
#define PG8_STAMP() do { if (STAMP && wid == 0 && nts < 64) { const unsigned long long _c = (unsigned long long)clock64(); \
        ts_lo = (lane == nts) ? (int)(unsigned)_c : ts_lo; ts_hi = (lane == nts) ? (int)(unsigned)(_c >> 32) : ts_hi; ++nts; } } while (0)
    PG8_STAMP();
    unsigned voffA[2], voffB[2];
#pragma unroll
    for (int i = 0; i < 2; ++i) { int R, C; stage_rc(tid * 16 + i * 8192, R, C); const int Rb = Epi::PERM ? ((R & ~31) + perm32(R & 31)) : R;
        voffA[i] = (unsigned)(R * K + C) * 2u; voffB[i] = (unsigned)(Rb * K + C) * 2u; }
    const size_t kstep = (size_t)(BK * 2);
    const size_t hstep = (size_t)HALF * K * 2;
    const size_t tstep = 2 * hstep;
    const unsigned ldsw = (unsigned)wid * 1024u;
    const int aoff = lds_byte(wr * 64 + fr, fq * 8), boff = lds_byte(wc * 32 + fr, fq * 8);
#define PG8_SA(b, h) (((b) * 2 + (h)) * HTB)
#define PG8_SB(b, h) ((4 + (b) * 2 + (h)) * HTB)
#define PG8_STAGE(bufoff, gbase, voff) do { _Pragma("unroll") for (int _i = 0; _i < 2; ++_i) \
        __builtin_amdgcn_global_load_lds((const unsigned*)((const char*)(gbase) + (voff)[_i]), (PG8_LAS unsigned*)(lds + (bufoff) + ldsw + _i * 8192), 16, 0, 0); } while (0)
#define PG8_LDA(dst, b, h) do { _Pragma("unroll") for (int m = 0; m < 4; ++m) _Pragma("unroll") for (int k = 0; k < 2; ++k) dst[m][k] = *(const PG8_LAS bf16x8*)(lds + PG8_SA(b, h) + aoff + m * 2048 + k * 1024); } while (0)
#define PG8_LDB(dst, b, h) do { _Pragma("unroll") for (int n = 0; n < 2; ++n) _Pragma("unroll") for (int k = 0; k < 2; ++k) dst[n][k] = *(const PG8_LAS bf16x8*)(lds + PG8_SB(b, h) + boff + n * 2048 + k * 1024); } while (0)
#define PG8_MMA(ai, bj, At, Bt) do { __builtin_amdgcn_s_setprio(1); _Pragma("unroll") for (int m = 0; m < 4; ++m) _Pragma("unroll") for (int n = 0; n < 2; ++n) _Pragma("unroll") for (int k = 0; k < 2; ++k) \
        acc[ai][bj][m][n] = __builtin_amdgcn_mfma_f32_16x16x32_bf16(Bt[n][k], At[m][k], acc[ai][bj][m][n], 0, 0, 0); __builtin_amdgcn_s_setprio(0); } while (0)
#define PG8_WAIT_V(n) asm volatile("s_waitcnt vmcnt(" #n ")" ::: "memory")
#define PG8_WAIT_L(n) asm volatile("s_waitcnt lgkmcnt(" #n ")" ::: "memory")
#define PG8_BAR __builtin_amdgcn_s_barrier()
#define PG8_SCHED __builtin_amdgcn_sched_barrier(0)
    Unit cur, nxt; int ui = 0;
    if (!S.next(0, cur)) return;
    f32x4 acc[2][2][4][2];
#pragma unroll
    for (int a = 0; a < 2; ++a)
#pragma unroll
        for (int b = 0; b < 2; ++b)
#pragma unroll
            for (int m = 0; m < 4; ++m)
#pragma unroll
                for (int n = 0; n < 2; ++n) acc[a][b][m][n] = (f32x4){0.f, 0.f, 0.f, 0.f};
    bf16x8 At[4][2], B0[2][2], B1[2][2];
    const char* cA = (const char*)g.A + (size_t)cur.pm * tstep; const char* cB = (const char*)g.Bt + (size_t)cur.pn * tstep;
    S.a_ready(cur);
    PG8_STAGE(PG8_SB(0, 0), cB, voffB); PG8_STAGE(PG8_SA(0, 0), cA, voffA); PG8_STAGE(PG8_SB(0, 1), cB + hstep, voffB); PG8_STAGE(PG8_SA(0, 1), cA + hstep, voffA);
    if (wr == 1) PG8_BAR;
    PG8_WAIT_V(4); PG8_BAR;
    PG8_STAGE(PG8_SB(1, 0), cB + kstep, voffB); PG8_STAGE(PG8_SA(1, 0), cA + kstep, voffA); PG8_STAGE(PG8_SB(1, 1), cB + hstep + kstep, voffB);
    PG8_WAIT_V(6); PG8_BAR;
    PG8_STAMP();
    for (;;) {
        const bool has_next = S.next(ui + 1, nxt);
        const char* nA = has_next ? (const char*)g.A + (size_t)nxt.pm * tstep : cA; const char* nB = has_next ? (const char*)g.Bt + (size_t)nxt.pn * tstep : cB;
        for (int t = 0; t < nt; t += 2) {
            const bool last = (t == nt - 2);
            const char* a1 = cA + (size_t)(t + 1) * kstep;
            const char* a2 = last ? nA : cA + (size_t)(t + 2) * kstep; const char* b2 = last ? nB : cB + (size_t)(t + 2) * kstep;
            const char* a3 = a2 + kstep; const char* b3 = b2 + kstep;
            if (last && has_next) S.a_ready(nxt);
            PG8_LDB(B0, 0, 0); PG8_SCHED; PG8_LDA(At, 0, 0); PG8_STAGE(PG8_SA(1, 1), a1 + hstep, voffA);
            PG8_WAIT_L(8); PG8_BAR; PG8_WAIT_L(0); PG8_MMA(0, 0, At, B0); PG8_BAR; PG8_SCHED;
            PG8_LDB(B1, 0, 1); PG8_STAGE(PG8_SB(0, 0), b2, voffB);
            PG8_BAR; PG8_WAIT_L(0); PG8_MMA(0, 1, At, B1); PG8_BAR;
            PG8_LDA(At, 0, 1); PG8_STAGE(PG8_SA(0, 0), a2, voffA);
            PG8_BAR; PG8_WAIT_L(0); PG8_MMA(1, 0, At, B0); PG8_BAR; PG8_SCHED;
            PG8_STAGE(PG8_SB(0, 1), b2 + hstep, voffB);
            PG8_WAIT_V(6); PG8_BAR; PG8_MMA(1, 1, At, B1); PG8_BAR;
            PG8_LDB(B0, 1, 0); PG8_SCHED; PG8_LDA(At, 1, 0); PG8_STAGE(PG8_SA(0, 1), a2 + hstep, voffA);
            PG8_WAIT_L(8); PG8_BAR; PG8_WAIT_L(0); PG8_MMA(0, 0, At, B0); PG8_BAR; PG8_SCHED;
            PG8_LDB(B1, 1, 1); PG8_STAGE(PG8_SB(1, 0), b3, voffB);
            PG8_BAR; PG8_WAIT_L(0); PG8_MMA(0, 1, At, B1); PG8_BAR;
            PG8_LDA(At, 1, 1); PG8_STAGE(PG8_SA(1, 0), a3, voffA);
            PG8_BAR; PG8_WAIT_L(0); PG8_MMA(1, 0, At, B0); PG8_BAR; PG8_SCHED;
            PG8_STAGE(PG8_SB(1, 1), b3 + hstep, voffB);
            PG8_WAIT_V(6); PG8_BAR; PG8_MMA(1, 1, At, B1); PG8_BAR;
        }
        PG8_STAMP();
        if constexpr (!Epi::AFTER_DRAIN) { E(acc, cur, wr, wc, fr, fq); S.done(cur); }
        PG8_STAMP();
        if (!has_next) break;
#pragma unroll
        for (int a = 0; a < 2; ++a)
#pragma unroll
            for (int b = 0; b < 2; ++b)
#pragma unroll
                for (int m = 0; m < 4; ++m)
#pragma unroll
                    for (int n = 0; n < 2; ++n) acc[a][b][m][n] = (f32x4){0.f, 0.f, 0.f, 0.f};
        cur = nxt; cA = nA; cB = nB; ++ui;
    }
    PG8_WAIT_V(0);
    if (wr == 0) PG8_BAR;
    PG8_BAR;
    if constexpr (Epi::AFTER_DRAIN) { E.fused(acc, cur, wr, wc, fr, fq, lds, wid, lane); S.done(cur); }
    PG8_STAMP();
    if (STAMP && wid == 0) { stamps[lane] = lane < nts ? (((unsigned long long)(unsigned)ts_hi << 32) | (unsigned)ts_lo) : 0ull;
        if (lane == 62) stamps[62] = rt_entry; if (lane == 63) stamps[63] = (unsigned long long)wall_clock64(); }
#undef PG8_STAMP
#undef PG8_SA
#undef PG8_SB
#undef PG8_STAGE
#undef PG8_LDA
#undef PG8_LDB
#undef PG8_MMA
#undef PG8_WAIT_V
#undef PG8_WAIT_L
#undef PG8_BAR
#undef PG8_SCHED
}
}

#define LAS __attribute__((address_space(3)))
typedef unsigned short u16;
typedef short bf16x8 __attribute__((ext_vector_type(8)));
typedef short bf16x4 __attribute__((ext_vector_type(4)));
typedef float f32x4 __attribute__((ext_vector_type(4)));
typedef unsigned u32x4 __attribute__((ext_vector_type(4)));
typedef unsigned u32x2 __attribute__((ext_vector_type(2)));

constexpr int T_ = 32768, S_ = 4096, D_ = 2048, DFF_ = 5632, DIN_ = 5136, ZC_ = 5120, QC_ = 6144;
constexpr int LDS_MAIN = 139264, LDS_BYTES = LDS_MAIN + 16;
constexpr size_t SZ_WIN = (size_t)ZC_ * D_ * 2, SZ_WSQ = (size_t)D_ * D_ * 2, SZ_WQKV = (size_t)QC_ * D_ * 2, SZ_W13 = (size_t)2 * DFF_ * D_ * 2, SZ_W2 = (size_t)D_ * DFF_ * 2;
constexpr size_t OFF_WIN = 0, OFF_WOUT = OFF_WIN + SZ_WIN, OFF_WQKV = OFF_WOUT + SZ_WSQ, OFF_WO = OFF_WQKV + SZ_WQKV, OFF_W13 = OFF_WO + SZ_WSQ, OFF_W2 = OFF_W13 + 2 * SZ_W13,
                 OFF_WRG = OFF_W2 + 2 * SZ_W2, OFF_XN = OFF_WRG + (size_t)64 * 16384 * 2, OFF_BIG = OFF_XN + (size_t)T_ * D_ * 2, OFF_MIX = OFF_BIG + (size_t)T_ * QC_ * 2,
                 OFF_GATES = OFF_MIX + (size_t)T_ * D_ * 4, OFF_RGSUM = OFF_GATES + (size_t)T_ * 16 * 4, OFF_RGCAR = OFF_RGSUM + (size_t)8 * 64 * 2 * 1024 * 8,
                 OFF_LSE = OFF_RGCAR + (size_t)8 * 64 * 2 * 1024 * 4, OFF_SS = OFF_LSE + (size_t)3 * T_ * 16 * 4, OFF_BAR = OFF_SS + (size_t)4 * T_ * 4, WS_END = OFF_BAR + 16384;

struct Seg { const float* src; u16* dst; const float* gain; int ld, K, nN32, mode, rowoff, ntiles; };
struct Params {
    const float *x, *e_norm, *e_w_in, *e_gate_b, *e_conv_w, *e_conv_b, *e_rg_wa, *e_rg_ba, *e_rg_wx, *e_rg_bx, *e_rg_lam, *e_head_g, *e_w_out, *o_norm, *o_w_qkv, *o_w_o, *f_norm, *f_w1, *f_w3, *f_w2, *final_norm;
    float* out; unsigned char* ws;
    Seg seg[12]; int nseg, total_tiles;
};


typedef const __attribute__((address_space(4))) Params* PP;
__device__ __forceinline__ PP get_params() { auto k = __builtin_amdgcn_kernarg_segment_ptr(); asm volatile("" : "+s"(k)); return (PP)k; }
__device__ __forceinline__ int l_tid() { int t = threadIdx.x; asm volatile("" : "+v"(t)); return t; }
extern __shared__ __attribute__((aligned(16))) unsigned char lds_raw[];
__device__ __forceinline__ int l_bid() { int t = __builtin_amdgcn_readfirstlane(*(volatile LAS int*)((LAS unsigned char*)lds_raw + 139264 + 8)); asm volatile("" : "+s"(t)); return t; }
__device__ __forceinline__ int l_nblk() { int t = gridDim.x; asm volatile("" : "+s"(t)); return t; }
__device__ __forceinline__ unsigned pk2(float lo, float hi) { return pg8::cvt_pk_bf16(lo, hi); }
__device__ __forceinline__ float bflo(unsigned w) { return __uint_as_float(w << 16); }
__device__ __forceinline__ float bfhi(unsigned w) { return __uint_as_float(w & 0xffff0000u); }
__device__ __forceinline__ float wave_sum(float v) {
#pragma unroll
    for (int o = 1; o < 64; o <<= 1) v += __shfl_xor(v, o);
    return v;
}
__device__ __forceinline__ bf16x8 cat8(bf16x4 a, bf16x4 b) { return __builtin_shufflevector(a, b, 0, 1, 2, 3, 4, 5, 6, 7); }
__device__ __forceinline__ bf16x4 lds_tr(LAS unsigned char* p) { return __builtin_amdgcn_ds_read_tr16_b64_v4i16((LAS bf16x4*)p); }
__device__ __forceinline__ bf16x8 lds_r8(LAS unsigned char* p) { return *(LAS bf16x8*)p; }
__device__ __forceinline__ bf16x8 as_bf16x8(u32x4 v) { union { u32x4 u; bf16x8 b; } c; c.u = v; return c.b; }
#define MFMA16(a, b, c) __builtin_amdgcn_mfma_f32_16x16x32_bf16((a), (b), (c), 0, 0, 0)
#define LDSWAIT() asm volatile("s_waitcnt lgkmcnt(0)" ::: "memory")
__device__ __forceinline__ float sigmoidf_(float v) { return __builtin_amdgcn_rcpf(1.0f + __expf(-v)); }

__device__ __forceinline__ void transpose_item(const float* src, const float* gain, int ld, u16* dst, int K, int nN32, int mode, int rowoff, int item, LAS float* scr, int lane) {
    const int nb = item % nN32, kb = item / nN32, k0 = 64 * kb, n0 = 32 * nb;
#pragma unroll 8
    for (int i = 0; i < 32; ++i) { const int kk = 2 * i + (lane >> 5); scr[kk * 33 + (lane & 31)] = src[(size_t)(k0 + kk) * ld + n0 + (lane & 31)]; }
    LDSWAIT();
    const int R0 = mode ? (((n0 >> 7) << 8) + (n0 & 127) + rowoff) : (n0 + rowoff);
    const int c = lane & 7;
    f32x4 g0 = (f32x4){1.f, 1.f, 1.f, 1.f}, g1 = g0;
    if (gain) { g0 = *(const f32x4*)(gain + k0 + 8 * c); g1 = *(const f32x4*)(gain + k0 + 8 * c + 4); }
#pragma unroll
    for (int j = 0; j < 4; ++j) { const int n = (lane >> 3) + 8 * j; const LAS float* s = scr + (8 * c) * 33 + n;
        u32x4 o; o.x = pk2(s[0 * 33] * g0.x, s[1 * 33] * g0.y); o.y = pk2(s[2 * 33] * g0.z, s[3 * 33] * g0.w); o.z = pk2(s[4 * 33] * g1.x, s[5 * 33] * g1.y); o.w = pk2(s[6 * 33] * g1.z, s[7 * 33] * g1.w);
        *(u32x4*)(dst + (size_t)(R0 + n) * K + k0 + 8 * c) = o; }
    LDSWAIT();
}

__device__ __forceinline__ void phase0(LAS unsigned char* L) { PP p = get_params();
    const int tid = l_tid(), lane = tid & 63, wid = tid >> 6;
    const int gw = l_bid() * 8 + wid, NGW = l_nblk() * 8;
    LAS float* scr = (LAS float*)(L + wid * 8704);
    for (int it = gw; it < p->total_tiles; it += NGW) {
        int r = it, si = 0;
        while (r >= p->seg[si].ntiles) { r -= p->seg[si].ntiles; ++si; }
        transpose_item(p->seg[si].src, p->seg[si].gain, p->seg[si].ld, p->seg[si].dst, p->seg[si].K, p->seg[si].nN32, p->seg[si].mode, p->seg[si].rowoff, r, scr, lane);
    }
    for (int it = gw; it < 256; it += NGW) {
        const int mi = it >> 3, sub = it & 7, mat = mi >> 4, dn = mi & 15;
        const float* src = (mat ? p->e_rg_wx : p->e_rg_wa) + (size_t)dn * 16384;
        u16* dst = (u16*)(p->ws + OFF_WRG) + (size_t)((((dn >> 3) * 2 + mat) * 8) + (dn & 7)) * 16384;
        transpose_item(src, nullptr, 128, dst, 128, 4, 0, 0, sub, scr, lane);
    }
    __syncthreads();
    { float* SSZ = (float*)(p->ws + OFF_SS); for (int i = l_bid() * 512 + tid; i < 4 * T_; i += l_nblk() * 512) SSZ[i] = 0.f; }
    LAS float* WgT = (LAS float*)L;
    for (int k = tid; k < D_; k += 512) {
        const float* s = p->e_w_in + (size_t)k * DIN_ + 3072;
#pragma unroll
        for (int c = 0; c < 4; ++c) { const f32x4 v = *(const f32x4*)(s + 4 * c);
            WgT[(4 * c + 0) * D_ + k] = v.x; WgT[(4 * c + 1) * D_ + k] = v.y; WgT[(4 * c + 2) * D_ + k] = v.z; WgT[(4 * c + 3) * D_ + k] = v.w; }
    }
    __syncthreads();
    u16* XN = (u16*)(p->ws + OFF_XN);
    float* GT = (float*)(p->ws + OFF_GATES);
    f32x4 gk[8];
#pragma unroll
    for (int i = 0; i < 8; ++i) gk[i] = *(const f32x4*)(p->e_norm + 256 * i + 4 * lane);
    const float gb = p->e_gate_b[(lane >> 1) & 15];
    for (int rp = gw; rp < T_ / 2; rp += NGW) {
        const float* x0 = p->x + (size_t)(2 * rp) * D_; const float* x1 = x0 + D_;
        f32x4 a[8], b[8]; float s0 = 0.f, s1 = 0.f;
#pragma unroll
        for (int i = 0; i < 8; ++i) { a[i] = *(const f32x4*)(x0 + 256 * i + 4 * lane); b[i] = *(const f32x4*)(x1 + 256 * i + 4 * lane);
            s0 += a[i].x * a[i].x + a[i].y * a[i].y + a[i].z * a[i].z + a[i].w * a[i].w; s1 += b[i].x * b[i].x + b[i].y * b[i].y + b[i].z * b[i].z + b[i].w * b[i].w; }
        const float r0 = rsqrtf(wave_sum(s0) * (1.0f / D_) + 1e-6f), r1 = rsqrtf(wave_sum(s1) * (1.0f / D_) + 1e-6f);
        u16* o0 = XN + (size_t)(2 * rp) * D_; u16* o1 = o0 + D_;
#pragma unroll
        for (int i = 0; i < 8; ++i) { a[i] = a[i] * r0 * gk[i]; b[i] = b[i] * r1 * gk[i];
            u32x2 w0, w1; w0.x = pk2(a[i].x, a[i].y); w0.y = pk2(a[i].z, a[i].w); w1.x = pk2(b[i].x, b[i].y); w1.y = pk2(b[i].z, b[i].w);
            *(u32x2*)(o0 + 256 * i + 4 * lane) = w0; *(u32x2*)(o1 + 256 * i + 4 * lane) = w1; }
        float v[32];
#pragma unroll
        for (int j = 0; j < 16; ++j) { float c0 = 0.f, c1 = 0.f;
#pragma unroll
            for (int i = 0; i < 8; ++i) { const f32x4 w = *(LAS f32x4*)(WgT + j * D_ + 256 * i + 4 * lane);
                c0 += a[i].x * w.x + a[i].y * w.y + a[i].z * w.z + a[i].w * w.w; c1 += b[i].x * w.x + b[i].y * w.y + b[i].z * w.z + b[i].w * w.w; }
            v[j] = c0; v[16 + j] = c1; }
#pragma unroll
        for (int j = 0; j < 16; ++j) { const bool hi = lane & 32; const float keep = hi ? v[j + 16] : v[j], send = hi ? v[j] : v[j + 16]; v[j] = keep + __shfl_xor(send, 32); }
#pragma unroll
        for (int j = 0; j < 8; ++j) { const bool hi = lane & 16; const float keep = hi ? v[j + 8] : v[j], send = hi ? v[j] : v[j + 8]; v[j] = keep + __shfl_xor(send, 16); }
#pragma unroll
        for (int j = 0; j < 4; ++j) { const bool hi = lane & 8; const float keep = hi ? v[j + 4] : v[j], send = hi ? v[j] : v[j + 4]; v[j] = keep + __shfl_xor(send, 8); }
#pragma unroll
        for (int j = 0; j < 2; ++j) { const bool hi = lane & 4; const float keep = hi ? v[j + 2] : v[j], send = hi ? v[j] : v[j + 2]; v[j] = keep + __shfl_xor(send, 4); }
        { const bool hi = lane & 2; const float keep = hi ? v[1] : v[0], send = hi ? v[0] : v[1]; v[0] = keep + __shfl_xor(send, 2); }
        v[0] += __shfl_xor(v[0], 1);
        if ((lane & 1) == 0) { const int idx = lane >> 1; GT[(size_t)(2 * rp + (idx >> 4)) * 16 + (idx & 15)] = v[0] + gb; }
    }
}

template <bool TO_F32>
__device__ __forceinline__ void norm_phase(const float* X, const float* g, u16* O, float* OF) {
    const int tid = l_tid(), lane = tid & 63, wid = tid >> 6;
    const int gw = l_bid() * 8 + wid, NGW = l_nblk() * 8;
    f32x4 gk[8];
#pragma unroll
    for (int i = 0; i < 8; ++i) gk[i] = *(const f32x4*)(g + 256 * i + 4 * lane);
    for (int row = gw; row < T_; row += NGW) {
        const float* x0 = X + (size_t)row * D_;
        f32x4 a[8]; float s0 = 0.f;
#pragma unroll
        for (int i = 0; i < 8; ++i) { a[i] = *(const f32x4*)(x0 + 256 * i + 4 * lane); s0 += a[i].x * a[i].x + a[i].y * a[i].y + a[i].z * a[i].z + a[i].w * a[i].w; }
        const float r0 = rsqrtf(wave_sum(s0) * (1.0f / D_) + 1e-6f);
#pragma unroll
        for (int i = 0; i < 8; ++i) { a[i] = a[i] * r0 * gk[i];
            if (TO_F32) *(f32x4*)(OF + (size_t)row * D_ + 256 * i + 4 * lane) = a[i];
            else { u32x2 w0; w0.x = pk2(a[i].x, a[i].y); w0.y = pk2(a[i].z, a[i].w); *(u32x2*)(O + (size_t)row * D_ + 256 * i + 4 * lane) = w0; } }
    }
}

__device__ __forceinline__ float scan_add64(float v, int lane) {
#pragma unroll
    for (int d = 1; d < 64; d <<= 1) { const float t = __shfl_up(v, d); if (lane >= d) v += t; }
    return v;
}
__device__ __forceinline__ float scan_max64(float v, int lane) {
#pragma unroll
    for (int d = 1; d < 64; d <<= 1) { const float t = __shfl_up(v, d); if (lane >= d) v = fmaxf(v, t); }
    return v;
}
struct GateV { float a, g, wsrc, winter, mout, decay, mnext; };
__device__ __forceinline__ GateV gate_math(float gi, float gf, float m_carry, int lane) {
    GateV o;
    const float lf = (gf >= 0.f) ? -log1pf(__expf(-gf)) : (gf - log1pf(__expf(gf)));
    const float b = scan_add64(lf, lane);
    o.a = gi - b;
    const float M = scan_max64(o.a, lane);
    o.g = fmaxf(m_carry, M);
    const float bL = __shfl(b, 63), g63 = __shfl(o.g, 63);
    o.wsrc = __expf(o.a - g63); o.decay = __expf(m_carry - g63); o.winter = __expf(m_carry - o.g); o.mout = b + o.g; o.mnext = bL + g63;
    return o;
}

__device__ __forceinline__ void mlstm_phase(LAS unsigned char* L) { PP p = get_params();
    const int tid = l_tid(), lane = tid & 63, wid = __builtin_amdgcn_readfirstlane(tid >> 6), l15 = lane & 15, quad = lane >> 4;
    const u16* Z = (const u16*)(p->ws + OFF_BIG);
    const float* GT = (const float*)(p->ws + OFF_GATES);
    u16* HB = (u16*)(p->ws + OFF_MIX);
    constexpr int QS = 0, KS = 17408, VS = 34816, VW = 46080, CB = 57344, GA = 79104, GB = GA + 16384, GM = GB + 16384, GC = GM + 16384;
    constexpr float QSCALE = 0.08838834764831845f;
    const int r = tid >> 3, pc = tid & 7;
    const int lt = wid & 3, dvh = wid >> 2, lidx = 16 * lt + l15;
    for (int item = l_bid(); item < 256; item += l_nblk()) {
        const int dvq = item & 3, dir = (item >> 2) & 1, hh = (item >> 3) & 3, b = item >> 5;
        const size_t tok0 = (size_t)b * S_;
        u32x4 nq0, nq1, nk0, nk1, nv;
        {   const int pp = r; const int t = dir ? (S_ - 1 - pp) : pp; const u16* zr = Z + (tok0 + t) * ZC_;
            nq0 = *(const u32x4*)(zr + hh * 128 + 8 * pc); nq1 = *(const u32x4*)(zr + hh * 128 + 64 + 8 * pc);
            nk0 = *(const u32x4*)(zr + 512 + hh * 128 + 8 * pc); nk1 = *(const u32x4*)(zr + 512 + hh * 128 + 64 + 8 * pc);
            nv = *(const u32x4*)(zr + 1024 + hh * 256 + dvq * 64 + 8 * pc); }
#pragma unroll 2
        for (int k = 0; k < 8; ++k) { const int c = wid + 8 * k; const int pl = 64 * c + lane; const int tl = dir ? (S_ - 1 - pl) : pl; const float* gr = GT + (tok0 + tl) * 16;
            const float gi = gr[(2 * dir) * 4 + hh], gf = gr[(2 * dir + 1) * 4 + hh];
            const float lf = (gf >= 0.f) ? -log1pf(__expf(-gf)) : (gf - log1pf(__expf(gf)));
            const float bb = scan_add64(lf, lane), aa = gi - bb, MM = scan_max64(aa, lane);
            *(LAS float*)(L + GA + (c * 64 + lane) * 4) = aa; *(LAS float*)(L + GB + (c * 64 + lane) * 4) = bb; *(LAS float*)(L + GM + (c * 64 + lane) * 4) = MM; }
        f32x4 Cacc[5];
#pragma unroll
        for (int i = 0; i < 5; ++i) Cacc[i] = (f32x4){0.f, 0.f, 0.f, 0.f};
        for (int i = tid; i < 1360; i += 512) *(LAS u32x4*)(L + CB + i * 16) = (u32x4){0u, 0u, 0u, 0u};
        __syncthreads();
        if (wid == 0) {
            float m = -1e30f, mine = 0.f;
            for (int c = 0; c < 64; ++c) { const float bL = *(LAS float*)(L + GB + (c * 64 + 63) * 4), M63 = *(LAS float*)(L + GM + (c * 64 + 63) * 4);
                mine = (lane == c) ? m : mine; m = bL + fmaxf(m, M63); }
            *(LAS float*)(L + GC + lane * 4) = mine;
        }
        __syncthreads();
#define MLSTM_STAGE(cs) do { \
            *(LAS u32x4*)(L + QS + r * 272 + pc * 16) = nq0; *(LAS u32x4*)(L + QS + r * 272 + 128 + pc * 16) = nq1; \
            *(LAS u32x4*)(L + KS + r * 272 + pc * 16) = nk0; *(LAS u32x4*)(L + KS + r * 272 + 128 + pc * 16) = nk1; \
            *(LAS u32x4*)(L + VS + r * 176 + pc * 16) = nv; \
            const float g63_ = fmaxf(*(LAS float*)(L + GC + (cs) * 4), *(LAS float*)(L + GM + ((cs) * 64 + 63) * 4)); \
            const float wr_ = __expf(*(LAS float*)(L + GA + ((cs) * 64 + r) * 4) - g63_); u32x4 sv; \
            sv.x = pk2(bflo(nv.x) * wr_, bfhi(nv.x) * wr_); sv.y = pk2(bflo(nv.y) * wr_, bfhi(nv.y) * wr_); sv.z = pk2(bflo(nv.z) * wr_, bfhi(nv.z) * wr_); sv.w = pk2(bflo(nv.w) * wr_, bfhi(nv.w) * wr_); \
            *(LAS u32x4*)(L + VW + r * 176 + pc * 16) = sv; \
            if (pc < 2) { u32x4 one = (u32x4){pc == 0 ? 0x3F80u : 0u, 0u, 0u, 0u}; u32x4 ws_ = (u32x4){pc == 0 ? (pk2(wr_, 0.f) & 0xffffu) : 0u, 0u, 0u, 0u}; \
                *(LAS u32x4*)(L + VS + r * 176 + 128 + pc * 16) = one; *(LAS u32x4*)(L + VW + r * 176 + 128 + pc * 16) = ws_; } \
        } while (0)
        MLSTM_STAGE(0);
        for (int c = 0; c < 64; ++c) {
            if (c + 1 < 64) {
                const int pp = 64 * (c + 1) + r; const int t = dir ? (S_ - 1 - pp) : pp; const u16* zr = Z + (tok0 + t) * ZC_;
                nq0 = *(const u32x4*)(zr + hh * 128 + 8 * pc); nq1 = *(const u32x4*)(zr + hh * 128 + 64 + 8 * pc);
                nk0 = *(const u32x4*)(zr + 512 + hh * 128 + 8 * pc); nk1 = *(const u32x4*)(zr + 512 + hh * 128 + 64 + 8 * pc);
                nv = *(const u32x4*)(zr + 1024 + hh * 256 + dvq * 64 + 8 * pc);
            }
            __syncthreads();
            const float m_c = *(LAS float*)(L + GC + c * 4);
            const float g63 = fmaxf(m_c, *(LAS float*)(L + GM + (c * 64 + 63) * 4));
            const float g_l = fmaxf(m_c, *(LAS float*)(L + GM + (c * 64 + lidx) * 4));
            const float winter_l = __expf(m_c - g_l), mout_l = *(LAS float*)(L + GB + (c * 64 + lidx) * 4) + g_l;
            bf16x8 qf[4];
#pragma unroll
            for (int ks = 0; ks < 4; ++ks) qf[ks] = lds_r8(L + QS + (16 * lt + l15) * 272 + (32 * ks + 8 * quad) * 2);
            f32x4 sacc[4];
#pragma unroll
            for (int st = 0; st < 4; ++st) { sacc[st] = (f32x4){0.f, 0.f, 0.f, 0.f};
                if (st <= lt) {
#pragma unroll
                    for (int ks = 0; ks < 4; ++ks) { const bf16x8 kf = lds_r8(L + KS + (16 * st + l15) * 272 + (32 * ks + 8 * quad) * 2); sacc[st] = MFMA16(kf, qf[ks], sacc[st]); } } }
            float pw[4][4];
#pragma unroll
            for (int st = 0; st < 4; ++st) { const f32x4 a4 = *(LAS f32x4*)(L + GA + (c * 64 + 16 * st + 4 * quad) * 4);
#pragma unroll
                for (int jj = 0; jj < 4; ++jj) { const int sidx = 16 * st + 4 * quad + jj;
                    const float w = (sidx <= lidx) ? __expf(a4[jj] - g_l) * QSCALE : 0.f; pw[st][jj] = sacc[st][jj] * w; } }
            bf16x8 pf[2];
#pragma unroll
            for (int i = 0; i < 2; ++i) { u32x4 t; t.x = pk2(pw[2 * i][0], pw[2 * i][1]); t.y = pk2(pw[2 * i][2], pw[2 * i][3]); t.z = pk2(pw[2 * i + 1][0], pw[2 * i + 1][1]); t.w = pk2(pw[2 * i + 1][2], pw[2 * i + 1][3]); pf[i] = as_bf16x8(t); }
            f32x4 nacc[3];
#pragma unroll
            for (int x = 0; x < 3; ++x) { const int dt = (x < 2) ? (2 * dvh + x) : 4; nacc[x] = (f32x4){0.f, 0.f, 0.f, 0.f};
#pragma unroll
                for (int ks = 0; ks < 4; ++ks) { const bf16x8 cf = lds_r8(L + CB + (16 * dt + l15) * 272 + (32 * ks + 8 * quad) * 2); nacc[x] = MFMA16(cf, qf[ks], nacc[x]); }
                nacc[x] = nacc[x] * (winter_l * QSCALE);
#pragma unroll
                for (int i = 0; i < 2; ++i) {
                    const bf16x4 lo = lds_tr(L + VS + (32 * i + 4 * quad + (l15 >> 2)) * 176 + (16 * dt + 4 * (l15 & 3)) * 2);
                    const bf16x4 hi = lds_tr(L + VS + (32 * i + 16 + 4 * quad + (l15 >> 2)) * 176 + (16 * dt + 4 * (l15 & 3)) * 2);
                    nacc[x] = MFMA16(cat8(lo, hi), pf[i], nacc[x]); } }
            const float den = __shfl(nacc[2][0], l15);
            const float inv = 1.0f / fmaxf(fabsf(den), __expf(-mout_l));
            {   const int pp = 64 * c + lidx; const int t = dir ? (S_ - 1 - pp) : pp;
                u16* hrow = HB + ((size_t)dir * T_ + tok0 + t) * 1024 + hh * 256 + dvq * 64 + 4 * quad;
#pragma unroll
                for (int x = 0; x < 2; ++x) { const f32x4 hv = nacc[x] * inv; u32x2 w; w.x = pk2(hv[0], hv[1]); w.y = pk2(hv[2], hv[3]); *(u32x2*)(hrow + 16 * (2 * dvh + x)) = w; } }
            const float decay = __expf(m_c - g63);
#pragma unroll
            for (int dt = 0; dt < 5; ++dt) Cacc[dt] = Cacc[dt] * decay;
#pragma unroll
            for (int i = 0; i < 2; ++i) {
                const bf16x4 alo = lds_tr(L + KS + (32 * i + 8 * quad + (l15 >> 2)) * 272 + (16 * wid + 4 * (l15 & 3)) * 2);
                const bf16x4 ahi = lds_tr(L + KS + (32 * i + 8 * quad + 4 + (l15 >> 2)) * 272 + (16 * wid + 4 * (l15 & 3)) * 2);
                const bf16x8 kf = cat8(alo, ahi);
#pragma unroll
                for (int dt = 0; dt < 5; ++dt) {
                    const bf16x4 blo = lds_tr(L + VW + (32 * i + 8 * quad + (l15 >> 2)) * 176 + (16 * dt + 4 * (l15 & 3)) * 2);
                    const bf16x4 bhi = lds_tr(L + VW + (32 * i + 8 * quad + 4 + (l15 >> 2)) * 176 + (16 * dt + 4 * (l15 & 3)) * 2);
                    Cacc[dt] = MFMA16(kf, cat8(blo, bhi), Cacc[dt]); } }
            __syncthreads();
#pragma unroll
            for (int dt = 0; dt < 5; ++dt) { u32x2 w; w.x = pk2(Cacc[dt][0], Cacc[dt][1]); w.y = pk2(Cacc[dt][2], Cacc[dt][3]);
                *(LAS u32x2*)(L + CB + (16 * dt + l15) * 272 + (16 * wid + 4 * quad) * 2) = w; }
            if (c + 1 < 64) { MLSTM_STAGE(c + 1); }
        }
        __syncthreads();
    }
#undef MLSTM_STAGE
}

__device__ __forceinline__ void mlstm_combine_phase() { PP p = get_params();
    const int tid = l_tid(), lane = tid & 63, wid = tid >> 6;
    const int gw = l_bid() * 8 + wid, NGW = l_nblk() * 8;
    const u16* Z = (const u16*)(p->ws + OFF_BIG);
    const u16* HB = (const u16*)(p->ws + OFF_MIX);
    u16* Y = (u16*)(p->ws + OFF_XN);
    for (int it = gw; it < T_ * 4; it += NGW) {
        const int t = it >> 2, hh = it & 3;
        const u32x2 fw = *(const u32x2*)(HB + (size_t)t * 1024 + hh * 256 + 4 * lane), bw = *(const u32x2*)(HB + ((size_t)T_ + t) * 1024 + hh * 256 + 4 * lane);
        const f32x4 hm = (f32x4){bflo(fw.x) + bflo(bw.x), bfhi(fw.x) + bfhi(bw.x), bflo(fw.y) + bflo(bw.y), bfhi(fw.y) + bfhi(bw.y)};
        const float ss = wave_sum(hm.x * hm.x + hm.y * hm.y + hm.z * hm.z + hm.w * hm.w);
        const float rs = rsqrtf(ss * (1.0f / 256.f) + 1e-6f);
        const f32x4 hg = *(const f32x4*)(p->e_head_g + hh * 256 + 4 * lane);
        const u32x2 ob = *(const u32x2*)(Z + (size_t)t * ZC_ + 2048 + hh * 256 + 4 * lane);
        u32x2 w; w.x = pk2(hm.x * rs * hg.x * sigmoidf_(bflo(ob.x)), hm.y * rs * hg.y * sigmoidf_(bfhi(ob.x)));
        w.y = pk2(hm.z * rs * hg.z * sigmoidf_(bflo(ob.y)), hm.w * rs * hg.w * sigmoidf_(bfhi(ob.y)));
        *(u32x2*)(Y + (size_t)t * D_ + hh * 256 + 4 * lane) = w;
    }
}

__device__ __forceinline__ float gelu_tanh(float v) { const float u = 0.7978845608028654f * (v + 0.044715f * v * v * v); const float e = __expf(2.0f * u); return 0.5f * v * (1.0f + (1.0f - 2.0f * __builtin_amdgcn_rcpf(e + 1.0f))); }

__device__ __forceinline__ float softplus_neg(float v) { const float x = __expf(-v); return (x < 0.1f) ? x * (1.0f - x * (0.5f - x * (0.33333334f - x * (0.25f - x * 0.2f)))) : __logf(1.0f + x); }
template <bool FINAL>
__device__ __forceinline__ void rglru_phase(LAS unsigned char* L) { PP p = get_params();
    const int tid = l_tid(), lane = tid & 63, wid = __builtin_amdgcn_readfirstlane(tid >> 6), l15 = lane & 15, quad = lane >> 4;
    const u16* Z = (const u16*)(p->ws + OFF_BIG);
    const u16* WRG = (const u16*)(p->ws + OFF_WRG);
    float2* SUM = (float2*)(p->ws + OFF_RGSUM);
    const float* CAR = (const float*)(p->ws + OFF_RGCAR);
    u16* Y = (u16*)(p->ws + OFF_XN);
    const int cgp = tid & 15, tq = tid >> 4;
    for (int grp = l_bid(); grp < 256; grp += l_nblk()) {
        const int b = grp >> 5, n = (grp >> 2) & 7, seg = grp & 3;
        const size_t tok0 = (size_t)b * S_;
        const int chb = n * 128 + 8 * cgp, ch0 = n * 128 + 16 * wid + 4 * quad;
        __syncthreads();
        LAS float* CW = (LAS float*)(L + 34816);
        for (int i = tid; i < 640; i += 512) { const int j = i >> 7, c = i & 127; CW[i] = (j < 4) ? p->e_conv_w[j * 1024 + n * 128 + c] : p->e_conv_b[n * 128 + c]; }
        LAS float* CB2 = CW + 640;
        for (int i = tid; i < 768; i += 512) { const int dir = i / 384, k = (i % 384) >> 7, c = i & 127; const int gi = dir * 1024 + n * 128 + c;
            CB2[i] = (k == 0) ? p->e_rg_ba[gi] : (k == 1) ? p->e_rg_bx[gi] : (-8.0f * softplus_neg(p->e_rg_lam[gi])); }
        u32x4 pre[5];
#define RG_ISSUE(tile_) do { _Pragma("unroll") for (int j = 0; j < 5; ++j) { const int pos = 64 * (tile_) + 2 * tq - 2 + j; pre[j] = (u32x4){0u, 0u, 0u, 0u}; \
            if (pos >= 0 && pos < S_) pre[j] = *(const u32x4*)(Z + (tok0 + pos) * ZC_ + 3072 + chb); } } while (0)
        RG_ISSUE(seg * 16);
        __syncthreads();
        for (int i = 0; i < 16; ++i) {
            const int tile = seg * 16 + i;
            LAS unsigned char* Xb = L + (i & 1) * 17408;
#pragma unroll
            for (int hh = 0; hh < 2; ++hh) { const int tl = 2 * tq + hh;
                float acc[8];
                { const f32x4 c0 = *(LAS f32x4*)(CW + 512 + 8 * cgp), c1 = *(LAS f32x4*)(CW + 512 + 8 * cgp + 4);
                  acc[0] = c0.x; acc[1] = c0.y; acc[2] = c0.z; acc[3] = c0.w; acc[4] = c1.x; acc[5] = c1.y; acc[6] = c1.z; acc[7] = c1.w; }
#pragma unroll
                for (int j = 0; j < 4; ++j) { const u32x4 v = pre[hh + j]; const f32x4 w0 = *(LAS f32x4*)(CW + j * 128 + 8 * cgp), w1 = *(LAS f32x4*)(CW + j * 128 + 8 * cgp + 4);
                    acc[0] += bflo(v.x) * w0.x; acc[1] += bfhi(v.x) * w0.y; acc[2] += bflo(v.y) * w0.z; acc[3] += bfhi(v.y) * w0.w;
                    acc[4] += bflo(v.z) * w1.x; acc[5] += bfhi(v.z) * w1.y; acc[6] += bflo(v.w) * w1.z; acc[7] += bfhi(v.w) * w1.w; }
                u32x4 o; o.x = pk2(acc[0], acc[1]); o.y = pk2(acc[2], acc[3]); o.z = pk2(acc[4], acc[5]); o.w = pk2(acc[6], acc[7]);
                *(LAS u32x4*)(Xb + (16 * (tl & 3) + (tl >> 2)) * 272 + cgp * 16) = o; }
            __syncthreads();
            if (i + 1 < 16) RG_ISSUE(tile + 1);
            float cin[2][4];
            if (FINAL) {
#pragma unroll
                for (int dir = 0; dir < 2; ++dir) { const f32x4 c4 = *(const f32x4*)(CAR + ((size_t)((b * 64 + tile) * 2 + dir)) * 1024 + ch0); cin[dir][0] = c4.x; cin[dir][1] = c4.y; cin[dir][2] = c4.z; cin[dir][3] = c4.w; }
            }
            float hsum[4][4];
#pragma unroll
            for (int tt = 0; tt < 4; ++tt)
#pragma unroll
                for (int jj = 0; jj < 4; ++jj) hsum[tt][jj] = 0.f;
#pragma unroll
            for (int dir = 0; dir < 2; ++dir) {
                bf16x8 wa[4], wx[4];
                {   const u16* wb = WRG + (size_t)(((dir * 2 + 0) * 8) + n) * 16384 + (16 * wid + l15) * 128 + 8 * quad;
#pragma unroll
                    for (int ks = 0; ks < 4; ++ks) { wa[ks] = *(const bf16x8*)(wb + 32 * ks); wx[ks] = *(const bf16x8*)(wb + (size_t)8 * 16384 + 32 * ks); } }
                const f32x4 ba4v = *(LAS f32x4*)(CB2 + dir * 384 + 16 * wid + 4 * quad), bx4v = *(LAS f32x4*)(CB2 + dir * 384 + 128 + 16 * wid + 4 * quad), cf4v = *(LAS f32x4*)(CB2 + dir * 384 + 256 + 16 * wid + 4 * quad);
                float av[4][4], uv[4][4];
#pragma unroll
                for (int tt = 0; tt < 4; ++tt) {
                    f32x4 pa = (f32x4){0.f, 0.f, 0.f, 0.f}, px = (f32x4){0.f, 0.f, 0.f, 0.f};
#pragma unroll
                    for (int ks = 0; ks < 4; ++ks) { const bf16x8 xf = lds_r8(Xb + (16 * tt + l15) * 272 + (32 * ks + 8 * quad) * 2); pa = MFMA16(wa[ks], xf, pa); px = MFMA16(wx[ks], xf, px); }
                    const u32x2 xc = *(LAS u32x2*)(Xb + (16 * tt + l15) * 272 + (16 * wid + 4 * quad) * 2);
                    const float xv[4] = {bflo(xc.x), bfhi(xc.x), bflo(xc.y), bfhi(xc.y)};
#pragma unroll
                    for (int jj = 0; jj < 4; ++jj) { const float rr = sigmoidf_(pa[jj] + ba4v[jj]), ii = sigmoidf_(px[jj] + bx4v[jj]); const float la = cf4v[jj] * rr, x2 = 2.0f * la;
                        const float em = -x2 * (1.0f + x2 * (0.5f + x2 * (0.16666667f + x2 * (0.041666668f + x2 * 0.0083333333f))));
                        av[tt][jj] = __expf(la); uv[tt][jj] = __builtin_amdgcn_sqrtf(fmaxf(em, 0.f)) * ii * xv[jj]; }
                }
#pragma unroll
                for (int jj = 0; jj < 4; ++jj) {
                    const float a0 = av[dir ? 3 : 0][jj], a1 = av[dir ? 2 : 1][jj], a2 = av[dir ? 1 : 2][jj], a3 = av[dir ? 0 : 3][jj];
                    const float u0 = uv[dir ? 3 : 0][jj], u1 = uv[dir ? 2 : 1][jj], u2 = uv[dir ? 1 : 2][jj], u3 = uv[dir ? 0 : 3][jj];
                    float A = a0 * a1 * a2 * a3, U = ((u0 * a1 + u1) * a2 + u2) * a3 + u3;
#pragma unroll
                    for (int d = 1; d < 16; d <<= 1) {
                        const float Ap = dir ? __shfl_down(A, d, 16) : __shfl_up(A, d, 16), Up = dir ? __shfl_down(U, d, 16) : __shfl_up(U, d, 16);
                        const bool ok = dir ? (l15 + d < 16) : (l15 >= d);
                        if (ok) { U = A * Up + U; A = A * Ap; } }
                    if (FINAL) {
                        float Ae = dir ? __shfl_down(A, 1, 16) : __shfl_up(A, 1, 16), Ue = dir ? __shfl_down(U, 1, 16) : __shfl_up(U, 1, 16);
                        const bool edge = dir ? (l15 == 15) : (l15 == 0);
                        if (edge) { Ae = 1.f; Ue = 0.f; }
                        const float hin = Ae * cin[dir][jj] + Ue;
                        const float h0 = a0 * hin + u0, h1 = a1 * h0 + u1, h2 = a2 * h1 + u2, h3 = a3 * h2 + u3;
                        hsum[dir ? 3 : 0][jj] += h0; hsum[dir ? 2 : 1][jj] += h1; hsum[dir ? 1 : 2][jj] += h2; hsum[dir ? 0 : 3][jj] += h3;
                    } else {
                        const int el = dir ? 0 : 15;
                        if (l15 == el) SUM[((size_t)((b * 64 + tile) * 2 + dir)) * 1024 + ch0 + jj] = make_float2(A, U);
                    }
                }
            }
            if (FINAL) {
                u32x2 gr[4];
#pragma unroll
                for (int tt = 0; tt < 4; ++tt) gr[tt] = *(const u32x2*)(Z + (tok0 + 64 * tile + 4 * l15 + tt) * ZC_ + 4096 + ch0);
#pragma unroll
                for (int tt = 0; tt < 4; ++tt) { const int t = 64 * tile + 4 * l15 + tt;
                    u32x2 w; w.x = pk2(hsum[tt][0] * gelu_tanh(bflo(gr[tt].x)), hsum[tt][1] * gelu_tanh(bfhi(gr[tt].x))); w.y = pk2(hsum[tt][2] * gelu_tanh(bflo(gr[tt].y)), hsum[tt][3] * gelu_tanh(bfhi(gr[tt].y)));
                    *(u32x2*)(Y + (tok0 + t) * D_ + 1024 + ch0) = w; }
            }
        }
        __syncthreads();
#undef RG_ISSUE
    }
}

__device__ __forceinline__ void rglru_carry_phase() { PP p = get_params();
    const int tid = l_tid(), lane = tid & 63, wid = tid >> 6;
    const float2* SUM = (const float2*)(p->ws + OFF_RGSUM);
    float* CAR = (float*)(p->ws + OFF_RGCAR);
    if (wid == 0) {
        for (int chain = l_bid() * 64 + lane; chain < 16384; chain += l_nblk() * 64) {
            const int ch = chain & 1023, dir = (chain >> 10) & 1, b = chain >> 11;
            float h = 0.f;
#pragma unroll 8
            for (int k = 0; k < 64; ++k) { const int tile = dir ? (63 - k) : k; const size_t idx = ((size_t)((b * 64 + tile) * 2 + dir)) * 1024 + ch;
                const float2 s = SUM[idx]; CAR[idx] = h; h = s.x * h + s.y; }
        }
    }
}

struct AttnItem { int g, head, b, dil, sp, r, nb; };
__device__ __forceinline__ AttnItem attn_decode(int it0, int nblk) {
    int item = it0;
    if (nblk == 256) { const int k = it0 >> 8, w = it0 & 255, xcd = w & 7, slot = w >> 3; item = (((k / 3) * 8 + xcd) * 3 + (k % 3)) * 32 + slot; }
    AttnItem a; const int blk32 = item & 31, bh = item / 96; a.g = (item >> 5) % 3; a.head = bh & 15; a.b = bh >> 4;
    const int lg = 2 * a.g; a.dil = 1 << lg; a.sp = S_ >> lg; a.r = blk32 & (a.dil - 1); a.nb = blk32 >> lg;
    return a;
}
__device__ __forceinline__ void attn_phase(LAS unsigned char* L) { PP p = get_params();
    const int tid = l_tid(), lane = tid & 63, wid = __builtin_amdgcn_readfirstlane(tid >> 6), l15 = lane & 15, quad = lane >> 4;
    const u16* QKV = (const u16*)(p->ws + OFF_BIG);
    float* LSE = (float*)(p->ws + OFF_LSE);
    constexpr int KS = 0, VS = 65536;
    constexpr float SCALE = 0.08838834764831845f;
    const int pc = tid & 15, rb = tid >> 4;
    const int nblk = l_nblk();
    bf16x8 qf[4];
#define ATT_DMA(A_, which, BASE, ISV) do { _Pragma("unroll") for (int it = 0; it < 8; ++it) { const int lam = rb + 32 * it, x_ = lam & 15; \
        const int lr = (ISV) ? ((lam & ~15) + 8 * ((x_ >> 2) & 1) + 4 * (x_ >> 3) + (x_ & 3)) : lam; \
        const int cx = (ISV) ? (((lam & 3) << 2) | ((lam >> 2) & 3)) : x_; \
        const int i = 128 * (A_).nb - 64 + lr; const int ic = i < 0 ? 0 : (i >= (A_).sp ? (A_).sp - 1 : i);     \
        const unsigned bo_ = ((unsigned)(((which) * 128 + (A_).b * 16 + (A_).head) * S_ + (A_).r + ic * (A_).dil) * 128u + (unsigned)(8 * (pc ^ cx))) * 2u; \
        __builtin_amdgcn_global_load_lds((const unsigned*)((const char*)QKV + bo_), (LAS unsigned*)(L + (BASE) + (4 * wid + 32 * it) * 256), 16, 0, 0); } } while (0)
#define ATT_LOADQ(A_) do { const unsigned qb_ = ((unsigned)(((A_).b * 16 + (A_).head) * S_ + (A_).r + (128 * (A_).nb + 16 * wid + l15) * (A_).dil) * 128u + (unsigned)(8 * quad)) * 2u; \
        _Pragma("unroll") for (int ks = 0; ks < 4; ++ks) qf[ks] = *(const bf16x8*)((const char*)QKV + qb_ + 64 * ks); } while (0)
    int it0 = l_bid();
    AttnItem cur = attn_decode(it0 < 12288 ? it0 : 0, nblk);
    __syncthreads();
    if (it0 < 12288) { ATT_DMA(cur, 1, KS, 0); ATT_LOADQ(cur); }
    u32x2 pend[8]; u16* pend_ptr = nullptr; float pend_lse = 0.f; float* pend_lse_ptr = nullptr; bool have_pend = false;
    for (; it0 < 12288; it0 += nblk) {
        asm volatile("s_waitcnt vmcnt(0)" ::: "memory");
        __syncthreads();
        ATT_DMA(cur, 2, VS, 1);
        if (have_pend) {
#pragma unroll
            for (int dt = 0; dt < 8; ++dt) *(u32x2*)(pend_ptr + 16 * dt) = pend[dt];
            if (quad == 0) *pend_lse_ptr = pend_lse;
        }
        const int qi = 128 * cur.nb + 16 * wid + l15;
        const size_t qrow = (size_t)cur.b * S_ + cur.r + (size_t)qi * cur.dil;
        f32x4 sacc[9];
#pragma unroll
        for (int kt = 0; kt < 9; ++kt) { sacc[kt] = (f32x4){0.f, 0.f, 0.f, 0.f};
#pragma unroll
            for (int ks = 0; ks < 4; ++ks) { const bf16x8 kf = lds_r8(L + KS + (16 * wid + 16 * kt + l15) * 256 + (((4 * ks + quad) ^ l15) << 4)); sacc[kt] = MFMA16(kf, qf[ks], sacc[kt]); }
            if (kt % 3 == 2) __builtin_amdgcn_sched_barrier(0); }
        const float pen2 = exp2f(-0.5f * (float)(cur.head + 1)) * (float)cur.dil * 1.4426950408889634f, sc2 = SCALE * 1.4426950408889634f;
        float mx = -1e30f;
        int rel0 = 4 * quad - l15; asm volatile("" : "+v"(rel0));
        const float relf = (float)rel0;
        const bool seq_edge = (cur.nb == 0) || (cur.nb == (cur.sp >> 7) - 1);
        if (seq_edge) {
#pragma unroll
            for (int kt = 0; kt < 9; ++kt)
#pragma unroll
                for (int jj = 0; jj < 4; ++jj) { const int rel = 16 * kt + jj - 64 + rel0, ki = qi + rel; const int arel = rel < 0 ? -rel : rel;
                    const bool valid = (arel <= 64) && (ki >= 0) && (ki < cur.sp);
                    const float sc = valid ? (sacc[kt][jj] * sc2 - pen2 * (float)arel) : -1e30f; sacc[kt][jj] = sc; mx = fmaxf(mx, sc); }
        } else {
#pragma unroll
            for (int kt = 0; kt < 9; ++kt)
#pragma unroll
                for (int jj = 0; jj < 4; ++jj) { const float rr = relf + (float)(16 * kt + jj - 64);
                    float sc = __builtin_fmaf(sacc[kt][jj], sc2, -(pen2 * fabsf(rr)));
                    if (kt == 0) sc = (rel0 + jj >= 0) ? sc : -1e30f;
                    if (kt == 8) sc = (rel0 + jj <= 0) ? sc : -1e30f;
                    sacc[kt][jj] = sc; mx = fmaxf(mx, sc); }
        }
        mx = fmaxf(mx, __shfl_xor(mx, 16)); mx = fmaxf(mx, __shfl_xor(mx, 32));
        float lsum = 0.f;
#pragma unroll
        for (int kt = 0; kt < 9; ++kt)
#pragma unroll
            for (int jj = 0; jj < 4; ++jj) { const float pv = __builtin_amdgcn_exp2f(sacc[kt][jj] - mx); sacc[kt][jj] = pv; lsum += pv; }
        lsum += __shfl_xor(lsum, 16); lsum += __shfl_xor(lsum, 32);
        bf16x8 pf[5];
#pragma unroll
        for (int i = 0; i < 5; ++i) { u32x4 t; t.x = pk2(sacc[2 * i][0], sacc[2 * i][1]); t.y = pk2(sacc[2 * i][2], sacc[2 * i][3]);
            if (i < 4) { t.z = pk2(sacc[2 * i + 1][0], sacc[2 * i + 1][1]); t.w = pk2(sacc[2 * i + 1][2], sacc[2 * i + 1][3]); } else { t.z = 0u; t.w = 0u; }
            pf[i] = as_bf16x8(t); }
        asm volatile("s_waitcnt vmcnt(0)" ::: "memory");
        __syncthreads();
        const AttnItem cur0 = cur;
        if (it0 + nblk < 12288) { cur = attn_decode(it0 + nblk, nblk); ATT_DMA(cur, 1, KS, 0); ATT_LOADQ(cur); }
        f32x4 oacc[8];
        const int vrow = 16 * wid + 8 * (quad & 1) + 4 * (quad >> 1) + (l15 >> 2), vx = ((l15 >> 2) << 2) | ((2 * (quad & 1) + (quad >> 1)) & 3);
#pragma unroll
        for (int dt = 0; dt < 8; ++dt) { oacc[dt] = (f32x4){0.f, 0.f, 0.f, 0.f};
#pragma unroll
            for (int i = 0; i < 5; ++i) {
                const int vch = ((2 * dt + ((l15 & 3) >> 1)) ^ vx) * 16 + 8 * (l15 & 1);
                const bf16x4 lo = lds_tr(L + VS + 256 * (vrow + 32 * i) + vch);
                bf16x4 hi = (bf16x4){0, 0, 0, 0};
                if (i < 4) hi = lds_tr(L + VS + 256 * (vrow + 32 * i + 16) + vch);
                oacc[dt] = MFMA16(cat8(lo, hi), pf[i], oacc[dt]); }
            if (dt & 1) __builtin_amdgcn_sched_barrier(0); }
        const float inv = 1.0f / lsum;
        u16* OB = (cur0.g < 2) ? ((u16*)(p->out) + (size_t)cur0.g * T_ * D_) : (u16*)(p->ws + OFF_XN);
        pend_ptr = OB + qrow * D_ + cur0.head * 128 + 4 * quad;
#pragma unroll
        for (int dt = 0; dt < 8; ++dt) { pend[dt].x = pk2(oacc[dt][0] * inv, oacc[dt][1] * inv); pend[dt].y = pk2(oacc[dt][2] * inv, oacc[dt][3] * inv); }
        pend_lse = (mx + __log2f(lsum)) * 0.6931471805599453f; pend_lse_ptr = LSE + ((size_t)cur0.g * T_ + qrow) * 16 + cur0.head; have_pend = true;
    }
    if (have_pend) {
#pragma unroll
        for (int dt = 0; dt < 8; ++dt) *(u32x2*)(pend_ptr + 16 * dt) = pend[dt];
        if (quad == 0) *pend_lse_ptr = pend_lse;
    }
    __syncthreads();
#undef ATT_DMA
#undef ATT_LOADQ
}

__device__ __forceinline__ void attn_merge_phase() { PP p = get_params();
    const u16* O0 = (const u16*)(p->out); const u16* O1 = O0 + (size_t)T_ * D_; u16* O2 = (u16*)(p->ws + OFF_XN);
    const float* LSE = (const float*)(p->ws + OFF_LSE);
    for (size_t gi = (size_t)l_bid() * 512 + l_tid(); gi < (size_t)T_ * 256; gi += (size_t)l_nblk() * 512) {
        const size_t t = gi >> 8; const int c8 = (int)(gi & 255), head = c8 >> 4;
        const float l0 = LSE[t * 16 + head], l1 = LSE[((size_t)T_ + t) * 16 + head], l2 = LSE[((size_t)2 * T_ + t) * 16 + head];
        const float mx = fmaxf(l0, fmaxf(l1, l2));
        float w0 = __expf(l0 - mx), w1 = __expf(l1 - mx), w2 = __expf(l2 - mx); const float inv = 1.0f / (w0 + w1 + w2); w0 *= inv; w1 *= inv; w2 *= inv;
        const u32x4 a = *(const u32x4*)(O0 + t * D_ + 8 * c8), bq = *(const u32x4*)(O1 + t * D_ + 8 * c8), c = *(const u32x4*)(O2 + t * D_ + 8 * c8);
        u32x4 o;
        o.x = pk2(w0 * bflo(a.x) + w1 * bflo(bq.x) + w2 * bflo(c.x), w0 * bfhi(a.x) + w1 * bfhi(bq.x) + w2 * bfhi(c.x));
        o.y = pk2(w0 * bflo(a.y) + w1 * bflo(bq.y) + w2 * bflo(c.y), w0 * bfhi(a.y) + w1 * bfhi(bq.y) + w2 * bfhi(c.y));
        o.z = pk2(w0 * bflo(a.z) + w1 * bflo(bq.z) + w2 * bflo(c.z), w0 * bfhi(a.z) + w1 * bfhi(bq.z) + w2 * bfhi(c.z));
        o.w = pk2(w0 * bflo(a.w) + w1 * bflo(bq.w) + w2 * bflo(c.w), w0 * bfhi(a.w) + w1 * bfhi(bq.w) + w2 * bfhi(c.w));
        *(u32x4*)(O2 + t * D_ + 8 * c8) = o;
    }
}

#define XB_TMO      128
#define XB_XCNT(j)  (256  + 64 * (j))
#define XB_XSUB(j)  (1280 + 64 * (j))
#define XB_XGEN(j)  (2304 + 64 * (j))
#define XB_TOP      3328
#define XB_TOPGEN   3392
#define XCD_BAR_WORDS 3456
#define XB_SPIN_CAP (1u << 18)
__device__ __forceinline__ unsigned xb_ld(unsigned* p)              { return __hip_atomic_load(p, __ATOMIC_RELAXED, __HIP_MEMORY_SCOPE_AGENT); }
__device__ __forceinline__ unsigned xb_add(unsigned* p, unsigned v) { return __hip_atomic_fetch_add(p, v, __ATOMIC_RELAXED, __HIP_MEMORY_SCOPE_AGENT); }
__device__ __forceinline__ unsigned xb_xcc_id() { return (unsigned)__builtin_amdgcn_s_getreg((3 << 11) | 20) & 0xFu; }
#define XB_SPIN(cond, bar) do { unsigned _sp = 0; while (cond) { __builtin_amdgcn_s_sleep(1); \
    if ((++_sp & 255u) == 0u) { if (xb_ld(&(bar)[XB_TMO])) break; if (_sp > XB_SPIN_CAP) { atomicAdd(&(bar)[XB_TMO], 1u); break; } } } } while (0)

struct XcdBarrier {
    unsigned* bar; unsigned x;
    volatile LAS unsigned* st;
};

__device__ __forceinline__ XcdBarrier xcd_barrier_post(unsigned* bar, volatile LAS unsigned* st) {
    XcdBarrier b; b.bar = bar; b.x = xb_xcc_id(); b.st = st;
    if (threadIdx.x == 0) (void)xb_add(&bar[XB_XCNT(b.x)], 1u);
    return b;
}
__device__ __forceinline__ void xcd_barrier_complete(unsigned* bar, unsigned x, unsigned& nloc, unsigned& nx) {
    const unsigned G = gridDim.x * gridDim.y * gridDim.z;
    unsigned sum, cnt, mine, sp = 0u;
    for (;;) {
        sum = 0u; cnt = 0u; mine = 0u;
#pragma unroll
        for (unsigned j = 0; j < 16; ++j) { const unsigned c = xb_ld(&bar[XB_XCNT(j)]); sum += c; cnt += (c > 0u) ? 1u : 0u; mine = (j == x) ? c : mine; }
        if (sum == G) break;
        __builtin_amdgcn_s_sleep(1);
        if ((++sp & 255u) == 0u) { if (xb_ld(&bar[XB_TMO])) break; if (sp > XB_SPIN_CAP) { atomicAdd(&bar[XB_TMO], 1u); break; } }
    }
    nloc = mine > 0u ? mine : 1u; nx = cnt > 0u ? cnt : 1u;
}

__device__ __forceinline__ void xcd_barrier(const XcdBarrier& b) {
    asm volatile("s_waitcnt vmcnt(0)" ::: "memory");
    __syncthreads();
    if (threadIdx.x == 0) {
        unsigned* bar = b.bar;
        __builtin_amdgcn_s_waitcnt(0);
        unsigned nloc = b.st[0], nx = b.st[1];
        if (nloc == 0u) { xcd_barrier_complete(bar, b.x, nloc, nx); b.st[0] = nloc; b.st[1] = nx; }
        const unsigned old = xb_add(&bar[XB_XSUB(b.x)], 1u);
        const unsigned gen = old / nloc;
        if (old + 1u == (gen + 1u) * nloc) {
            __builtin_amdgcn_fence(__ATOMIC_RELEASE, "agent");
            asm volatile("s_waitcnt vmcnt(0)" ::: "memory");
            const unsigned og = xb_add(&bar[XB_TOP], 1u);
            const unsigned tg = og / nx;
            if (og + 1u == (tg + 1u) * nx) xb_add(&bar[XB_TOPGEN], 1u);
            else XB_SPIN(xb_ld(&bar[XB_TOPGEN]) == tg, bar);
            __builtin_amdgcn_fence(__ATOMIC_ACQUIRE, "agent");
            xb_add(&bar[XB_XGEN(b.x)], 1u);
            asm volatile("s_waitcnt vmcnt(0)" ::: "memory");
        } else {
            XB_SPIN(xb_ld(&bar[XB_XGEN(b.x)]) == gen, bar);
            __builtin_amdgcn_fence(__ATOMIC_ACQUIRE, "agent");
            asm volatile("s_waitcnt vmcnt(0)" ::: "memory");
        }
    }
    __syncthreads();
}


template <class Epi>
__device__ __forceinline__ void run_gemm(LAS unsigned char* L, const u16* A, const u16* Bt, int N, int K, const Epi& E) {
    pg8::Gemm g; g.A = A; g.Bt = Bt; g.M = T_; g.N = N; g.K = K;
    pg8::StaticOrder S; S.init(T_, N, l_nblk(), l_bid());
    pg8::gemm_phase<Epi, pg8::StaticOrder, false>(L, g, S, E, nullptr);
}
__device__ __forceinline__ void gemm_zin(LAS unsigned char* L) { PP p = get_params(); unsigned char* ws = p->ws;
    run_gemm(L, (const u16*)(ws + OFF_XN), (const u16*)(ws + OFF_WIN), ZC_, D_, pg8::EpiStoreBf16{(u16*)(ws + OFF_BIG), ZC_, nullptr, 0}); }
__device__ __forceinline__ void gemm_qkv(LAS unsigned char* L) { PP p = get_params(); unsigned char* ws = p->ws;
    run_gemm(L, (const u16*)(ws + OFF_MIX), (const u16*)(ws + OFF_WQKV), QC_, D_, pg8::EpiStoreBf16{(u16*)(ws + OFF_BIG), QC_, (const float*)(ws + OFF_SS) + T_, 1}); }
__device__ __forceinline__ void gemm_res0(LAS unsigned char* L) { PP p = get_params(); unsigned char* ws = p->ws;
    run_gemm(L, (const u16*)(ws + OFF_XN), (const u16*)(ws + OFF_WOUT), D_, D_,
             pg8::EpiRes<false, false, true>{(const void*)p->x, nullptr, (u16*)(ws + OFF_MIX), (float*)(ws + OFF_SS), D_}); }
__device__ __forceinline__ void gemm_res1(LAS unsigned char* L) { PP p = get_params(); unsigned char* ws = p->ws;
    run_gemm(L, (const u16*)(ws + OFF_XN), (const u16*)(ws + OFF_WO), D_, D_,
             pg8::EpiRes<true, false, true>{(const void*)(ws + OFF_MIX), nullptr, (u16*)(ws + OFF_MIX), (float*)(ws + OFF_SS) + 2 * T_, D_}); }
__device__ __forceinline__ void gemm_up(LAS unsigned char* L, int l) { PP p = get_params(); unsigned char* ws = p->ws;
    run_gemm(L, (const u16*)(ws + OFF_MIX), (const u16*)(ws + OFF_W13) + (size_t)l * 2 * DFF_ * D_, 2 * DFF_, D_, pg8::EpiSwiGLU{(u16*)(ws + OFF_BIG), DFF_, (const float*)(ws + OFF_SS) + (l ? 2 * T_ : 0)}); }
__device__ __forceinline__ void gemm_down0(LAS unsigned char* L) { PP p = get_params(); unsigned char* ws = p->ws;
    run_gemm(L, (const u16*)(ws + OFF_BIG), (const u16*)(ws + OFF_W2), D_, DFF_,
             pg8::EpiRes<true, false, true>{(const void*)(ws + OFF_MIX), nullptr, (u16*)(ws + OFF_MIX), (float*)(ws + OFF_SS) + T_, D_}); }
__device__ __forceinline__ void gemm_down1(LAS unsigned char* L) { PP p = get_params(); unsigned char* ws = p->ws;
    run_gemm(L, (const u16*)(ws + OFF_BIG), (const u16*)(ws + OFF_W2) + (size_t)D_ * DFF_, D_, DFF_,
             pg8::EpiRes<true, false, true>{(const void*)(ws + OFF_MIX), nullptr, (u16*)(ws + OFF_MIX), (float*)(ws + OFF_SS) + 3 * T_, D_}); }
__device__ __forceinline__ void norm_final() { PP p = get_params();
    const u16* XBp = (const u16*)(p->ws + OFF_MIX); const float* ss = (const float*)(p->ws + OFF_SS) + 3 * T_; float* out = p->out; const float* g = p->final_norm;
    for (size_t gi = (size_t)l_bid() * 512 + l_tid(); gi < (size_t)T_ * 256; gi += (size_t)l_nblk() * 512) {
        const size_t t = gi >> 8; const int c8 = (int)(gi & 255);
        const float rs = rsqrtf(ss[t] * (1.0f / D_) + 1e-6f);
        const u32x4 w = *(const u32x4*)(XBp + t * D_ + 8 * c8);
        const f32x4 g0 = *(const f32x4*)(g + 8 * c8), g1 = *(const f32x4*)(g + 8 * c8 + 4);
        f32x4 o0, o1;
        o0.x = bflo(w.x) * rs * g0.x; o0.y = bfhi(w.x) * rs * g0.y; o0.z = bflo(w.y) * rs * g0.z; o0.w = bfhi(w.y) * rs * g0.w;
        o1.x = bflo(w.z) * rs * g1.x; o1.y = bfhi(w.z) * rs * g1.y; o1.z = bflo(w.w) * rs * g1.z; o1.w = bfhi(w.w) * rs * g1.w;
        *(f32x4*)(out + t * D_ + 8 * c8) = o0; *(f32x4*)(out + t * D_ + 8 * c8 + 4) = o1;
    }
}

__global__ __launch_bounds__(512, 2) void mega_fwd(Params pdummy) {
    LAS unsigned char* L = (LAS unsigned char*)lds_raw;
    cg::grid_group grid = cg::this_grid();
    volatile LAS unsigned* xst = (volatile LAS unsigned*)(L + LDS_MAIN);
    if (threadIdx.x < 4) xst[threadIdx.x] = (threadIdx.x == 2) ? blockIdx.x : 0u;
    __syncthreads();
    unsigned* barw = (unsigned*)(get_params()->ws + OFF_BAR);
    XcdBarrier xb = xcd_barrier_post(barw, xst);
    if (threadIdx.x == 0) xst[3] = xb_add(&barw[3520 + 64 * xb.x], 1u);
    phase0(L);
    grid.sync();
    if (threadIdx.x == 0) {
        bool ok = (gridDim.x == 256) && (xb.x < 8u);
        for (int j = 0; j < 8; ++j) ok = ok && (xb_ld(&barw[3520 + 64 * j]) == 32u);
        if (ok) xst[2] = xst[3] * 8u + xb.x;
    }
    __syncthreads();
    gemm_zin(L);
    xcd_barrier(xb);
    mlstm_phase(L);
    __builtin_amdgcn_fence(__ATOMIC_ACQUIRE, "agent"); asm volatile("s_waitcnt vmcnt(0)" ::: "memory"); __syncthreads();
    rglru_phase<false>(L);
    xcd_barrier(xb);
    rglru_carry_phase();
    __builtin_amdgcn_fence(__ATOMIC_ACQUIRE, "agent"); asm volatile("s_waitcnt vmcnt(0)" ::: "memory"); __syncthreads();
    mlstm_combine_phase();
    xcd_barrier(xb);
    rglru_phase<true>(L);
    xcd_barrier(xb);
    gemm_res0(L);
    xcd_barrier(xb);
    gemm_up(L, 0);
    xcd_barrier(xb);
    gemm_down0(L);
    xcd_barrier(xb);
    gemm_qkv(L);
    xcd_barrier(xb);
    attn_phase(L);
    xcd_barrier(xb);
    attn_merge_phase();
    xcd_barrier(xb);
    gemm_res1(L);
    xcd_barrier(xb);
    gemm_up(L, 1);
    xcd_barrier(xb);
    gemm_down1(L);
    xcd_barrier(xb);
    norm_final();
}

extern "C" void kernel_launch(void* const* d_in, const int* in_sizes, int n_in, void* d_out, int out_size, void* d_ws, size_t ws_size, hipStream_t stream) {
    static int grid_blocks = 0;
    if (!grid_blocks) {
        int dev = 0, cus = 0, per_cu = 0;
        hipGetDevice(&dev);
        hipDeviceGetAttribute(&cus, hipDeviceAttributeMultiprocessorCount, dev);
        hipFuncSetAttribute((const void*)mega_fwd, hipFuncAttributeMaxDynamicSharedMemorySize, LDS_BYTES);
        hipOccupancyMaxActiveBlocksPerMultiprocessor(&per_cu, (const void*)mega_fwd, 512, LDS_BYTES);
        if (per_cu < 1) per_cu = 1;
        grid_blocks = cus * per_cu;
        if (ws_size < WS_END) fprintf(stderr, "workspace too small: %zu < %zu\n", ws_size, (size_t)WS_END);
    }
    Params p; memset(&p, 0, sizeof(p));
    const float** ptrs = (const float**)&p;
    for (int i = 0; i < 21; ++i) ptrs[i] = (const float*)d_in[i];
    p.out = (float*)d_out; p.ws = (unsigned char*)d_ws;
    unsigned char* ws = (unsigned char*)d_ws;
    int ns = 0, tot = 0;
    auto add = [&](const float* src, size_t dst_off, int ld, int K, int N, int mode, int rowoff, const float* gain) {
        Seg& s = p.seg[ns++]; s.src = src; s.dst = (u16*)(ws + dst_off); s.gain = gain; s.ld = ld; s.K = K; s.nN32 = N / 32; s.mode = mode; s.rowoff = rowoff; s.ntiles = (K / 64) * (N / 32); tot += s.ntiles; };
    add(p.e_w_in, OFF_WIN, DIN_, D_, 3072, 0, 0, nullptr);
    add(p.e_w_in + 3088, OFF_WIN, DIN_, D_, 2048, 0, 3072, nullptr);
    add(p.e_w_out, OFF_WOUT, D_, D_, D_, 0, 0, nullptr);
    add(p.o_w_qkv, OFF_WQKV, QC_, D_, QC_, 0, 0, p.o_norm);
    add(p.o_w_o, OFF_WO, D_, D_, D_, 0, 0, nullptr);
    for (int l = 0; l < 2; ++l) {
        add(p.f_w1 + (size_t)l * D_ * DFF_, OFF_W13 + l * SZ_W13, DFF_, D_, DFF_, 1, 0, p.f_norm + l * D_);
        add(p.f_w3 + (size_t)l * D_ * DFF_, OFF_W13 + l * SZ_W13, DFF_, D_, DFF_, 1, 128, p.f_norm + l * D_);
        add(p.f_w2 + (size_t)l * DFF_ * D_, OFF_W2 + l * SZ_W2, D_, DFF_, D_, 0, 0, nullptr);
    }
    p.nseg = ns; p.total_tiles = tot;
    hipMemsetAsync((unsigned char*)d_ws + OFF_BAR, 0, 16384, stream);
    void* args[] = {&p};
    hipError_t e = hipLaunchCooperativeKernel((const void*)mega_fwd, dim3(grid_blocks), dim3(512), args, LDS_BYTES, stream);
    if (e != hipSuccess) fprintf(stderr, "cooperative launch failed: %s (grid %d)\n", hipGetErrorString(e), grid_blocks);
}
```

```cpp
#include <hip/hip_runtime.h>
#include <hip/hip_cooperative_groups.h>
#include <cstdio>
#include <cstring>
namespace cg = cooperative_groups;
namespace pg8 {
#define PG8_LAS __attribute__((address_space(3)))
typedef unsigned short bf16_t;
typedef short bf16x8 __attribute__((ext_vector_type(8)));
typedef float f32x4 __attribute__((ext_vector_type(4)));
typedef unsigned u32x4 __attribute__((ext_vector_type(4)));
constexpr int BM = 256, BK = 64, HALF = 128, HTB = HALF * BK * 2  , STAGE_BYTES = 8 * HTB, NXCD = 8, WGM = 4;

__host__ __device__ __forceinline__ int lds_byte(int r, int c) { const int st = (r >> 4) * 2 + (c >> 5), rr = r & 15, cc = c & 31, ob = rr * 64 + cc * 2; return st * 1024 + (ob ^ (((ob >> 9) & 1) << 5)); }
__host__ __device__ __forceinline__ void stage_rc(int b, int& R, int& C) { const int st = b / 1024, sb = b % 1024, swz = sb ^ (((sb >> 9) & 1) << 5); R = (st >> 1) * 16 + swz / 64; C = (st & 1) * 32 + (swz % 64) / 2; }
__host__ __device__ __forceinline__ int perm32(int rho) { const int n = rho >> 4, i = rho & 15; return 8 * (i >> 2) + 4 * n + (i & 3); }

struct Unit { int pm, pn; };
struct Gemm { const bf16_t* A; const bf16_t* Bt; int M, N, K; };

struct StaticOrder {
    int nM, nN, nwg, G, c;
    __host__ __device__ void init(int M, int N, int G_, int c_) { nM = M / BM; nN = N / BM; nwg = nM * nN; G = G_; c = c_; }
    __host__ __device__ bool next(int i, Unit& u) const {
        const long L = (long)i * G + c; if (L >= nwg) return false;
        int wgid = (int)L; { const int q = nwg / NXCD, r = nwg % NXCD, xcd = wgid % NXCD, off = wgid / NXCD; wgid = (xcd < r ? xcd * (q + 1) : r * (q + 1) + (xcd - r) * q) + off; }
        const int nig = WGM * nN, gid = wgid / nig, fm = gid * WGM, gsz = (nM - fm) < WGM ? (nM - fm) : WGM;
        u.pm = fm + ((wgid % nig) % gsz); u.pn = (wgid % nig) / gsz; return true;
    }
    __device__ __forceinline__ void a_ready(const Unit&) const {}
    __device__ __forceinline__ void done(const Unit&) const {}
};
__device__ __forceinline__ unsigned cvt_pk_bf16(float lo, float hi) { unsigned r; asm volatile("v_cvt_pk_bf16_f32 %0, %1, %2" : "=v"(r) : "v"(lo), "v"(hi)); return r; }
typedef float f32x2 __attribute__((ext_vector_type(2)));
typedef unsigned u32x4 __attribute__((ext_vector_type(4)));
typedef unsigned u32x2 __attribute__((ext_vector_type(2)));
struct EpiStoreBf16 {
    static constexpr bool PERM = true, AFTER_DRAIN = false;
    bf16_t* O; int ldc; const float* ss; int headmajor;
    __device__ __forceinline__ void operator()(const f32x4 (&acc)[2][2][4][2], const Unit& u, int wr, int wc, int fr, int fq) const {
        const int row0 = u.pm * BM + wr * 64 + fr, col0 = u.pn * BM + wc * 32 + 8 * fq;
        float rs[2][4];
#pragma unroll
        for (int ai = 0; ai < 2; ++ai)
#pragma unroll
            for (int m = 0; m < 4; ++m) rs[ai][m] = ss ? ss[row0 + ai * HALF + m * 16] : 0.f;
#pragma unroll
        for (int ai = 0; ai < 2; ++ai)
#pragma unroll
            for (int m = 0; m < 4; ++m) rs[ai][m] = ss ? rsqrtf(rs[ai][m] * (1.0f / 2048.0f) + 1e-6f) : 1.0f;
#pragma unroll
        for (int ai = 0; ai < 2; ++ai)
#pragma unroll
            for (int m = 0; m < 4; ++m) { const int row = row0 + ai * HALF + m * 16;
                bf16_t* rowp = headmajor ? O + ((size_t)((col0 >> 11) * 128 + (row >> 12) * 16 + ((col0 >> 7) & 15)) * 4096 + (row & 4095)) * 128 + (col0 & 127)
                                         : O + (size_t)row * ldc + col0;
                const size_t bjstep = headmajor ? (size_t)4096 * 128 : (size_t)HALF;
#pragma unroll
                for (int bj = 0; bj < 2; ++bj) { const f32x4 v0 = acc[ai][bj][m][0] * rs[ai][m], v1 = acc[ai][bj][m][1] * rs[ai][m];
                    u32x4 w; w.x = cvt_pk_bf16(v0[0], v0[1]); w.y = cvt_pk_bf16(v0[2], v0[3]); w.z = cvt_pk_bf16(v1[0], v1[1]); w.w = cvt_pk_bf16(v1[2], v1[3]);
                    *(u32x4*)(rowp + bj * bjstep) = w; } }
    }
};
struct EpiResF32 {
    static constexpr bool PERM = false, AFTER_DRAIN = false;
    float* C; const float* base; int ldc; bf16_t* XB; float* ss;
    __device__ __forceinline__ void operator()(const f32x4 (&acc)[2][2][4][2], const Unit& u, int wr, int wc, int fr, int fq) const {
        const int row0 = u.pm * BM + wr * 64 + fr, col0 = u.pn * BM + wc * 32 + 4 * fq;
        float sq[2][4];
#pragma unroll
        for (int ai = 0; ai < 2; ++ai)
#pragma unroll
            for (int m = 0; m < 4; ++m) sq[ai][m] = 0.f;
#pragma unroll
        for (int bj = 0; bj < 2; ++bj)
#pragma unroll
          for (int ai = 0; ai < 2; ++ai) {
            f32x4 bv[4][2];
#pragma unroll
            for (int m = 0; m < 4; ++m)
#pragma unroll
                for (int n = 0; n < 2; ++n) bv[m][n] = *(const f32x4*)(base + (size_t)(row0 + ai * HALF + m * 16) * ldc + col0 + bj * HALF + n * 16);
#pragma unroll
            for (int m = 0; m < 4; ++m)
#pragma unroll
                for (int n = 0; n < 2; ++n) { const size_t off = (size_t)(row0 + ai * HALF + m * 16) * ldc + col0 + bj * HALF + n * 16;
                    const f32x4 r = acc[ai][bj][m][n] + bv[m][n];
                    *(f32x4*)(C + off) = r;
                    if (XB) { sq[ai][m] += r[0] * r[0] + r[1] * r[1] + r[2] * r[2] + r[3] * r[3]; u32x2 w; w.x = cvt_pk_bf16(r[0], r[1]); w.y = cvt_pk_bf16(r[2], r[3]); *(u32x2*)(XB + off) = w; } }
          }
        if (XB) {
#pragma unroll
            for (int ai = 0; ai < 2; ++ai)
#pragma unroll
                for (int m = 0; m < 4; ++m) { float s = sq[ai][m]; s += __shfl_xor(s, 16); s += __shfl_xor(s, 32); if (fq == 0) unsafeAtomicAdd(ss + row0 + ai * HALF + m * 16, s); } }
    }
};
__device__ __forceinline__ float silu_mul(float a, float b) { return a * __builtin_amdgcn_rcpf(1.0f + __expf(-a)) * b; }
struct EpiSwiGLU {
    static constexpr bool PERM = true, AFTER_DRAIN = false;
    bf16_t* O; int ldc; const float* ss;
    __device__ __forceinline__ void operator()(const f32x4 (&acc)[2][2][4][2], const Unit& u, int wr, int wc, int fr, int fq) const {
        const int row0 = u.pm * BM + wr * 64 + fr, col0 = u.pn * HALF + wc * 32 + 8 * fq;
        float rs[2][4];
#pragma unroll
        for (int ai = 0; ai < 2; ++ai)
#pragma unroll
            for (int m = 0; m < 4; ++m) rs[ai][m] = ss[row0 + ai * HALF + m * 16];
#pragma unroll
        for (int ai = 0; ai < 2; ++ai)
#pragma unroll
            for (int m = 0; m < 4; ++m) rs[ai][m] = rsqrtf(rs[ai][m] * (1.0f / 2048.0f) + 1e-6f);
#pragma unroll
        for (int ai = 0; ai < 2; ++ai)
#pragma unroll
            for (int m = 0; m < 4; ++m) { bf16_t* rowp = O + (size_t)(row0 + ai * HALF + m * 16) * ldc + col0;
                const f32x4 a0 = acc[ai][0][m][0] * rs[ai][m], a1 = acc[ai][0][m][1] * rs[ai][m], b0 = acc[ai][1][m][0] * rs[ai][m], b1 = acc[ai][1][m][1] * rs[ai][m];
                u32x4 w; w.x = cvt_pk_bf16(silu_mul(a0[0], b0[0]), silu_mul(a0[1], b0[1])); w.y = cvt_pk_bf16(silu_mul(a0[2], b0[2]), silu_mul(a0[3], b0[3]));
                w.z = cvt_pk_bf16(silu_mul(a1[0], b1[0]), silu_mul(a1[1], b1[1])); w.w = cvt_pk_bf16(silu_mul(a1[2], b1[2]), silu_mul(a1[3], b1[3]));
                *(u32x4*)rowp = w; }
    }
};

template <bool BASE_BF16, bool OUT_F32, bool OUT_BF16>
struct EpiRes {
    static constexpr bool PERM = true, AFTER_DRAIN = false;
    const void* base; float* C; bf16_t* XB; float* ss; int ldc;
    __device__ __forceinline__ void operator()(const f32x4 (&acc)[2][2][4][2], const Unit& u, int wr, int wc, int fr, int fq) const {
        const int row0 = u.pm * BM + wr * 64 + fr, col0 = u.pn * BM + wc * 32 + 8 * fq;
        constexpr int NA = BASE_BF16 ? 2 : 1;
        float sq[2][4];
#pragma unroll
        for (int ai = 0; ai < 2; ++ai)
#pragma unroll
            for (int m = 0; m < 4; ++m) sq[ai][m] = 0.f;
#pragma unroll
        for (int bj = 0; bj < 2; ++bj)
#pragma unroll
          for (int a0 = 0; a0 < 2; a0 += NA) {
            u32x4 raw[NA][4]; f32x4 f0[NA][4], f1[NA][4];
#pragma unroll
            for (int da = 0; da < NA; ++da)
#pragma unroll
                for (int m = 0; m < 4; ++m) { const size_t off = (size_t)(row0 + (a0 + da) * HALF + m * 16) * ldc + col0 + bj * HALF;
                    if (BASE_BF16) raw[da][m] = *(const u32x4*)((const bf16_t*)base + off);
                    else { f0[da][m] = *(const f32x4*)((const float*)base + off); f1[da][m] = *(const f32x4*)((const float*)base + off + 4); } }
#pragma unroll
            for (int da = 0; da < NA; ++da)
#pragma unroll
                for (int m = 0; m < 4; ++m) { const int ai = a0 + da; const size_t off = (size_t)(row0 + ai * HALF + m * 16) * ldc + col0 + bj * HALF;
                    f32x4 b0, b1;
                    if (BASE_BF16) { const u32x4 w = raw[da][m];
                        b0 = (f32x4){__uint_as_float(w.x << 16), __uint_as_float(w.x & 0xffff0000u), __uint_as_float(w.y << 16), __uint_as_float(w.y & 0xffff0000u)};
                        b1 = (f32x4){__uint_as_float(w.z << 16), __uint_as_float(w.z & 0xffff0000u), __uint_as_float(w.w << 16), __uint_as_float(w.w & 0xffff0000u)}; }
                    else { b0 = f0[da][m]; b1 = f1[da][m]; }
                    const f32x4 r0 = acc[ai][bj][m][0] + b0, r1 = acc[ai][bj][m][1] + b1;
                    if (OUT_F32) { *(f32x4*)(C + off) = r0; *(f32x4*)(C + off + 4) = r1; }
                    if (OUT_BF16) { sq[ai][m] += (r0[0] * r0[0] + r0[1] * r0[1] + r0[2] * r0[2] + r0[3] * r0[3]) + (r1[0] * r1[0] + r1[1] * r1[1] + r1[2] * r1[2] + r1[3] * r1[3]);
                        u32x4 w; w.x = cvt_pk_bf16(r0[0], r0[1]); w.y = cvt_pk_bf16(r0[2], r0[3]); w.z = cvt_pk_bf16(r1[0], r1[1]); w.w = cvt_pk_bf16(r1[2], r1[3]);
                        *(u32x4*)(XB + off) = w; } }
          }
        if (OUT_BF16) {
#pragma unroll
            for (int ai = 0; ai < 2; ++ai)
#pragma unroll
                for (int m = 0; m < 4; ++m) { float s = sq[ai][m]; s += __shfl_xor(s, 16); s += __shfl_xor(s, 32); if (fq == 0) unsafeAtomicAdd(ss + row0 + ai * HALF + m * 16, s); } }
    }
};
template <class Epi, class Sched, bool STAMP = false>
__device__ __forceinline__ void gemm_phase(PG8_LAS unsigned char* lds, const Gemm g, const Sched& S, const Epi& E, unsigned long long* stamps) {
    int tid_ = threadIdx.x; asm volatile("" : "+v"(tid_)); const int tid = tid_, wid = __builtin_amdgcn_readfirstlane(tid >> 6), lane = tid & 63, wr = wid >> 2, wc = wid & 3, fr = lane & 15, fq = lane >> 4;
    const int K = g.K, nt = K / BK;
    int ts_lo = 0, ts_hi = 0, nts = 0; const unsigned long long rt_entry = STAMP ? (unsigned long long)wall_clock64() : 0ull;
#define PG8_STAMP() do { if (STAMP && wid == 0 && nts < 64) { const unsigned long long _c = (unsigned long long)clock64(); \
        ts_lo = (lane == nts) ? (int)(unsigned)_c : ts_lo; ts_hi = (lane == nts) ? (int)(unsigned)(_c >> 32) : ts_hi; ++nts; } } while (0)
    PG8_STAMP();
    unsigned voffA[2], voffB[2];
#pragma unroll
    for (int i = 0; i < 2; ++i) { int R, C; stage_rc(tid * 16 + i * 8192, R, C); const int Rb = Epi::PERM ? ((R & ~31) + perm32(R & 31)) : R;
        voffA[i] = (unsigned)(R * K + C) * 2u; voffB[i] = (unsigned)(Rb * K + C) * 2u; }
    const size_t kstep = (size_t)(BK * 2);
    const size_t hstep = (size_t)HALF * K * 2;
    const size_t tstep = 2 * hstep;
    const unsigned ldsw = (unsigned)wid * 1024u;
    const int aoff = lds_byte(wr * 64 + fr, fq * 8), boff = lds_byte(wc * 32 + fr, fq * 8);
#define PG8_SA(b, h) (((b) * 2 + (h)) * HTB)
#define PG8_SB(b, h) ((4 + (b) * 2 + (h)) * HTB)
#define PG8_STAGE(bufoff, gbase, voff) do { _Pragma("unroll") for (int _i = 0; _i < 2; ++_i) \
        __builtin_amdgcn_global_load_lds((const unsigned*)((const char*)(gbase) + (voff)[_i]), (PG8_LAS unsigned*)(lds + (bufoff) + ldsw + _i * 8192), 16, 0, 0); } while (0)
#define PG8_LDA(dst, b, h) do { _Pragma("unroll") for (int m = 0; m < 4; ++m) _Pragma("unroll") for (int k = 0; k < 2; ++k) dst[m][k] = *(const PG8_LAS bf16x8*)(lds + PG8_SA(b, h) + aoff + m * 2048 + k * 1024); } while (0)
#define PG8_LDB(dst, b, h) do { _Pragma("unroll") for (int n = 0; n < 2; ++n) _Pragma("unroll") for (int k = 0; k < 2; ++k) dst[n][k] = *(const PG8_LAS bf16x8*)(lds + PG8_SB(b, h) + boff + n * 2048 + k * 1024); } while (0)
#define PG8_MMA(ai, bj, At, Bt) do { __builtin_amdgcn_s_setprio(1); _Pragma("unroll") for (int m = 0; m < 4; ++m) _Pragma("unroll") for (int n = 0; n < 2; ++n) _Pragma("unroll") for (int k = 0; k < 2; ++k) \
        acc[ai][bj][m][n] = __builtin_amdgcn_mfma_f32_16x16x32_bf16(Bt[n][k], At[m][k], acc[ai][bj][m][n], 0, 0, 0); __builtin_amdgcn_s_setprio(0); } while (0)
#define PG8_WAIT_V(n) asm volatile("s_waitcnt vmcnt(" #n ")" ::: "memory")
#define PG8_WAIT_L(n) asm volatile("s_waitcnt lgkmcnt(" #n ")" ::: "memory")
#define PG8_BAR __builtin_amdgcn_s_barrier()
#define PG8_SCHED __builtin_amdgcn_sched_barrier(0)
    Unit cur, nxt; int ui = 0;
    if (!S.next(0, cur)) return;
    f32x4 acc[2][2][4][2];
#pragma unroll
    for (int a = 0; a < 2; ++a)
#pragma unroll
        for (int b = 0; b < 2; ++b)
#pragma unroll
            for (int m = 0; m < 4; ++m)
#pragma unroll
                for (int n = 0; n < 2; ++n) acc[a][b][m][n] = (f32x4){0.f, 0.f, 0.f, 0.f};
    bf16x8 At[4][2], B0[2][2], B1[2][2];
    const char* cA = (const char*)g.A + (size_t)cur.pm * tstep; const char* cB = (const char*)g.Bt + (size_t)cur.pn * tstep;
    S.a_ready(cur);
    PG8_STAGE(PG8_SB(0, 0), cB, voffB); PG8_STAGE(PG8_SA(0, 0), cA, voffA); PG8_STAGE(PG8_SB(0, 1), cB + hstep, voffB); PG8_STAGE(PG8_SA(0, 1), cA + hstep, voffA);
    if (wr == 1) PG8_BAR;
    PG8_WAIT_V(4); PG8_BAR;
    PG8_STAGE(PG8_SB(1, 0), cB + kstep, voffB); PG8_STAGE(PG8_SA(1, 0), cA + kstep, voffA); PG8_STAGE(PG8_SB(1, 1), cB + hstep + kstep, voffB);
    PG8_WAIT_V(6); PG8_BAR;
    PG8_STAMP();
    for (;;) {
        const bool has_next = S.next(ui + 1, nxt);
        const char* nA = has_next ? (const char*)g.A + (size_t)nxt.pm * tstep : cA; const char* nB = has_next ? (const char*)g.Bt + (size_t)nxt.pn * tstep : cB;
        for (int t = 0; t < nt; t += 2) {
            const bool last = (t == nt - 2);
            const char* a1 = cA + (size_t)(t + 1) * kstep;
            const char* a2 = last ? nA : cA + (size_t)(t + 2) * kstep; const char* b2 = last ? nB : cB + (size_t)(t + 2) * kstep;
            const char* a3 = a2 + kstep; const char* b3 = b2 + kstep;
            if (last && has_next) S.a_ready(nxt);
            PG8_LDB(B0, 0, 0); PG8_SCHED; PG8_LDA(At, 0, 0); PG8_STAGE(PG8_SA(1, 1), a1 + hstep, voffA);
            PG8_WAIT_L(8); PG8_BAR; PG8_WAIT_L(0); PG8_MMA(0, 0, At, B0); PG8_BAR; PG8_SCHED;
            PG8_LDB(B1, 0, 1); PG8_STAGE(PG8_SB(0, 0), b2, voffB);
            PG8_BAR; PG8_WAIT_L(0); PG8_MMA(0, 1, At, B1); PG8_BAR;
            PG8_LDA(At, 0, 1); PG8_STAGE(PG8_SA(0, 0), a2, voffA);
            PG8_BAR; PG8_WAIT_L(0); PG8_MMA(1, 0, At, B0); PG8_BAR; PG8_SCHED;
            PG8_STAGE(PG8_SB(0, 1), b2 + hstep, voffB);
            PG8_WAIT_V(6); PG8_BAR; PG8_MMA(1, 1, At, B1); PG8_BAR;
            PG8_LDB(B0, 1, 0); PG8_SCHED; PG8_LDA(At, 1, 0); PG8_STAGE(PG8_SA(0, 1), a2 + hstep, voffA);
            PG8_WAIT_L(8); PG8_BAR; PG8_WAIT_L(0); PG8_MMA(0, 0, At, B0); PG8_BAR; PG8_SCHED;
            PG8_LDB(B1, 1, 1); PG8_STAGE(PG8_SB(1, 0), b3, voffB);
            PG8_BAR; PG8_WAIT_L(0); PG8_MMA(0, 1, At, B1); PG8_BAR;
            PG8_LDA(At, 1, 1); PG8_STAGE(PG8_SA(1, 0), a3, voffA);
            PG8_BAR; PG8_WAIT_L(0); PG8_MMA(1, 0, At, B0); PG8_BAR; PG8_SCHED;
            PG8_STAGE(PG8_SB(1, 1), b3 + hstep, voffB);
            PG8_WAIT_V(6); PG8_BAR; PG8_MMA(1, 1, At, B1); PG8_BAR;
        }
        PG8_STAMP();
        if constexpr (!Epi::AFTER_DRAIN) { E(acc, cur, wr, wc, fr, fq); S.done(cur); }
        PG8_STAMP();
        if (!has_next) break;
#pragma unroll
        for (int a = 0; a < 2; ++a)
#pragma unroll
            for (int b = 0; b < 2; ++b)
#pragma unroll
                for (int m = 0; m < 4; ++m)
#pragma unroll
                    for (int n = 0; n < 2; ++n) acc[a][b][m][n] = (f32x4){0.f, 0.f, 0.f, 0.f};
        cur = nxt; cA = nA; cB = nB; ++ui;
    }
    PG8_WAIT_V(0);
    if (wr == 0) PG8_BAR;
    PG8_BAR;
    if constexpr (Epi::AFTER_DRAIN) { E.fused(acc, cur, wr, wc, fr, fq, lds, wid, lane); S.done(cur); }
    PG8_STAMP();
    if (STAMP && wid == 0) { stamps[lane] = lane < nts ? (((unsigned long long)(unsigned)ts_hi << 32) | (unsigned)ts_lo) : 0ull;
        if (lane == 62) stamps[62] = rt_entry; if (lane == 63) stamps[63] = (unsigned long long)wall_clock64(); }
#undef PG8_STAMP
#undef PG8_SA
#undef PG8_SB
#undef PG8_STAGE
#undef PG8_LDA
#undef PG8_LDB
#undef PG8_MMA
#undef PG8_WAIT_V
#undef PG8_WAIT_L
#undef PG8_BAR
#undef PG8_SCHED
}
}

#define LAS __attribute__((address_space(3)))
typedef unsigned short u16;
typedef short bf16x8 __attribute__((ext_vector_type(8)));
typedef short bf16x4 __attribute__((ext_vector_type(4)));
typedef float f32x4 __attribute__((ext_vector_type(4)));
typedef unsigned u32x4 __attribute__((ext_vector_type(4)));
typedef unsigned u32x2 __attribute__((ext_vector_type(2)));

constexpr int T_ = 32768, S_ = 4096, D_ = 2048, DFF_ = 5632, DIN_ = 5136, ZC_ = 5120, QC_ = 6144;
constexpr int LDS_MAIN = 139264, LDS_BYTES = LDS_MAIN + 16;
constexpr size_t SZ_WIN = (size_t)ZC_ * D_ * 2, SZ_WSQ = (size_t)D_ * D_ * 2, SZ_WQKV = (size_t)QC_ * D_ * 2, SZ_W13 = (size_t)2 * DFF_ * D_ * 2, SZ_W2 = (size_t)D_ * DFF_ * 2;
constexpr size_t OFF_WIN = 0, OFF_WOUT = OFF_WIN + SZ_WIN, OFF_WQKV = OFF_WOUT + SZ_WSQ, OFF_WO = OFF_WQKV + SZ_WQKV, OFF_W13 = OFF_WO + SZ_WSQ, OFF_W2 = OFF_W13 + 2 * SZ_W13,
                 OFF_WRG = OFF_W2 + 2 * SZ_W2, OFF_XN = OFF_WRG + (size_t)64 * 16384 * 2, OFF_BIG = OFF_XN + (size_t)T_ * D_ * 2, OFF_MIX = OFF_BIG + (size_t)T_ * QC_ * 2,
                 OFF_GATES = OFF_MIX + (size_t)T_ * D_ * 4, OFF_RGSUM = OFF_GATES + (size_t)T_ * 16 * 4, OFF_RGCAR = OFF_RGSUM + (size_t)8 * 64 * 2 * 1024 * 8,
                 OFF_LSE = OFF_RGCAR + (size_t)8 * 64 * 2 * 1024 * 4, OFF_SS = OFF_LSE + (size_t)3 * T_ * 16 * 4, OFF_BAR = OFF_SS + (size_t)4 * T_ * 4, WS_END = OFF_BAR + 16384;

struct Seg { const float* src; u16* dst; const float* gain; int ld, K, nN32, mode, rowoff, ntiles; };
struct Params {
    const float *x, *e_norm, *e_w_in, *e_gate_b, *e_conv_w, *e_conv_b, *e_rg_wa, *e_rg_ba, *e_rg_wx, *e_rg_bx, *e_rg_lam, *e_head_g, *e_w_out, *o_norm, *o_w_qkv, *o_w_o, *f_norm, *f_w1, *f_w3, *f_w2, *final_norm;
    float* out; unsigned char* ws;
    Seg seg[12]; int nseg, total_tiles;
};


typedef const __attribute__((address_space(4))) Params* PP;
__device__ __forceinline__ PP get_params() { auto k = __builtin_amdgcn_kernarg_segment_ptr(); asm volatile("" : "+s"(k)); return (PP)k; }
__device__ __forceinline__ int l_tid() { int t = threadIdx.x; asm volatile("" : "+v"(t)); return t; }
extern __shared__ __attribute__((aligned(16))) unsigned char lds_raw[];
__device__ __forceinline__ int l_bid() { int t = __builtin_amdgcn_readfirstlane(*(volatile LAS int*)((LAS unsigned char*)lds_raw + 139264 + 8)); asm volatile("" : "+s"(t)); return t; }
__device__ __forceinline__ int l_nblk() { int t = gridDim.x; asm volatile("" : "+s"(t)); return t; }
__device__ __forceinline__ unsigned pk2(float lo, float hi) { return pg8::cvt_pk_bf16(lo, hi); }
__device__ __forceinline__ float bflo(unsigned w) { return __uint_as_float(w << 16); }
__device__ __forceinline__ float bfhi(unsigned w) { return __uint_as_float(w & 0xffff0000u); }
__device__ __forceinline__ float wave_sum(float v) {
#pragma unroll
    for (int o = 1; o < 64; o <<= 1) v += __shfl_xor(v, o);
    return v;
}
__device__ __forceinline__ bf16x8 cat8(bf16x4 a, bf16x4 b) { return __builtin_shufflevector(a, b, 0, 1, 2, 3, 4, 5, 6, 7); }
__device__ __forceinline__ bf16x4 lds_tr(LAS unsigned char* p) { return __builtin_amdgcn_ds_read_tr16_b64_v4i16((LAS bf16x4*)p); }
__device__ __forceinline__ bf16x8 lds_r8(LAS unsigned char* p) { return *(LAS bf16x8*)p; }
__device__ __forceinline__ bf16x8 as_bf16x8(u32x4 v) { union { u32x4 u; bf16x8 b; } c; c.u = v; return c.b; }
#define MFMA16(a, b, c) __builtin_amdgcn_mfma_f32_16x16x32_bf16((a), (b), (c), 0, 0, 0)
#define LDSWAIT() asm volatile("s_waitcnt lgkmcnt(0)" ::: "memory")
__device__ __forceinline__ float sigmoidf_(float v) { return __builtin_amdgcn_rcpf(1.0f + __expf(-v)); }

__device__ __forceinline__ void transpose_item(const float* src, const float* gain, int ld, u16* dst, int K, int nN32, int mode, int rowoff, int item, LAS float* scr, int lane) {
    const int nb = item % nN32, kb = item / nN32, k0 = 64 * kb, n0 = 32 * nb;
#pragma unroll 8
    for (int i = 0; i < 32; ++i) { const int kk = 2 * i + (lane >> 5); scr[kk * 33 + (lane & 31)] = src[(size_t)(k0 + kk) * ld + n0 + (lane & 31)]; }
    LDSWAIT();
    const int R0 = mode ? (((n0 >> 7) << 8) + (n0 & 127) + rowoff) : (n0 + rowoff);
    const int c = lane & 7;
    f32x4 g0 = (f32x4){1.f, 1.f, 1.f, 1.f}, g1 = g0;
    if (gain) { g0 = *(const f32x4*)(gain + k0 + 8 * c); g1 = *(const f32x4*)(gain + k0 + 8 * c + 4); }
#pragma unroll
    for (int j = 0; j < 4; ++j) { const int n = (lane >> 3) + 8 * j; const LAS float* s = scr + (8 * c) * 33 + n;
        u32x4 o; o.x = pk2(s[0 * 33] * g0.x, s[1 * 33] * g0.y); o.y = pk2(s[2 * 33] * g0.z, s[3 * 33] * g0.w); o.z = pk2(s[4 * 33] * g1.x, s[5 * 33] * g1.y); o.w = pk2(s[6 * 33] * g1.z, s[7 * 33] * g1.w);
        *(u32x4*)(dst + (size_t)(R0 + n) * K + k0 + 8 * c) = o; }
    LDSWAIT();
}

__device__ __forceinline__ void phase0(LAS unsigned char* L) { PP p = get_params();
    const int tid = l_tid(), lane = tid & 63, wid = tid >> 6;
    const int gw = l_bid() * 8 + wid, NGW = l_nblk() * 8;
    LAS float* scr = (LAS float*)(L + wid * 8704);
    for (int it = gw; it < p->total_tiles; it += NGW) {
        int r = it, si = 0;
        while (r >= p->seg[si].ntiles) { r -= p->seg[si].ntiles; ++si; }
        transpose_item(p->seg[si].src, p->seg[si].gain, p->seg[si].ld, p->seg[si].dst, p->seg[si].K, p->seg[si].nN32, p->seg[si].mode, p->seg[si].rowoff, r, scr, lane);
    }
    for (int it = gw; it < 256; it += NGW) {
        const int mi = it >> 3, sub = it & 7, mat = mi >> 4, dn = mi & 15;
        const float* src = (mat ? p->e_rg_wx : p->e_rg_wa) + (size_t)dn * 16384;
        u16* dst = (u16*)(p->ws + OFF_WRG) + (size_t)((((dn >> 3) * 2 + mat) * 8) + (dn & 7)) * 16384;
        transpose_item(src, nullptr, 128, dst, 128, 4, 0, 0, sub, scr, lane);
    }
    __syncthreads();
    { float* SSZ = (float*)(p->ws + OFF_SS); for (int i = l_bid() * 512 + tid; i < 4 * T_; i += l_nblk() * 512) SSZ[i] = 0.f; }
    LAS float* WgT = (LAS float*)L;
    for (int k = tid; k < D_; k += 512) {
        const float* s = p->e_w_in + (size_t)k * DIN_ + 3072;
#pragma unroll
        for (int c = 0; c < 4; ++c) { const f32x4 v = *(const f32x4*)(s + 4 * c);
            WgT[(4 * c + 0) * D_ + k] = v.x; WgT[(4 * c + 1) * D_ + k] = v.y; WgT[(4 * c + 2) * D_ + k] = v.z; WgT[(4 * c + 3) * D_ + k] = v.w; }
    }
    __syncthreads();
    u16* XN = (u16*)(p->ws + OFF_XN);
    float* GT = (float*)(p->ws + OFF_GATES);
    f32x4 gk[8];
#pragma unroll
    for (int i = 0; i < 8; ++i) gk[i] = *(const f32x4*)(p->e_norm + 256 * i + 4 * lane);
    const float gb = p->e_gate_b[(lane >> 1) & 15];
    for (int rp = gw; rp < T_ / 2; rp += NGW) {
        const float* x0 = p->x + (size_t)(2 * rp) * D_; const float* x1 = x0 + D_;
        f32x4 a[8], b[8]; float s0 = 0.f, s1 = 0.f;
#pragma unroll
        for (int i = 0; i < 8; ++i) { a[i] = *(const f32x4*)(x0 + 256 * i + 4 * lane); b[i] = *(const f32x4*)(x1 + 256 * i + 4 * lane);
            s0 += a[i].x * a[i].x + a[i].y * a[i].y + a[i].z * a[i].z + a[i].w * a[i].w; s1 += b[i].x * b[i].x + b[i].y * b[i].y + b[i].z * b[i].z + b[i].w * b[i].w; }
        const float r0 = rsqrtf(wave_sum(s0) * (1.0f / D_) + 1e-6f), r1 = rsqrtf(wave_sum(s1) * (1.0f / D_) + 1e-6f);
        u16* o0 = XN + (size_t)(2 * rp) * D_; u16* o1 = o0 + D_;
#pragma unroll
        for (int i = 0; i < 8; ++i) { a[i] = a[i] * r0 * gk[i]; b[i] = b[i] * r1 * gk[i];
            u32x2 w0, w1; w0.x = pk2(a[i].x, a[i].y); w0.y = pk2(a[i].z, a[i].w); w1.x = pk2(b[i].x, b[i].y); w1.y = pk2(b[i].z, b[i].w);
            *(u32x2*)(o0 + 256 * i + 4 * lane) = w0; *(u32x2*)(o1 + 256 * i + 4 * lane) = w1; }
        float v[32];
#pragma unroll
        for (int j = 0; j < 16; ++j) { float c0 = 0.f, c1 = 0.f;
#pragma unroll
            for (int i = 0; i < 8; ++i) { const f32x4 w = *(LAS f32x4*)(WgT + j * D_ + 256 * i + 4 * lane);
                c0 += a[i].x * w.x + a[i].y * w.y + a[i].z * w.z + a[i].w * w.w; c1 += b[i].x * w.x + b[i].y * w.y + b[i].z * w.z + b[i].w * w.w; }
            v[j] = c0; v[16 + j] = c1; }
#pragma unroll
        for (int j = 0; j < 16; ++j) { const bool hi = lane & 32; const float keep = hi ? v[j + 16] : v[j], send = hi ? v[j] : v[j + 16]; v[j] = keep + __shfl_xor(send, 32); }
#pragma unroll
        for (int j = 0; j < 8; ++j) { const bool hi = lane & 16; const float keep = hi ? v[j + 8] : v[j], send = hi ? v[j] : v[j + 8]; v[j] = keep + __shfl_xor(send, 16); }
#pragma unroll
        for (int j = 0; j < 4; ++j) { const bool hi = lane & 8; const float keep = hi ? v[j + 4] : v[j], send = hi ? v[j] : v[j + 4]; v[j] = keep + __shfl_xor(send, 8); }
#pragma unroll
        for (int j = 0; j < 2; ++j) { const bool hi = lane & 4; const float keep = hi ? v[j + 2] : v[j], send = hi ? v[j] : v[j + 2]; v[j] = keep + __shfl_xor(send, 4); }
        { const bool hi = lane & 2; const float keep = hi ? v[1] : v[0], send = hi ? v[0] : v[1]; v[0] = keep + __shfl_xor(send, 2); }
        v[0] += __shfl_xor(v[0], 1);
        if ((lane & 1) == 0) { const int idx = lane >> 1; GT[(size_t)(2 * rp + (idx >> 4)) * 16 + (idx & 15)] = v[0] + gb; }
    }
}

template <bool TO_F32>
__device__ __forceinline__ void norm_phase(const float* X, const float* g, u16* O, float* OF) {
    const int tid = l_tid(), lane = tid & 63, wid = tid >> 6;
    const int gw = l_bid() * 8 + wid, NGW = l_nblk() * 8;
    f32x4 gk[8];
#pragma unroll
    for (int i = 0; i < 8; ++i) gk[i] = *(const f32x4*)(g + 256 * i + 4 * lane);
    for (int row = gw; row < T_; row += NGW) {
        const float* x0 = X + (size_t)row * D_;
        f32x4 a[8]; float s0 = 0.f;
#pragma unroll
        for (int i = 0; i < 8; ++i) { a[i] = *(const f32x4*)(x0 + 256 * i + 4 * lane); s0 += a[i].x * a[i].x + a[i].y * a[i].y + a[i].z * a[i].z + a[i].w * a[i].w; }
        const float r0 = rsqrtf(wave_sum(s0) * (1.0f / D_) + 1e-6f);
#pragma unroll
        for (int i = 0; i < 8; ++i) { a[i] = a[i] * r0 * gk[i];
            if (TO_F32) *(f32x4*)(OF + (size_t)row * D_ + 256 * i + 4 * lane) = a[i];
            else { u32x2 w0; w0.x = pk2(a[i].x, a[i].y); w0.y = pk2(a[i].z, a[i].w); *(u32x2*)(O + (size_t)row * D_ + 256 * i + 4 * lane) = w0; } }
    }
}

__device__ __forceinline__ float scan_add64(float v, int lane) {
#pragma unroll
    for (int d = 1; d < 64; d <<= 1) { const float t = __shfl_up(v, d); if (lane >= d) v += t; }
    return v;
}
__device__ __forceinline__ float scan_max64(float v, int lane) {
#pragma unroll
    for (int d = 1; d < 64; d <<= 1) { const float t = __shfl_up(v, d); if (lane >= d) v = fmaxf(v, t); }
    return v;
}
struct GateV { float a, g, wsrc, winter, mout, decay, mnext; };
__device__ __forceinline__ GateV gate_math(float gi, float gf, float m_carry, int lane) {
    GateV o;
    const float lf = (gf >= 0.f) ? -log1pf(__expf(-gf)) : (gf - log1pf(__expf(gf)));
    const float b = scan_add64(lf, lane);
    o.a = gi - b;
    const float M = scan_max64(o.a, lane);
    o.g = fmaxf(m_carry, M);
    const float bL = __shfl(b, 63), g63 = __shfl(o.g, 63);
    o.wsrc = __expf(o.a - g63); o.decay = __expf(m_carry - g63); o.winter = __expf(m_carry - o.g); o.mout = b + o.g; o.mnext = bL + g63;
    return o;
}

__device__ __forceinline__ void mlstm_phase(LAS unsigned char* L) { PP p = get_params();
    const int tid = l_tid(), lane = tid & 63, wid = __builtin_amdgcn_readfirstlane(tid >> 6), l15 = lane & 15, quad = lane >> 4;
    const u16* Z = (const u16*)(p->ws + OFF_BIG);
    const float* GT = (const float*)(p->ws + OFF_GATES);
    u16* HB = (u16*)(p->ws + OFF_MIX);
    constexpr int QS = 0, KS = 17408, VS = 34816, VW = 46080, CB = 57344, GA = 79104, GB = GA + 16384, GM = GB + 16384, GC = GM + 16384;
    constexpr float QSCALE = 0.08838834764831845f;
    const int r = tid >> 3, pc = tid & 7;
    const int lt = wid & 3, dvh = wid >> 2, lidx = 16 * lt + l15;
    for (int item = l_bid(); item < 256; item += l_nblk()) {
        const int dvq = item & 3, dir = (item >> 2) & 1, hh = (item >> 3) & 3, b = item >> 5;
        const size_t tok0 = (size_t)b * S_;
        u32x4 nq0, nq1, nk0, nk1, nv;
        {   const int pp = r; const int t = dir ? (S_ - 1 - pp) : pp; const u16* zr = Z + (tok0 + t) * ZC_;
            nq0 = *(const u32x4*)(zr + hh * 128 + 8 * pc); nq1 = *(const u32x4*)(zr + hh * 128 + 64 + 8 * pc);
            nk0 = *(const u32x4*)(zr + 512 + hh * 128 + 8 * pc); nk1 = *(const u32x4*)(zr + 512 + hh * 128 + 64 + 8 * pc);
            nv = *(const u32x4*)(zr + 1024 + hh * 256 + dvq * 64 + 8 * pc); }
#pragma unroll 2
        for (int k = 0; k < 8; ++k) { const int c = wid + 8 * k; const int pl = 64 * c + lane; const int tl = dir ? (S_ - 1 - pl) : pl; const float* gr = GT + (tok0 + tl) * 16;
            const float gi = gr[(2 * dir) * 4 + hh], gf = gr[(2 * dir + 1) * 4 + hh];
            const float lf = (gf >= 0.f) ? -log1pf(__expf(-gf)) : (gf - log1pf(__expf(gf)));
            const float bb = scan_add64(lf, lane), aa = gi - bb, MM = scan_max64(aa, lane);
            *(LAS float*)(L + GA + (c * 64 + lane) * 4) = aa; *(LAS float*)(L + GB + (c * 64 + lane) * 4) = bb; *(LAS float*)(L + GM + (c * 64 + lane) * 4) = MM; }
        f32x4 Cacc[5];
#pragma unroll
        for (int i = 0; i < 5; ++i) Cacc[i] = (f32x4){0.f, 0.f, 0.f, 0.f};
        for (int i = tid; i < 1360; i += 512) *(LAS u32x4*)(L + CB + i * 16) = (u32x4){0u, 0u, 0u, 0u};
        __syncthreads();
        if (wid == 0) {
            float m = -1e30f, mine = 0.f;
            for (int c = 0; c < 64; ++c) { const float bL = *(LAS float*)(L + GB + (c * 64 + 63) * 4), M63 = *(LAS float*)(L + GM + (c * 64 + 63) * 4);
                mine = (lane == c) ? m : mine; m = bL + fmaxf(m, M63); }
            *(LAS float*)(L + GC + lane * 4) = mine;
        }
        __syncthreads();
#define MLSTM_STAGE(cs) do { \
            *(LAS u32x4*)(L + QS + r * 272 + pc * 16) = nq0; *(LAS u32x4*)(L + QS + r * 272 + 128 + pc * 16) = nq1; \
            *(LAS u32x4*)(L + KS + r * 272 + pc * 16) = nk0; *(LAS u32x4*)(L + KS + r * 272 + 128 + pc * 16) = nk1; \
            *(LAS u32x4*)(L + VS + r * 176 + pc * 16) = nv; \
            const float g63_ = fmaxf(*(LAS float*)(L + GC + (cs) * 4), *(LAS float*)(L + GM + ((cs) * 64 + 63) * 4)); \
            const float wr_ = __expf(*(LAS float*)(L + GA + ((cs) * 64 + r) * 4) - g63_); u32x4 sv; \
            sv.x = pk2(bflo(nv.x) * wr_, bfhi(nv.x) * wr_); sv.y = pk2(bflo(nv.y) * wr_, bfhi(nv.y) * wr_); sv.z = pk2(bflo(nv.z) * wr_, bfhi(nv.z) * wr_); sv.w = pk2(bflo(nv.w) * wr_, bfhi(nv.w) * wr_); \
            *(LAS u32x4*)(L + VW + r * 176 + pc * 16) = sv; \
            if (pc < 2) { u32x4 one = (u32x4){pc == 0 ? 0x3F80u : 0u, 0u, 0u, 0u}; u32x4 ws_ = (u32x4){pc == 0 ? (pk2(wr_, 0.f) & 0xffffu) : 0u, 0u, 0u, 0u}; \
                *(LAS u32x4*)(L + VS + r * 176 + 128 + pc * 16) = one; *(LAS u32x4*)(L + VW + r * 176 + 128 + pc * 16) = ws_; } \
        } while (0)
        MLSTM_STAGE(0);
        for (int c = 0; c < 64; ++c) {
            if (c + 1 < 64) {
                const int pp = 64 * (c + 1) + r; const int t = dir ? (S_ - 1 - pp) : pp; const u16* zr = Z + (tok0 + t) * ZC_;
                nq0 = *(const u32x4*)(zr + hh * 128 + 8 * pc); nq1 = *(const u32x4*)(zr + hh * 128 + 64 + 8 * pc);
                nk0 = *(const u32x4*)(zr + 512 + hh * 128 + 8 * pc); nk1 = *(const u32x4*)(zr + 512 + hh * 128 + 64 + 8 * pc);
                nv = *(const u32x4*)(zr + 1024 + hh * 256 + dvq * 64 + 8 * pc);
            }
            __syncthreads();
            const float m_c = *(LAS float*)(L + GC + c * 4);
            const float g63 = fmaxf(m_c, *(LAS float*)(L + GM + (c * 64 + 63) * 4));
            const float g_l = fmaxf(m_c, *(LAS float*)(L + GM + (c * 64 + lidx) * 4));
            const float winter_l = __expf(m_c - g_l), mout_l = *(LAS float*)(L + GB + (c * 64 + lidx) * 4) + g_l;
            bf16x8 qf[4];
#pragma unroll
            for (int ks = 0; ks < 4; ++ks) qf[ks] = lds_r8(L + QS + (16 * lt + l15) * 272 + (32 * ks + 8 * quad) * 2);
            f32x4 sacc[4];
#pragma unroll
            for (int st = 0; st < 4; ++st) { sacc[st] = (f32x4){0.f, 0.f, 0.f, 0.f};
                if (st <= lt) {
#pragma unroll
                    for (int ks = 0; ks < 4; ++ks) { const bf16x8 kf = lds_r8(L + KS + (16 * st + l15) * 272 + (32 * ks + 8 * quad) * 2); sacc[st] = MFMA16(kf, qf[ks], sacc[st]); } } }
            float pw[4][4];
#pragma unroll
            for (int st = 0; st < 4; ++st) { const f32x4 a4 = *(LAS f32x4*)(L + GA + (c * 64 + 16 * st + 4 * quad) * 4);
#pragma unroll
                for (int jj = 0; jj < 4; ++jj) { const int sidx = 16 * st + 4 * quad + jj;
                    const float w = (sidx <= lidx) ? __expf(a4[jj] - g_l) * QSCALE : 0.f; pw[st][jj] = sacc[st][jj] * w; } }
            bf16x8 pf[2];
#pragma unroll
            for (int i = 0; i < 2; ++i) { u32x4 t; t.x = pk2(pw[2 * i][0], pw[2 * i][1]); t.y = pk2(pw[2 * i][2], pw[2 * i][3]); t.z = pk2(pw[2 * i + 1][0], pw[2 * i + 1][1]); t.w = pk2(pw[2 * i + 1][2], pw[2 * i + 1][3]); pf[i] = as_bf16x8(t); }
            f32x4 nacc[3];
#pragma unroll
            for (int x = 0; x < 3; ++x) { const int dt = (x < 2) ? (2 * dvh + x) : 4; nacc[x] = (f32x4){0.f, 0.f, 0.f, 0.f};
#pragma unroll
                for (int ks = 0; ks < 4; ++ks) { const bf16x8 cf = lds_r8(L + CB + (16 * dt + l15) * 272 + (32 * ks + 8 * quad) * 2); nacc[x] = MFMA16(cf, qf[ks], nacc[x]); }
                nacc[x] = nacc[x] * (winter_l * QSCALE);
#pragma unroll
                for (int i = 0; i < 2; ++i) {
                    const bf16x4 lo = lds_tr(L + VS + (32 * i + 4 * quad + (l15 >> 2)) * 176 + (16 * dt + 4 * (l15 & 3)) * 2);
                    const bf16x4 hi = lds_tr(L + VS + (32 * i + 16 + 4 * quad + (l15 >> 2)) * 176 + (16 * dt + 4 * (l15 & 3)) * 2);
                    nacc[x] = MFMA16(cat8(lo, hi), pf[i], nacc[x]); } }
            const float den = __shfl(nacc[2][0], l15);
            const float inv = 1.0f / fmaxf(fabsf(den), __expf(-mout_l));
            {   const int pp = 64 * c + lidx; const int t = dir ? (S_ - 1 - pp) : pp;
                u16* hrow = HB + ((size_t)dir * T_ + tok0 + t) * 1024 + hh * 256 + dvq * 64 + 4 * quad;
#pragma unroll
                for (int x = 0; x < 2; ++x) { const f32x4 hv = nacc[x] * inv; u32x2 w; w.x = pk2(hv[0], hv[1]); w.y = pk2(hv[2], hv[3]); *(u32x2*)(hrow + 16 * (2 * dvh + x)) = w; } }
            const float decay = __expf(m_c - g63);
#pragma unroll
            for (int dt = 0; dt < 5; ++dt) Cacc[dt] = Cacc[dt] * decay;
#pragma unroll
            for (int i = 0; i < 2; ++i) {
                const bf16x4 alo = lds_tr(L + KS + (32 * i + 8 * quad + (l15 >> 2)) * 272 + (16 * wid + 4 * (l15 & 3)) * 2);
                const bf16x4 ahi = lds_tr(L + KS + (32 * i + 8 * quad + 4 + (l15 >> 2)) * 272 + (16 * wid + 4 * (l15 & 3)) * 2);
                const bf16x8 kf = cat8(alo, ahi);
#pragma unroll
                for (int dt = 0; dt < 5; ++dt) {
                    const bf16x4 blo = lds_tr(L + VW + (32 * i + 8 * quad + (l15 >> 2)) * 176 + (16 * dt + 4 * (l15 & 3)) * 2);
                    const bf16x4 bhi = lds_tr(L + VW + (32 * i + 8 * quad + 4 + (l15 >> 2)) * 176 + (16 * dt + 4 * (l15 & 3)) * 2);
                    Cacc[dt] = MFMA16(kf, cat8(blo, bhi), Cacc[dt]); } }
            __syncthreads();
#pragma unroll
            for (int dt = 0; dt < 5; ++dt) { u32x2 w; w.x = pk2(Cacc[dt][0], Cacc[dt][1]); w.y = pk2(Cacc[dt][2], Cacc[dt][3]);
                *(LAS u32x2*)(L + CB + (16 * dt + l15) * 272 + (16 * wid + 4 * quad) * 2) = w; }
            if (c + 1 < 64) { MLSTM_STAGE(c + 1); }
        }
        __syncthreads();
    }
#undef MLSTM_STAGE
}

__device__ __forceinline__ void mlstm_combine_phase() { PP p = get_params();
    const int tid = l_tid(), lane = tid & 63, wid = tid >> 6;
    const int gw = l_bid() * 8 + wid, NGW = l_nblk() * 8;
    const u16* Z = (const u16*)(p->ws + OFF_BIG);
    const u16* HB = (const u16*)(p->ws + OFF_MIX);
    u16* Y = (u16*)(p->ws + OFF_XN);
    for (int it = gw; it < T_ * 4; it += NGW) {
        const int t = it >> 2, hh = it & 3;
        const u32x2 fw = *(const u32x2*)(HB + (size_t)t * 1024 + hh * 256 + 4 * lane), bw = *(const u32x2*)(HB + ((size_t)T_ + t) * 1024 + hh * 256 + 4 * lane);
        const f32x4 hm = (f32x4){bflo(fw.x) + bflo(bw.x), bfhi(fw.x) + bfhi(bw.x), bflo(fw.y) + bflo(bw.y), bfhi(fw.y) + bfhi(bw.y)};
        const float ss = wave_sum(hm.x * hm.x + hm.y * hm.y + hm.z * hm.z + hm.w * hm.w);
        const float rs = rsqrtf(ss * (1.0f / 256.f) + 1e-6f);
        const f32x4 hg = *(const f32x4*)(p->e_head_g + hh * 256 + 4 * lane);
        const u32x2 ob = *(const u32x2*)(Z + (size_t)t * ZC_ + 2048 + hh * 256 + 4 * lane);
        u32x2 w; w.x = pk2(hm.x * rs * hg.x * sigmoidf_(bflo(ob.x)), hm.y * rs * hg.y * sigmoidf_(bfhi(ob.x)));
        w.y = pk2(hm.z * rs * hg.z * sigmoidf_(bflo(ob.y)), hm.w * rs * hg.w * sigmoidf_(bfhi(ob.y)));
        *(u32x2*)(Y + (size_t)t * D_ + hh * 256 + 4 * lane) = w;
    }
}

__device__ __forceinline__ float gelu_tanh(float v) { const float u = 0.7978845608028654f * (v + 0.044715f * v * v * v); const float e = __expf(2.0f * u); return 0.5f * v * (1.0f + (1.0f - 2.0f * __builtin_amdgcn_rcpf(e + 1.0f))); }

__device__ __forceinline__ float softplus_neg(float v) { const float x = __expf(-v); return (x < 0.1f) ? x * (1.0f - x * (0.5f - x * (0.33333334f - x * (0.25f - x * 0.2f)))) : __logf(1.0f + x); }
template <bool FINAL>
__device__ __forceinline__ void rglru_phase(LAS unsigned char* L) { PP p = get_params();
    const int tid = l_tid(), lane = tid & 63, wid = __builtin_amdgcn_readfirstlane(tid >> 6), l15 = lane & 15, quad = lane >> 4;
    const u16* Z = (const u16*)(p->ws + OFF_BIG);
    const u16* WRG = (const u16*)(p->ws + OFF_WRG);
    float2* SUM = (float2*)(p->ws + OFF_RGSUM);
    const float* CAR = (const float*)(p->ws + OFF_RGCAR);
    u16* Y = (u16*)(p->ws + OFF_XN);
    const int cgp = tid & 15, tq = tid >> 4;
    for (int grp = l_bid(); grp < 256; grp += l_nblk()) {
        const int b = grp >> 5, n = (grp >> 2) & 7, seg = grp & 3;
        const size_t tok0 = (size_t)b * S_;
        const int chb = n * 128 + 8 * cgp, ch0 = n * 128 + 16 * wid + 4 * quad;
        __syncthreads();
        LAS float* CW = (LAS float*)(L + 34816);
        for (int i = tid; i < 640; i += 512) { const int j = i >> 7, c = i & 127; CW[i] = (j < 4) ? p->e_conv_w[j * 1024 + n * 128 + c] : p->e_conv_b[n * 128 + c]; }
        LAS float* CB2 = CW + 640;
        for (int i = tid; i < 768; i += 512) { const int dir = i / 384, k = (i % 384) >> 7, c = i & 127; const int gi = dir * 1024 + n * 128 + c;
            CB2[i] = (k == 0) ? p->e_rg_ba[gi] : (k == 1) ? p->e_rg_bx[gi] : (-8.0f * softplus_neg(p->e_rg_lam[gi])); }
        u32x4 pre[5];
#define RG_ISSUE(tile_) do { _Pragma("unroll") for (int j = 0; j < 5; ++j) { const int pos = 64 * (tile_) + 2 * tq - 2 + j; pre[j] = (u32x4){0u, 0u, 0u, 0u}; \
            if (pos >= 0 && pos < S_) pre[j] = *(const u32x4*)(Z + (tok0 + pos) * ZC_ + 3072 + chb); } } while (0)
        RG_ISSUE(seg * 16);
        __syncthreads();
        for (int i = 0; i < 16; ++i) {
            const int tile = seg * 16 + i;
            LAS unsigned char* Xb = L + (i & 1) * 17408;
#pragma unroll
            for (int hh = 0; hh < 2; ++hh) { const int tl = 2 * tq + hh;
                float acc[8];
                { const f32x4 c0 = *(LAS f32x4*)(CW + 512 + 8 * cgp), c1 = *(LAS f32x4*)(CW + 512 + 8 * cgp + 4);
                  acc[0] = c0.x; acc[1] = c0.y; acc[2] = c0.z; acc[3] = c0.w; acc[4] = c1.x; acc[5] = c1.y; acc[6] = c1.z; acc[7] = c1.w; }
#pragma unroll
                for (int j = 0; j < 4; ++j) { const u32x4 v = pre[hh + j]; const f32x4 w0 = *(LAS f32x4*)(CW + j * 128 + 8 * cgp), w1 = *(LAS f32x4*)(CW + j * 128 + 8 * cgp + 4);
                    acc[0] += bflo(v.x) * w0.x; acc[1] += bfhi(v.x) * w0.y; acc[2] += bflo(v.y) * w0.z; acc[3] += bfhi(v.y) * w0.w;
                    acc[4] += bflo(v.z) * w1.x; acc[5] += bfhi(v.z) * w1.y; acc[6] += bflo(v.w) * w1.z; acc[7] += bfhi(v.w) * w1.w; }
                u32x4 o; o.x = pk2(acc[0], acc[1]); o.y = pk2(acc[2], acc[3]); o.z = pk2(acc[4], acc[5]); o.w = pk2(acc[6], acc[7]);
                *(LAS u32x4*)(Xb + (16 * (tl & 3) + (tl >> 2)) * 272 + cgp * 16) = o; }
            __syncthreads();
            if (i + 1 < 16) RG_ISSUE(tile + 1);
            float cin[2][4];
            if (FINAL) {
#pragma unroll
                for (int dir = 0; dir < 2; ++dir) { const f32x4 c4 = *(const f32x4*)(CAR + ((size_t)((b * 64 + tile) * 2 + dir)) * 1024 + ch0); cin[dir][0] = c4.x; cin[dir][1] = c4.y; cin[dir][2] = c4.z; cin[dir][3] = c4.w; }
            }
            float hsum[4][4];
#pragma unroll
            for (int tt = 0; tt < 4; ++tt)
#pragma unroll
                for (int jj = 0; jj < 4; ++jj) hsum[tt][jj] = 0.f;
#pragma unroll
            for (int dir = 0; dir < 2; ++dir) {
                bf16x8 wa[4], wx[4];
                {   const u16* wb = WRG + (size_t)(((dir * 2 + 0) * 8) + n) * 16384 + (16 * wid + l15) * 128 + 8 * quad;
#pragma unroll
                    for (int ks = 0; ks < 4; ++ks) { wa[ks] = *(const bf16x8*)(wb + 32 * ks); wx[ks] = *(const bf16x8*)(wb + (size_t)8 * 16384 + 32 * ks); } }
                const f32x4 ba4v = *(LAS f32x4*)(CB2 + dir * 384 + 16 * wid + 4 * quad), bx4v = *(LAS f32x4*)(CB2 + dir * 384 + 128 + 16 * wid + 4 * quad), cf4v = *(LAS f32x4*)(CB2 + dir * 384 + 256 + 16 * wid + 4 * quad);
                float av[4][4], uv[4][4];
#pragma unroll
                for (int tt = 0; tt < 4; ++tt) {
                    f32x4 pa = (f32x4){0.f, 0.f, 0.f, 0.f}, px = (f32x4){0.f, 0.f, 0.f, 0.f};
#pragma unroll
                    for (int ks = 0; ks < 4; ++ks) { const bf16x8 xf = lds_r8(Xb + (16 * tt + l15) * 272 + (32 * ks + 8 * quad) * 2); pa = MFMA16(wa[ks], xf, pa); px = MFMA16(wx[ks], xf, px); }
                    const u32x2 xc = *(LAS u32x2*)(Xb + (16 * tt + l15) * 272 + (16 * wid + 4 * quad) * 2);
                    const float xv[4] = {bflo(xc.x), bfhi(xc.x), bflo(xc.y), bfhi(xc.y)};
#pragma unroll
                    for (int jj = 0; jj < 4; ++jj) { const float rr = sigmoidf_(pa[jj] + ba4v[jj]), ii = sigmoidf_(px[jj] + bx4v[jj]); const float la = cf4v[jj] * rr, x2 = 2.0f * la;
                        const float em = -x2 * (1.0f + x2 * (0.5f + x2 * (0.16666667f + x2 * (0.041666668f + x2 * 0.0083333333f))));
                        av[tt][jj] = __expf(la); uv[tt][jj] = __builtin_amdgcn_sqrtf(fmaxf(em, 0.f)) * ii * xv[jj]; }
                }
#pragma unroll
                for (int jj = 0; jj < 4; ++jj) {
                    const float a0 = av[dir ? 3 : 0][jj], a1 = av[dir ? 2 : 1][jj], a2 = av[dir ? 1 : 2][jj], a3 = av[dir ? 0 : 3][jj];
                    const float u0 = uv[dir ? 3 : 0][jj], u1 = uv[dir ? 2 : 1][jj], u2 = uv[dir ? 1 : 2][jj], u3 = uv[dir ? 0 : 3][jj];
                    float A = a0 * a1 * a2 * a3, U = ((u0 * a1 + u1) * a2 + u2) * a3 + u3;
#pragma unroll
                    for (int d = 1; d < 16; d <<= 1) {
                        const float Ap = dir ? __shfl_down(A, d, 16) : __shfl_up(A, d, 16), Up = dir ? __shfl_down(U, d, 16) : __shfl_up(U, d, 16);
                        const bool ok = dir ? (l15 + d < 16) : (l15 >= d);
                        if (ok) { U = A * Up + U; A = A * Ap; } }
                    if (FINAL) {
                        float Ae = dir ? __shfl_down(A, 1, 16) : __shfl_up(A, 1, 16), Ue = dir ? __shfl_down(U, 1, 16) : __shfl_up(U, 1, 16);
                        const bool edge = dir ? (l15 == 15) : (l15 == 0);
                        if (edge) { Ae = 1.f; Ue = 0.f; }
                        const float hin = Ae * cin[dir][jj] + Ue;
                        const float h0 = a0 * hin + u0, h1 = a1 * h0 + u1, h2 = a2 * h1 + u2, h3 = a3 * h2 + u3;
                        hsum[dir ? 3 : 0][jj] += h0; hsum[dir ? 2 : 1][jj] += h1; hsum[dir ? 1 : 2][jj] += h2; hsum[dir ? 0 : 3][jj] += h3;
                    } else {
                        const int el = dir ? 0 : 15;
                        if (l15 == el) SUM[((size_t)((b * 64 + tile) * 2 + dir)) * 1024 + ch0 + jj] = make_float2(A, U);
                    }
                }
            }
            if (FINAL) {
                u32x2 gr[4];
#pragma unroll
                for (int tt = 0; tt < 4; ++tt) gr[tt] = *(const u32x2*)(Z + (tok0 + 64 * tile + 4 * l15 + tt) * ZC_ + 4096 + ch0);
#pragma unroll
                for (int tt = 0; tt < 4; ++tt) { const int t = 64 * tile + 4 * l15 + tt;
                    u32x2 w; w.x = pk2(hsum[tt][0] * gelu_tanh(bflo(gr[tt].x)), hsum[tt][1] * gelu_tanh(bfhi(gr[tt].x))); w.y = pk2(hsum[tt][2] * gelu_tanh(bflo(gr[tt].y)), hsum[tt][3] * gelu_tanh(bfhi(gr[tt].y)));
                    *(u32x2*)(Y + (tok0 + t) * D_ + 1024 + ch0) = w; }
            }
        }
        __syncthreads();
#undef RG_ISSUE
    }
}

__device__ __forceinline__ void rglru_carry_phase() { PP p = get_params();
    const int tid = l_tid(), lane = tid & 63, wid = tid >> 6;
    const float2* SUM = (const float2*)(p->ws + OFF_RGSUM);
    float* CAR = (float*)(p->ws + OFF_RGCAR);
    if (wid == 0) {
        for (int chain = l_bid() * 64 + lane; chain < 16384; chain += l_nblk() * 64) {
            const int ch = chain & 1023, dir = (chain >> 10) & 1, b = chain >> 11;
            float h = 0.f;
#pragma unroll 8
            for (int k = 0; k < 64; ++k) { const int tile = dir ? (63 - k) : k; const size_t idx = ((size_t)((b * 64 + tile) * 2 + dir)) * 1024 + ch;
                const float2 s = SUM[idx]; CAR[idx] = h; h = s.x * h + s.y; }
        }
    }
}

struct AttnItem { int g, head, b, dil, sp, r, nb; };
__device__ __forceinline__ AttnItem attn_decode(int it0, int nblk) {
    int item = it0;
    if (nblk == 256) { const int k = it0 >> 8, w = it0 & 255, xcd = w & 7, slot = w >> 3; item = (((k / 3) * 8 + xcd) * 3 + (k % 3)) * 32 + slot; }
    AttnItem a; const int blk32 = item & 31, bh = item / 96; a.g = (item >> 5) % 3; a.head = bh & 15; a.b = bh >> 4;
    const int lg = 2 * a.g; a.dil = 1 << lg; a.sp = S_ >> lg; a.r = blk32 & (a.dil - 1); a.nb = blk32 >> lg;
    return a;
}
__device__ __forceinline__ void attn_phase(LAS unsigned char* L) { PP p = get_params();
    const int tid = l_tid(), lane = tid & 63, wid = __builtin_amdgcn_readfirstlane(tid >> 6), l15 = lane & 15, quad = lane >> 4;
    const u16* QKV = (const u16*)(p->ws + OFF_BIG);
    float* LSE = (float*)(p->ws + OFF_LSE);
    constexpr int KS = 0, VS = 65536;
    constexpr float SCALE = 0.08838834764831845f;
    const int pc = tid & 15, rb = tid >> 4;
    const int nblk = l_nblk();
    bf16x8 qf[4];
#define ATT_DMA(A_, which, BASE, ISV) do { _Pragma("unroll") for (int it = 0; it < 8; ++it) { const int lam = rb + 32 * it, x_ = lam & 15; \
        const int lr = (ISV) ? ((lam & ~15) + 8 * ((x_ >> 2) & 1) + 4 * (x_ >> 3) + (x_ & 3)) : lam; \
        const int cx = (ISV) ? (((lam & 3) << 2) | ((lam >> 2) & 3)) : x_; \
        const int i = 128 * (A_).nb - 64 + lr; const int ic = i < 0 ? 0 : (i >= (A_).sp ? (A_).sp - 1 : i);     \
        const unsigned bo_ = ((unsigned)(((which) * 128 + (A_).b * 16 + (A_).head) * S_ + (A_).r + ic * (A_).dil) * 128u + (unsigned)(8 * (pc ^ cx))) * 2u; \
        __builtin_amdgcn_global_load_lds((const unsigned*)((const char*)QKV + bo_), (LAS unsigned*)(L + (BASE) + (4 * wid + 32 * it) * 256), 16, 0, 0); } } while (0)
#define ATT_LOADQ(A_) do { const unsigned qb_ = ((unsigned)(((A_).b * 16 + (A_).head) * S_ + (A_).r + (128 * (A_).nb + 16 * wid + l15) * (A_).dil) * 128u + (unsigned)(8 * quad)) * 2u; \
        _Pragma("unroll") for (int ks = 0; ks < 4; ++ks) qf[ks] = *(const bf16x8*)((const char*)QKV + qb_ + 64 * ks); } while (0)
    int it0 = l_bid();
    AttnItem cur = attn_decode(it0 < 12288 ? it0 : 0, nblk);
    __syncthreads();
    if (it0 < 12288) { ATT_DMA(cur, 1, KS, 0); ATT_LOADQ(cur); }
    u32x2 pend[8]; u16* pend_ptr = nullptr; float pend_lse = 0.f; float* pend_lse_ptr = nullptr; bool have_pend = false;
    for (; it0 < 12288; it0 += nblk) {
        asm volatile("s_waitcnt vmcnt(0)" ::: "memory");
        __syncthreads();
        ATT_DMA(cur, 2, VS, 1);
        if (have_pend) {
#pragma unroll
            for (int dt = 0; dt < 8; ++dt) *(u32x2*)(pend_ptr + 16 * dt) = pend[dt];
            if (quad == 0) *pend_lse_ptr = pend_lse;
        }
        const int qi = 128 * cur.nb + 16 * wid + l15;
        const size_t qrow = (size_t)cur.b * S_ + cur.r + (size_t)qi * cur.dil;
        f32x4 sacc[9];
#pragma unroll
        for (int kt = 0; kt < 9; ++kt) { sacc[kt] = (f32x4){0.f, 0.f, 0.f, 0.f};
#pragma unroll
            for (int ks = 0; ks < 4; ++ks) { const bf16x8 kf = lds_r8(L + KS + (16 * wid + 16 * kt + l15) * 256 + (((4 * ks + quad) ^ l15) << 4)); sacc[kt] = MFMA16(kf, qf[ks], sacc[kt]); }
            if (kt % 3 == 2) __builtin_amdgcn_sched_barrier(0); }
        const float pen2 = exp2f(-0.5f * (float)(cur.head + 1)) * (float)cur.dil * 1.4426950408889634f, sc2 = SCALE * 1.4426950408889634f;
        float mx = -1e30f;
        int rel0 = 4 * quad - l15; asm volatile("" : "+v"(rel0));
        const float relf = (float)rel0;
        const bool seq_edge = (cur.nb == 0) || (cur.nb == (cur.sp >> 7) - 1);
        if (seq_edge) {
#pragma unroll
            for (int kt = 0; kt < 9; ++kt)
#pragma unroll
                for (int jj = 0; jj < 4; ++jj) { const int rel = 16 * kt + jj - 64 + rel0, ki = qi + rel; const int arel = rel < 0 ? -rel : rel;
                    const bool valid = (arel <= 64) && (ki >= 0) && (ki < cur.sp);
                    const float sc = valid ? (sacc[kt][jj] * sc2 - pen2 * (float)arel) : -1e30f; sacc[kt][jj] = sc; mx = fmaxf(mx, sc); }
        } else {
#pragma unroll
            for (int kt = 0; kt < 9; ++kt)
#pragma unroll
                for (int jj = 0; jj < 4; ++jj) { const float rr = relf + (float)(16 * kt + jj - 64);
                    float sc = __builtin_fmaf(sacc[kt][jj], sc2, -(pen2 * fabsf(rr)));
                    if (kt == 0) sc = (rel0 + jj >= 0) ? sc : -1e30f;
                    if (kt == 8) sc = (rel0 + jj <= 0) ? sc : -1e30f;
                    sacc[kt][jj] = sc; mx = fmaxf(mx, sc); }
        }
        mx = fmaxf(mx, __shfl_xor(mx, 16)); mx = fmaxf(mx, __shfl_xor(mx, 32));
        float lsum = 0.f;
#pragma unroll
        for (int kt = 0; kt < 9; ++kt)
#pragma unroll
            for (int jj = 0; jj < 4; ++jj) { const float pv = __builtin_amdgcn_exp2f(sacc[kt][jj] - mx); sacc[kt][jj] = pv; lsum += pv; }
        lsum += __shfl_xor(lsum, 16); lsum += __shfl_xor(lsum, 32);
        bf16x8 pf[5];
#pragma unroll
        for (int i = 0; i < 5; ++i) { u32x4 t; t.x = pk2(sacc[2 * i][0], sacc[2 * i][1]); t.y = pk2(sacc[2 * i][2], sacc[2 * i][3]);
            if (i < 4) { t.z = pk2(sacc[2 * i + 1][0], sacc[2 * i + 1][1]); t.w = pk2(sacc[2 * i + 1][2], sacc[2 * i + 1][3]); } else { t.z = 0u; t.w = 0u; }
            pf[i] = as_bf16x8(t); }
        asm volatile("s_waitcnt vmcnt(0)" ::: "memory");
        __syncthreads();
        const AttnItem cur0 = cur;
        if (it0 + nblk < 12288) { cur = attn_decode(it0 + nblk, nblk); ATT_DMA(cur, 1, KS, 0); ATT_LOADQ(cur); }
        f32x4 oacc[8];
        const int vrow = 16 * wid + 8 * (quad & 1) + 4 * (quad >> 1) + (l15 >> 2), vx = ((l15 >> 2) << 2) | ((2 * (quad & 1) + (quad >> 1)) & 3);
#pragma unroll
        for (int dt = 0; dt < 8; ++dt) { oacc[dt] = (f32x4){0.f, 0.f, 0.f, 0.f};
#pragma unroll
            for (int i = 0; i < 5; ++i) {
                const int vch = ((2 * dt + ((l15 & 3) >> 1)) ^ vx) * 16 + 8 * (l15 & 1);
                const bf16x4 lo = lds_tr(L + VS + 256 * (vrow + 32 * i) + vch);
                bf16x4 hi = (bf16x4){0, 0, 0, 0};
                if (i < 4) hi = lds_tr(L + VS + 256 * (vrow + 32 * i + 16) + vch);
                oacc[dt] = MFMA16(cat8(lo, hi), pf[i], oacc[dt]); }
            if (dt & 1) __builtin_amdgcn_sched_barrier(0); }
        const float inv = 1.0f / lsum;
        u16* OB = (cur0.g < 2) ? ((u16*)(p->out) + (size_t)cur0.g * T_ * D_) : (u16*)(p->ws + OFF_XN);
        pend_ptr = OB + qrow * D_ + cur0.head * 128 + 4 * quad;
#pragma unroll
        for (int dt = 0; dt < 8; ++dt) { pend[dt].x = pk2(oacc[dt][0] * inv, oacc[dt][1] * inv); pend[dt].y = pk2(oacc[dt][2] * inv, oacc[dt][3] * inv); }
        pend_lse = (mx + __log2f(lsum)) * 0.6931471805599453f; pend_lse_ptr = LSE + ((size_t)cur0.g * T_ + qrow) * 16 + cur0.head; have_pend = true;
    }
    if (have_pend) {
#pragma unroll
        for (int dt = 0; dt < 8; ++dt) *(u32x2*)(pend_ptr + 16 * dt) = pend[dt];
        if (quad == 0) *pend_lse_ptr = pend_lse;
    }
    __syncthreads();
#undef ATT_DMA
#undef ATT_LOADQ
}

__device__ __forceinline__ void attn_merge_phase() { PP p = get_params();
    const u16* O0 = (const u16*)(p->out); const u16* O1 = O0 + (size_t)T_ * D_; u16* O2 = (u16*)(p->ws + OFF_XN);
    const float* LSE = (const float*)(p->ws + OFF_LSE);
    for (size_t gi = (size_t)l_bid() * 512 + l_tid(); gi < (size_t)T_ * 256; gi += (size_t)l_nblk() * 512) {
        const size_t t = gi >> 8; const int c8 = (int)(gi & 255), head = c8 >> 4;
        const float l0 = LSE[t * 16 + head], l1 = LSE[((size_t)T_ + t) * 16 + head], l2 = LSE[((size_t)2 * T_ + t) * 16 + head];
        const float mx = fmaxf(l0, fmaxf(l1, l2));
        float w0 = __expf(l0 - mx), w1 = __expf(l1 - mx), w2 = __expf(l2 - mx); const float inv = 1.0f / (w0 + w1 + w2); w0 *= inv; w1 *= inv; w2 *= inv;
        const u32x4 a = *(const u32x4*)(O0 + t * D_ + 8 * c8), bq = *(const u32x4*)(O1 + t * D_ + 8 * c8), c = *(const u32x4*)(O2 + t * D_ + 8 * c8);
        u32x4 o;
        o.x = pk2(w0 * bflo(a.x) + w1 * bflo(bq.x) + w2 * bflo(c.x), w0 * bfhi(a.x) + w1 * bfhi(bq.x) + w2 * bfhi(c.x));
        o.y = pk2(w0 * bflo(a.y) + w1 * bflo(bq.y) + w2 * bflo(c.y), w0 * bfhi(a.y) + w1 * bfhi(bq.y) + w2 * bfhi(c.y));
        o.z = pk2(w0 * bflo(a.z) + w1 * bflo(bq.z) + w2 * bflo(c.z), w0 * bfhi(a.z) + w1 * bfhi(bq.z) + w2 * bfhi(c.z));
        o.w = pk2(w0 * bflo(a.w) + w1 * bflo(bq.w) + w2 * bflo(c.w), w0 * bfhi(a.w) + w1 * bfhi(bq.w) + w2 * bfhi(c.w));
        *(u32x4*)(O2 + t * D_ + 8 * c8) = o;
    }
}

#define XB_TMO      128
#define XB_XCNT(j)  (256  + 64 * (j))
#define XB_XSUB(j)  (1280 + 64 * (j))
#define XB_XGEN(j)  (2304 + 64 * (j))
#define XB_TOP      3328
#define XB_TOPGEN   3392
#define XCD_BAR_WORDS 3456
#define XB_SPIN_CAP (1u << 18)
__device__ __forceinline__ unsigned xb_ld(unsigned* p)              { return __hip_atomic_load(p, __ATOMIC_RELAXED, __HIP_MEMORY_SCOPE_AGENT); }
__device__ __forceinline__ unsigned xb_add(unsigned* p, unsigned v) { return __hip_atomic_fetch_add(p, v, __ATOMIC_RELAXED, __HIP_MEMORY_SCOPE_AGENT); }
__device__ __forceinline__ unsigned xb_xcc_id() { return (unsigned)__builtin_amdgcn_s_getreg((3 << 11) | 20) & 0xFu; }
#define XB_SPIN(cond, bar) do { unsigned _sp = 0; while (cond) { __builtin_amdgcn_s_sleep(1); \
    if ((++_sp & 255u) == 0u) { if (xb_ld(&(bar)[XB_TMO])) break; if (_sp > XB_SPIN_CAP) { atomicAdd(&(bar)[XB_TMO], 1u); break; } } } } while (0)

struct XcdBarrier {
    unsigned* bar; unsigned x;
    volatile LAS unsigned* st;
};

__device__ __forceinline__ XcdBarrier xcd_barrier_post(unsigned* bar, volatile LAS unsigned* st) {
    XcdBarrier b; b.bar = bar; b.x = xb_xcc_id(); b.st = st;
    if (threadIdx.x == 0) (void)xb_add(&bar[XB_XCNT(b.x)], 1u);
    return b;
}
__device__ __forceinline__ void xcd_barrier_complete(unsigned* bar, unsigned x, unsigned& nloc, unsigned& nx) {
    const unsigned G = gridDim.x * gridDim.y * gridDim.z;
    unsigned sum, cnt, mine, sp = 0u;
    for (;;) {
        sum = 0u; cnt = 0u; mine = 0u;
#pragma unroll
        for (unsigned j = 0; j < 16; ++j) { const unsigned c = xb_ld(&bar[XB_XCNT(j)]); sum += c; cnt += (c > 0u) ? 1u : 0u; mine = (j == x) ? c : mine; }
        if (sum == G) break;
        __builtin_amdgcn_s_sleep(1);
        if ((++sp & 255u) == 0u) { if (xb_ld(&bar[XB_TMO])) break; if (sp > XB_SPIN_CAP) { atomicAdd(&bar[XB_TMO], 1u); break; } }
    }
    nloc = mine > 0u ? mine : 1u; nx = cnt > 0u ? cnt : 1u;
}

__device__ __forceinline__ void xcd_barrier(const XcdBarrier& b) {
    asm volatile("s_waitcnt vmcnt(0)" ::: "memory");
    __syncthreads();
    if (threadIdx.x == 0) {
        unsigned* bar = b.bar;
        __builtin_amdgcn_s_waitcnt(0);
        unsigned nloc = b.st[0], nx = b.st[1];
        if (nloc == 0u) { xcd_barrier_complete(bar, b.x, nloc, nx); b.st[0] = nloc; b.st[1] = nx; }
        const unsigned old = xb_add(&bar[XB_XSUB(b.x)], 1u);
        const unsigned gen = old / nloc;
        if (old + 1u == (gen + 1u) * nloc) {
            __builtin_amdgcn_fence(__ATOMIC_RELEASE, "agent");
            asm volatile("s_waitcnt vmcnt(0)" ::: "memory");
            const unsigned og = xb_add(&bar[XB_TOP], 1u);
            const unsigned tg = og / nx;
            if (og + 1u == (tg + 1u) * nx) xb_add(&bar[XB_TOPGEN], 1u);
            else XB_SPIN(xb_ld(&bar[XB_TOPGEN]) == tg, bar);
            __builtin_amdgcn_fence(__ATOMIC_ACQUIRE, "agent");
            xb_add(&bar[XB_XGEN(b.x)], 1u);
            asm volatile("s_waitcnt vmcnt(0)" ::: "memory");
        } else {
            XB_SPIN(xb_ld(&bar[XB_XGEN(b.x)]) == gen, bar);
            __builtin_amdgcn_fence(__ATOMIC_ACQUIRE, "agent");
            asm volatile("s_waitcnt vmcnt(0)" ::: "memory");
        }
    }
    __syncthreads();
}


template <class Epi>
__device__ __forceinline__ void run_gemm(LAS unsigned char* L, const u16* A, const u16* Bt, int N, int K, const Epi& E) {
    pg8::Gemm g; g.A = A; g.Bt = Bt; g.M = T_; g.N = N; g.K = K;
    pg8::StaticOrder S; S.init(T_, N, l_nblk(), l_bid());
    pg8::gemm_phase<Epi, pg8::StaticOrder, false>(L, g, S, E, nullptr);
}
__device__ __forceinline__ void gemm_zin(LAS unsigned char* L) { PP p = get_params(); unsigned char* ws = p->ws;
    run_gemm(L, (const u16*)(ws + OFF_XN), (const u16*)(ws + OFF_WIN), ZC_, D_, pg8::EpiStoreBf16{(u16*)(ws + OFF_BIG), ZC_, nullptr, 0}); }
__device__ __forceinline__ void gemm_qkv(LAS unsigned char* L) { PP p = get_params(); unsigned char* ws = p->ws;
    run_gemm(L, (const u16*)(ws + OFF_MIX), (const u16*)(ws + OFF_WQKV), QC_, D_, pg8::EpiStoreBf16{(u16*)(ws + OFF_BIG), QC_, (const float*)(ws + OFF_SS) + T_, 1}); }
__device__ __forceinline__ void gemm_res0(LAS unsigned char* L) { PP p = get_params(); unsigned char* ws = p->ws;
    run_gemm(L, (const u16*)(ws + OFF_XN), (const u16*)(ws + OFF_WOUT), D_, D_,
             pg8::EpiRes<false, false, true>{(const void*)p->x, nullptr, (u16*)(ws + OFF_MIX), (float*)(ws + OFF_SS), D_}); }
__device__ __forceinline__ void gemm_res1(LAS unsigned char* L) { PP p = get_params(); unsigned char* ws = p->ws;
    run_gemm(L, (const u16*)(ws + OFF_XN), (const u16*)(ws + OFF_WO), D_, D_,
             pg8::EpiRes<true, false, true>{(const void*)(ws + OFF_MIX), nullptr, (u16*)(ws + OFF_MIX), (float*)(ws + OFF_SS) + 2 * T_, D_}); }
__device__ __forceinline__ void gemm_up(LAS unsigned char* L, int l) { PP p = get_params(); unsigned char* ws = p->ws;
    run_gemm(L, (const u16*)(ws + OFF_MIX), (const u16*)(ws + OFF_W13) + (size_t)l * 2 * DFF_ * D_, 2 * DFF_, D_, pg8::EpiSwiGLU{(u16*)(ws + OFF_BIG), DFF_, (const float*)(ws + OFF_SS) + (l ? 2 * T_ : 0)}); }
__device__ __forceinline__ void gemm_down0(LAS unsigned char* L) { PP p = get_params(); unsigned char* ws = p->ws;
    run_gemm(L, (const u16*)(ws + OFF_BIG), (const u16*)(ws + OFF_W2), D_, DFF_,
             pg8::EpiRes<true, false, true>{(const void*)(ws + OFF_MIX), nullptr, (u16*)(ws + OFF_MIX), (float*)(ws + OFF_SS) + T_, D_}); }
__device__ __forceinline__ void gemm_down1(LAS unsigned char* L) { PP p = get_params(); unsigned char* ws = p->ws;
    run_gemm(L, (const u16*)(ws + OFF_BIG), (const u16*)(ws + OFF_W2) + (size_t)D_ * DFF_, D_, DFF_,
             pg8::EpiRes<true, false, true>{(const void*)(ws + OFF_MIX), nullptr, (u16*)(ws + OFF_MIX), (float*)(ws + OFF_SS) + 3 * T_, D_}); }
__device__ __forceinline__ void norm_final() { PP p = get_params();
    const u16* XBp = (const u16*)(p->ws + OFF_MIX); const float* ss = (const float*)(p->ws + OFF_SS) + 3 * T_; float* out = p->out; const float* g = p->final_norm;
    for (size_t gi = (size_t)l_bid() * 512 + l_tid(); gi < (size_t)T_ * 256; gi += (size_t)l_nblk() * 512) {
        const size_t t = gi >> 8; const int c8 = (int)(gi & 255);
        const float rs = rsqrtf(ss[t] * (1.0f / D_) + 1e-6f);
        const u32x4 w = *(const u32x4*)(XBp + t * D_ + 8 * c8);
        const f32x4 g0 = *(const f32x4*)(g + 8 * c8), g1 = *(const f32x4*)(g + 8 * c8 + 4);
        f32x4 o0, o1;
        o0.x = bflo(w.x) * rs * g0.x; o0.y = bfhi(w.x) * rs * g0.y; o0.z = bflo(w.y) * rs * g0.z; o0.w = bfhi(w.y) * rs * g0.w;
        o1.x = bflo(w.z) * rs * g1.x; o1.y = bfhi(w.z) * rs * g1.y; o1.z = bflo(w.w) * rs * g1.z; o1.w = bfhi(w.w) * rs * g1.w;
        *(f32x4*)(out + t * D_ + 8 * c8) = o0; *(f32x4*)(out + t * D_ + 8 * c8 + 4) = o1;
    }
}

__global__ __launch_bounds__(512, 2) void mega_fwd(Params pdummy) {
    LAS unsigned char* L = (LAS unsigned char*)lds_raw;
    cg::grid_group grid = cg::this_grid();
    volatile LAS unsigned* xst = (volatile LAS unsigned*)(L + LDS_MAIN);
    if (threadIdx.x < 4) xst[threadIdx.x] = (threadIdx.x == 2) ? blockIdx.x : 0u;
    __syncthreads();
    unsigned* barw = (unsigned*)(get_params()->ws + OFF_BAR);
    XcdBarrier xb = xcd_barrier_post(barw, xst);
    if (threadIdx.x == 0) xst[3] = xb_add(&barw[3520 + 64 * xb.x], 1u);
    phase0(L);
    grid.sync();
    if (threadIdx.x == 0) {
        bool ok = (gridDim.x == 256) && (xb.x < 8u);
        for (int j = 0; j < 8; ++j) ok = ok && (xb_ld(&barw[3520 + 64 * j]) == 32u);
        if (ok) xst[2] = xst[3] * 8u + xb.x;
    }
    __syncthreads();
    gemm_zin(L);
    xcd_barrier(xb);
    mlstm_phase(L);
    asm volatile("s_waitcnt vmcnt(0)" ::: "memory");
    rglru_phase<false>(L);
    xcd_barrier(xb);
    rglru_carry_phase();
    asm volatile("s_waitcnt vmcnt(0)" ::: "memory");
    mlstm_combine_phase();
    xcd_barrier(xb);
    rglru_phase<true>(L);
    xcd_barrier(xb);
    gemm_res0(L);
    xcd_barrier(xb);
    gemm_up(L, 0);
    xcd_barrier(xb);
    gemm_down0(L);
    xcd_barrier(xb);
    gemm_qkv(L);
    xcd_barrier(xb);
    attn_phase(L);
    xcd_barrier(xb);
    attn_merge_phase();
    xcd_barrier(xb);
    gemm_res1(L);
    xcd_barrier(xb);
    gemm_up(L, 1);
    xcd_barrier(xb);
    gemm_down1(L);
    xcd_barrier(xb);
    norm_final();
}

extern "C" void kernel_launch(void* const* d_in, const int* in_sizes, int n_in, void* d_out, int out_size, void* d_ws, size_t ws_size, hipStream_t stream) {
    static int grid_blocks = 0;
    if (!grid_blocks) {
        int dev = 0, cus = 0, per_cu = 0;
        hipGetDevice(&dev);
        hipDeviceGetAttribute(&cus, hipDeviceAttributeMultiprocessorCount, dev);
        hipFuncSetAttribute((const void*)mega_fwd, hipFuncAttributeMaxDynamicSharedMemorySize, LDS_BYTES);
        hipOccupancyMaxActiveBlocksPerMultiprocessor(&per_cu, (const void*)mega_fwd, 512, LDS_BYTES);
        if (per_cu < 1) per_cu = 1;
        grid_blocks = cus * per_cu;
        if (ws_size < WS_END) fprintf(stderr, "workspace too small: %zu < %zu\n", ws_size, (size_t)WS_END);
    }
    Params p; memset(&p, 0, sizeof(p));
    const float** ptrs = (const float**)&p;
    for (int i = 0; i < 21; ++i) ptrs[i] = (const float*)d_in[i];
    p.out = (float*)d_out; p.ws = (unsigned char*)d_ws;
    unsigned char* ws = (unsigned char*)d_ws;
    int ns = 0, tot = 0;
    auto add = [&](const float* src, size_t dst_off, int ld, int K, int N, int mode, int rowoff, const float* gain) {
        Seg& s = p.seg[ns++]; s.src = src; s.dst = (u16*)(ws + dst_off); s.gain = gain; s.ld = ld; s.K = K; s.nN32 = N / 32; s.mode = mode; s.rowoff = rowoff; s.ntiles = (K / 64) * (N / 32); tot += s.ntiles; };
    add(p.e_w_in, OFF_WIN, DIN_, D_, 3072, 0, 0, nullptr);
    add(p.e_w_in + 3088, OFF_WIN, DIN_, D_, 2048, 0, 3072, nullptr);
    add(p.e_w_out, OFF_WOUT, D_, D_, D_, 0, 0, nullptr);
    add(p.o_w_qkv, OFF_WQKV, QC_, D_, QC_, 0, 0, p.o_norm);
    add(p.o_w_o, OFF_WO, D_, D_, D_, 0, 0, nullptr);
    for (int l = 0; l < 2; ++l) {
        add(p.f_w1 + (size_t)l * D_ * DFF_, OFF_W13 + l * SZ_W13, DFF_, D_, DFF_, 1, 0, p.f_norm + l * D_);
        add(p.f_w3 + (size_t)l * D_ * DFF_, OFF_W13 + l * SZ_W13, DFF_, D_, DFF_, 1, 128, p.f_norm + l * D_);
        add(p.f_w2 + (size_t)l * DFF_ * D_, OFF_W2 + l * SZ_W2, D_, DFF_, D_, 0, 0, nullptr);
    }
    p.nseg = ns; p.total_tiles = tot;
    hipMemsetAsync((unsigned char*)d_ws + OFF_BAR, 0, 16384, stream);
    void* args[] = {&p};
    hipError_t e = hipLaunchCooperativeKernel((const void*)mega_fwd, dim3(grid_blocks), dim3(512), args, LDS_BYTES, stream);
    if (e != hipSuccess) fprintf(stderr, "cooperative launch failed: %s (grid %d)\n", hipGetErrorString(e), grid_blocks);
}
```

```cpp
#include <hip/hip_runtime.h>
#include <hip/hip_cooperative_groups.h>
#include <cstdio>
#include <cstring>
namespace cg = cooperative_groups;
namespace pg8 {
#define PG8_LAS __attribute__((address_space(3)))
typedef unsigned short bf16_t;
typedef short bf16x8 __attribute__((ext_vector_type(8)));
typedef float f32x4 __attribute__((ext_vector_type(4)));
typedef unsigned u32x4 __attribute__((ext_vector_type(4)));
constexpr int BM = 256, BK = 64, HALF = 128, HTB = HALF * BK * 2  , STAGE_BYTES = 8 * HTB, NXCD = 8, WGM = 4;

__host__ __device__ __forceinline__ int lds_byte(int r, int c) { const int st = (r >> 4) * 2 + (c >> 5), rr = r & 15, cc = c & 31, ob = rr * 64 + cc * 2; return st * 1024 + (ob ^ (((ob >> 9) & 1) << 5)); }
__host__ __device__ __forceinline__ void stage_rc(int b, int& R, int& C) { const int st = b / 1024, sb = b % 1024, swz = sb ^ (((sb >> 9) & 1) << 5); R = (st >> 1) * 16 + swz / 64; C = (st & 1) * 32 + (swz % 64) / 2; }
__host__ __device__ __forceinline__ int perm32(int rho) { const int n = rho >> 4, i = rho & 15; return 8 * (i >> 2) + 4 * n + (i & 3); }

struct Unit { int pm, pn; };
struct Gemm { const bf16_t* A; const bf16_t* Bt; int M, N, K; };

struct StaticOrder {
    int nM, nN, nwg, G, c;
    __host__ __device__ void init(int M, int N, int G_, int c_) { nM = M / BM; nN = N / BM; nwg = nM * nN; G = G_; c = c_; }
    __host__ __device__ bool next(int i, Unit& u) const {
        const long L = (long)i * G + c; if (L >= nwg) return false;
        int wgid = (int)L; { const int q = nwg / NXCD, r = nwg % NXCD, xcd = wgid % NXCD, off = wgid / NXCD; wgid = (xcd < r ? xcd * (q + 1) : r * (q + 1) + (xcd - r) * q) + off; }
        const int nig = WGM * nN, gid = wgid / nig, fm = gid * WGM, gsz = (nM - fm) < WGM ? (nM - fm) : WGM;
        u.pm = fm + ((wgid % nig) % gsz); u.pn = (wgid % nig) / gsz; return true;
    }
    __device__ __forceinline__ void a_ready(const Unit&) const {}
    __device__ __forceinline__ void done(const Unit&) const {}
};
__device__ __forceinline__ unsigned cvt_pk_bf16(float lo, float hi) { unsigned r; asm volatile("v_cvt_pk_bf16_f32 %0, %1, %2" : "=v"(r) : "v"(lo), "v"(hi)); return r; }
typedef float f32x2 __attribute__((ext_vector_type(2)));
typedef unsigned u32x4 __attribute__((ext_vector_type(4)));
typedef unsigned u32x2 __attribute__((ext_vector_type(2)));
struct EpiStoreBf16 {
    static constexpr bool PERM = true, AFTER_DRAIN = false;
    bf16_t* O; int ldc; const float* ss; int headmajor;
    __device__ __forceinline__ void operator()(const f32x4 (&acc)[2][2][4][2], const Unit& u, int wr, int wc, int fr, int fq) const {
        const int row0 = u.pm * BM + wr * 64 + fr, col0 = u.pn * BM + wc * 32 + 8 * fq;
        float rs[2][4];
#pragma unroll
        for (int ai = 0; ai < 2; ++ai)
#pragma unroll
            for (int m = 0; m < 4; ++m) rs[ai][m] = ss ? ss[row0 + ai * HALF + m * 16] : 0.f;
#pragma unroll
        for (int ai = 0; ai < 2; ++ai)
#pragma unroll
            for (int m = 0; m < 4; ++m) rs[ai][m] = ss ? rsqrtf(rs[ai][m] * (1.0f / 2048.0f) + 1e-6f) : 1.0f;
#pragma unroll
        for (int ai = 0; ai < 2; ++ai)
#pragma unroll
            for (int m = 0; m < 4; ++m) { const int row = row0 + ai * HALF + m * 16;
                bf16_t* rowp = headmajor ? O + ((size_t)((col0 >> 11) * 128 + (row >> 12) * 16 + ((col0 >> 7) & 15)) * 4096 + (row & 4095)) * 128 + (col0 & 127)
                                         : O + (size_t)row * ldc + col0;
                const size_t bjstep = headmajor ? (size_t)4096 * 128 : (size_t)HALF;
#pragma unroll
                for (int bj = 0; bj < 2; ++bj) { const f32x4 v0 = acc[ai][bj][m][0] * rs[ai][m], v1 = acc[ai][bj][m][1] * rs[ai][m];
                    u32x4 w; w.x = cvt_pk_bf16(v0[0], v0[1]); w.y = cvt_pk_bf16(v0[2], v0[3]); w.z = cvt_pk_bf16(v1[0], v1[1]); w.w = cvt_pk_bf16(v1[2], v1[3]);
                    *(u32x4*)(rowp + bj * bjstep) = w; } }
    }
};
struct EpiResF32 {
    static constexpr bool PERM = false, AFTER_DRAIN = false;
    float* C; const float* base; int ldc; bf16_t* XB; float* ss;
    __device__ __forceinline__ void operator()(const f32x4 (&acc)[2][2][4][2], const Unit& u, int wr, int wc, int fr, int fq) const {
        const int row0 = u.pm * BM + wr * 64 + fr, col0 = u.pn * BM + wc * 32 + 4 * fq;
        float sq[2][4];
#pragma unroll
        for (int ai = 0; ai < 2; ++ai)
#pragma unroll
            for (int m = 0; m < 4; ++m) sq[ai][m] = 0.f;
#pragma unroll
        for (int bj = 0; bj < 2; ++bj)
#pragma unroll
          for (int ai = 0; ai < 2; ++ai) {
            f32x4 bv[4][2];
#pragma unroll
            for (int m = 0; m < 4; ++m)
#pragma unroll
                for (int n = 0; n < 2; ++n) bv[m][n] = *(const f32x4*)(base + (size_t)(row0 + ai * HALF + m * 16) * ldc + col0 + bj * HALF + n * 16);
#pragma unroll
            for (int m = 0; m < 4; ++m)
#pragma unroll
                for (int n = 0; n < 2; ++n) { const size_t off = (size_t)(row0 + ai * HALF + m * 16) * ldc + col0 + bj * HALF + n * 16;
                    const f32x4 r = acc[ai][bj][m][n] + bv[m][n];
                    *(f32x4*)(C + off) = r;
                    if (XB) { sq[ai][m] += r[0] * r[0] + r[1] * r[1] + r[2] * r[2] + r[3] * r[3]; u32x2 w; w.x = cvt_pk_bf16(r[0], r[1]); w.y = cvt_pk_bf16(r[2], r[3]); *(u32x2*)(XB + off) = w; } }
          }
        if (XB) {
#pragma unroll
            for (int ai = 0; ai < 2; ++ai)
#pragma unroll
                for (int m = 0; m < 4; ++m) { float s = sq[ai][m]; s += __shfl_xor(s, 16); s += __shfl_xor(s, 32); if (fq == 0) unsafeAtomicAdd(ss + row0 + ai * HALF + m * 16, s); } }
    }
};
__device__ __forceinline__ float silu_mul(float a, float b) { return a * __builtin_amdgcn_rcpf(1.0f + __expf(-a)) * b; }
struct EpiSwiGLU {
    static constexpr bool PERM = true, AFTER_DRAIN = false;
    bf16_t* O; int ldc; const float* ss;
    __device__ __forceinline__ void operator()(const f32x4 (&acc)[2][2][4][2], const Unit& u, int wr, int wc, int fr, int fq) const {
        const int row0 = u.pm * BM + wr * 64 + fr, col0 = u.pn * HALF + wc * 32 + 8 * fq;
        float rs[2][4];
#pragma unroll
        for (int ai = 0; ai < 2; ++ai)
#pragma unroll
            for (int m = 0; m < 4; ++m) rs[ai][m] = ss[row0 + ai * HALF + m * 16];
#pragma unroll
        for (int ai = 0; ai < 2; ++ai)
#pragma unroll
            for (int m = 0; m < 4; ++m) rs[ai][m] = rsqrtf(rs[ai][m] * (1.0f / 2048.0f) + 1e-6f);
#pragma unroll
        for (int ai = 0; ai < 2; ++ai)
#pragma unroll
            for (int m = 0; m < 4; ++m) { bf16_t* rowp = O + (size_t)(row0 + ai * HALF + m * 16) * ldc + col0;
                const f32x4 a0 = acc[ai][0][m][0] * rs[ai][m], a1 = acc[ai][0][m][1] * rs[ai][m], b0 = acc[ai][1][m][0] * rs[ai][m], b1 = acc[ai][1][m][1] * rs[ai][m];
                u32x4 w; w.x = cvt_pk_bf16(silu_mul(a0[0], b0[0]), silu_mul(a0[1], b0[1])); w.y = cvt_pk_bf16(silu_mul(a0[2], b0[2]), silu_mul(a0[3], b0[3]));
                w.z = cvt_pk_bf16(silu_mul(a1[0], b1[0]), silu_mul(a1[1], b1[1])); w.w = cvt_pk_bf16(silu_mul(a1[2], b1[2]), silu_mul(a1[3], b1[3]));
                *(u32x4*)rowp = w; }
    }
};

template <bool BASE_BF16, bool OUT_F32, bool OUT_BF16>
struct EpiRes {
    static constexpr bool PERM = true, AFTER_DRAIN = false;
    const void* base; float* C; bf16_t* XB; float* ss; int ldc;
    __device__ __forceinline__ void operator()(const f32x4 (&acc)[2][2][4][2], const Unit& u, int wr, int wc, int fr, int fq) const {
        const int row0 = u.pm * BM + wr * 64 + fr, col0 = u.pn * BM + wc * 32 + 8 * fq;
        constexpr int NA = BASE_BF16 ? 2 : 1;
        float sq[2][4];
#pragma unroll
        for (int ai = 0; ai < 2; ++ai)
#pragma unroll
            for (int m = 0; m < 4; ++m) sq[ai][m] = 0.f;
#pragma unroll
        for (int bj = 0; bj < 2; ++bj)
#pragma unroll
          for (int a0 = 0; a0 < 2; a0 += NA) {
            u32x4 raw[NA][4]; f32x4 f0[NA][4], f1[NA][4];
#pragma unroll
            for (int da = 0; da < NA; ++da)
#pragma unroll
                for (int m = 0; m < 4; ++m) { const size_t off = (size_t)(row0 + (a0 + da) * HALF + m * 16) * ldc + col0 + bj * HALF;
                    if (BASE_BF16) raw[da][m] = *(const u32x4*)((const bf16_t*)base + off);
                    else { f0[da][m] = *(const f32x4*)((const float*)base + off); f1[da][m] = *(const f32x4*)((const float*)base + off + 4); } }
#pragma unroll
            for (int da = 0; da < NA; ++da)
#pragma unroll
                for (int m = 0; m < 4; ++m) { const int ai = a0 + da; const size_t off = (size_t)(row0 + ai * HALF + m * 16) * ldc + col0 + bj * HALF;
                    f32x4 b0, b1;
                    if (BASE_BF16) { const u32x4 w = raw[da][m];
                        b0 = (f32x4){__uint_as_float(w.x << 16), __uint_as_float(w.x & 0xffff0000u), __uint_as_float(w.y << 16), __uint_as_float(w.y & 0xffff0000u)};
                        b1 = (f32x4){__uint_as_float(w.z << 16), __uint_as_float(w.z & 0xffff0000u), __uint_as_float(w.w << 16), __uint_as_float(w.w & 0xffff0000u)}; }
                    else { b0 = f0[da][m]; b1 = f1[da][m]; }
                    const f32x4 r0 = acc[ai][bj][m][0] + b0, r1 = acc[ai][bj][m][1] + b1;
                    if (OUT_F32) { *(f32x4*)(C + off) = r0; *(f32x4*)(C + off + 4) = r1; }
                    if (OUT_BF16) { sq[ai][m] += (r0[0] * r0[0] + r0[1] * r0[1] + r0[2] * r0[2] + r0[3] * r0[3]) + (r1[0] * r1[0] + r1[1] * r1[1] + r1[2] * r1[2] + r1[3] * r1[3]);
                        u32x4 w; w.x = cvt_pk_bf16(r0[0], r0[1]); w.y = cvt_pk_bf16(r0[2], r0[3]); w.z = cvt_pk_bf16(r1[0], r1[1]); w.w = cvt_pk_bf16(r1[2], r1[3]);
                        *(u32x4*)(XB + off) = w; } }
          }
        if (OUT_BF16) {
#pragma unroll
            for (int ai = 0; ai < 2; ++ai)
#pragma unroll
                for (int m = 0; m < 4; ++m) { float s = sq[ai][m]; s += __shfl_xor(s, 16); s += __shfl_xor(s, 32); if (fq == 0) unsafeAtomicAdd(ss + row0 + ai * HALF + m * 16, s); } }
    }
};
template <class Epi, class Sched, bool STAMP = false>
__device__ __forceinline__ void gemm_phase(PG8_LAS unsigned char* lds, const Gemm g, const Sched& S, const Epi& E, unsigned long long* stamps) {
    int tid_ = threadIdx.x; asm volatile("" : "+v"(tid_)); const int tid = tid_, wid = __builtin_amdgcn_readfirstlane(tid >> 6), lane = tid & 63, wr = wid >> 2, wc = wid & 3, fr = lane & 15, fq = lane >> 4;
    const int K = g.K, nt = K / BK;
    int ts_lo = 0, ts_hi = 0, nts = 0; const unsigned long long rt_entry = STAMP ? (unsigned long long)wall_clock64() : 0ull;
#define PG8_STAMP() do { if (STAMP && wid == 0 && nts < 64) { const unsigned long long _c = (unsigned long long)clock64(); \
        ts_lo = (lane == nts) ? (int)(unsigned)_c : ts_lo; ts_hi = (lane == nts) ? (int)(unsigned)(_c >> 32) : ts_hi; ++nts; } } while (0)
    PG8_STAMP();
    unsigned voffA[2], voffB[2];
#pragma unroll
    for (int i = 0; i < 2; ++i) { int R, C; stage_rc(tid * 16 + i * 8192, R, C); const int Rb = Epi::PERM ? ((R & ~31) + perm32(R & 31)) : R;
        voffA[i] = (unsigned)(R * K + C) * 2u; voffB[i] = (unsigned)(Rb * K + C) * 2u; }
    const size_t kstep = (size_t)(BK * 2);
    const size_t hstep = (size_t)HALF * K * 2;
    const size_t tstep = 2 * hstep;
    const unsigned ldsw = (unsigned)wid * 1024u;
    const int aoff = lds_byte(wr * 64 + fr, fq * 8), boff = lds_byte(wc * 32 + fr, fq * 8);
#define PG8_SA(b, h) (((b) * 2 + (h)) * HTB)
#define PG8_SB(b, h) ((4 + (b) * 2 + (h)) * HTB)
#define PG8_STAGE(bufoff, gbase, voff) do { _Pragma("unroll") for (int _i = 0; _i < 2; ++_i) \
        __builtin_amdgcn_global_load_lds((const unsigned*)((const char*)(gbase) + (voff)[_i]), (PG8_LAS unsigned*)(lds + (bufoff) + ldsw + _i * 8192), 16, 0, 0); } while (0)
#define PG8_LDA(dst, b, h) do { _Pragma("unroll") for (int m = 0; m < 4; ++m) _Pragma("unroll") for (int k = 0; k < 2; ++k) dst[m][k] = *(const PG8_LAS bf16x8*)(lds + PG8_SA(b, h) + aoff + m * 2048 + k * 1024); } while (0)
#define PG8_LDB(dst, b, h) do { _Pragma("unroll") for (int n = 0; n < 2; ++n) _Pragma("unroll") for (int k = 0; k < 2; ++k) dst[n][k] = *(const PG8_LAS bf16x8*)(lds + PG8_SB(b, h) + boff + n * 2048 + k * 1024); } while (0)
#define PG8_MMA(ai, bj, At, Bt) do { __builtin_amdgcn_s_setprio(1); _Pragma("unroll") for (int m = 0; m < 4; ++m) _Pragma("unroll") for (int n = 0; n < 2; ++n) _Pragma("unroll") for (int k = 0; k < 2; ++k) \
        acc[ai][bj][m][n] = __builtin_amdgcn_mfma_f32_16x16x32_bf16(Bt[n][k], At[m][k], acc[ai][bj][m][n], 0, 0, 0); __builtin_amdgcn_s_setprio(0); } while (0)
#define PG8_WAIT_V(n) asm volatile("s_waitcnt vmcnt(" #n ")" ::: "memory")
#define PG8_WAIT_L(n) asm volatile("s_waitcnt lgkmcnt(" #n ")" ::: "memory")
#define PG8_BAR __builtin_amdgcn_s_barrier()
#define PG8_SCHED __builtin_amdgcn_sched_barrier(0)
    Unit cur, nxt; int ui = 0;
    if (!S.next(0, cur)) return;
    f32x4 acc[2][2][4][2];
#pragma unroll
    for (int a = 0; a < 2; ++a)
#pragma unroll
        for (int b = 0; b < 2; ++b)
#pragma unroll
            for (int m = 0; m < 4; ++m)
#pragma unroll
                for (int n = 0; n < 2; ++n) acc[a][b][m][n] = (f32x4){0.f, 0.f, 0.f, 0.f};
    bf16x8 At[4][2], B0[2][2], B1[2][2];
    const char* cA = (const char*)g.A + (size_t)cur.pm * tstep; const char* cB = (const char*)g.Bt + (size_t)cur.pn * tstep;
    S.a_ready(cur);
    PG8_STAGE(PG8_SB(0, 0), cB, voffB); PG8_STAGE(PG8_SA(0, 0), cA, voffA); PG8_STAGE(PG8_SB(0, 1), cB + hstep, voffB); PG8_STAGE(PG8_SA(0, 1), cA + hstep, voffA);
    if (wr == 1) PG8_BAR;
    PG8_WAIT_V(4); PG8_BAR;
    PG8_STAGE(PG8_SB(1, 0), cB + kstep, voffB); PG8_STAGE(PG8_SA(1, 0), cA + kstep, voffA); PG8_STAGE(PG8_SB(1, 1), cB + hstep + kstep, voffB);
    PG8_WAIT_V(6); PG8_BAR;
    PG8_STAMP();
    for (;;) {
        const bool has_next = S.next(ui + 1, nxt);
        const char* nA = has_next ? (const char*)g.A + (size_t)nxt.pm * tstep : cA; const char* nB = has_next ? (const char*)g.Bt + (size_t)nxt.pn * tstep : cB;
        for (int t = 0; t < nt; t += 2) {
            const bool last = (t == nt - 2);
            const char* a1 = cA + (size_t)(t + 1) * kstep;
            const char* a2 = last ? nA : cA + (size_t)(t + 2) * kstep; const char* b2 = last ? nB : cB + (size_t)(t + 2) * kstep;
            const char* a3 = a2 + kstep; const char* b3 = b2 + kstep;
            if (last && has_next) S.a_ready(nxt);
            PG8_LDB(B0, 0, 0); PG8_SCHED; PG8_LDA(At, 0, 0); PG8_STAGE(PG8_SA(1, 1), a1 + hstep, voffA);
            PG8_WAIT_L(8); PG8_BAR; PG8_WAIT_L(0); PG8_MMA(0, 0, At, B0); PG8_BAR; PG8_SCHED;
            PG8_LDB(B1, 0, 1); PG8_STAGE(PG8_SB(0, 0), b2, voffB);
            PG8_BAR; PG8_WAIT_L(0); PG8_MMA(0, 1, At, B1); PG8_BAR;
            PG8_LDA(At, 0, 1); PG8_STAGE(PG8_SA(0, 0), a2, voffA);
            PG8_BAR; PG8_WAIT_L(0); PG8_MMA(1, 0, At, B0); PG8_BAR; PG8_SCHED;
            PG8_STAGE(PG8_SB(0, 1), b2 + hstep, voffB);
            PG8_WAIT_V(6); PG8_BAR; PG8_MMA(1, 1, At, B1); PG8_BAR;
            PG8_LDB(B0, 1, 0); PG8_SCHED; PG8_LDA(At, 1, 0); PG8_STAGE(PG8_SA(0, 1), a2 + hstep, voffA);
            PG8_WAIT_L(8); PG8_BAR; PG8_WAIT_L(0); PG8_MMA(0, 0, At, B0); PG8_BAR; PG8_SCHED;
            PG8_LDB(B1, 1, 1); PG8_STAGE(PG8_SB(1, 0), b3, voffB);
            PG8_BAR; PG8_WAIT_L(0); PG8_MMA(0, 1, At, B1); PG8_BAR;
            PG8_LDA(At, 1, 1); PG8_STAGE(PG8_SA(1, 0), a3, voffA);
            PG8_BAR; PG8_WAIT_L(0); PG8_MMA(1, 0, At, B0); PG8_BAR; PG8_SCHED;
            PG8_STAGE(PG8_SB(1, 1), b3 + hstep, voffB);
            PG8_WAIT_V(6); PG8_BAR; PG8_MMA(1, 1, At, B1); PG8_BAR;
        }
        PG8_STAMP();
        if constexpr (!Epi::AFTER_DRAIN) { E(acc, cur, wr, wc, fr, fq); S.done(cur); }
        PG8_STAMP();
        if (!has_next) break;
#pragma unroll
        for (int a = 0; a < 2; ++a)
#pragma unroll
            for (int b = 0; b < 2; ++b)
#pragma unroll
                for (int m = 0; m < 4; ++m)
#pragma unroll
                    for (int n = 0; n < 2; ++n) acc[a][b][m][n] = (f32x4){0.f, 0.f, 0.f, 0.f};
        cur = nxt; cA = nA; cB = nB; ++ui;
    }
    PG8_WAIT_V(0);
    if (wr == 0) PG8_BAR;
    PG8_BAR;
    if constexpr (Epi::AFTER_DRAIN) { E.fused(acc, cur, wr, wc, fr, fq, lds, wid, lane); S.done(cur); }
    PG8_STAMP();
    if (STAMP && wid == 0) { stamps[lane] = lane < nts ? (((unsigned long long)(unsigned)ts_hi << 32) | (unsigned)ts_lo) : 0ull;
        if (lane == 62) stamps[62] = rt_entry; if (lane == 63) stamps[63] = (unsigned long long)wall_clock64(); }
#undef PG8_STAMP
#undef PG8_SA
#undef PG8_SB
#undef PG8_STAGE
#undef PG8_LDA
#undef PG8_LDB
#undef PG8_MMA
#undef PG8_WAIT_V
#undef PG8_WAIT_L
#undef PG8_BAR
#undef PG8_SCHED
}
}

#define LAS __attribute__((address_space(3)))
typedef unsigned short u16;
typedef short bf16x8 __attribute__((ext_vector_type(8)));
typedef short bf16x4 __attribute__((ext_vector_type(4)));
typedef float f32x4 __attribute__((ext_vector_type(4)));
typedef unsigned u32x4 __attribute__((ext_vector_type(4)));
typedef unsigned u32x2 __attribute__((ext_vector_type(2)));

constexpr int T_ = 32768, S_ = 4096, D_ = 2048, DFF_ = 5632, DIN_ = 5136, ZC_ = 5120, QC_ = 6144;
constexpr int LDS_MAIN = 139264, LDS_BYTES = LDS_MAIN + 16;
constexpr size_t SZ_WIN = (size_t)ZC_ * D_ * 2, SZ_WSQ = (size_t)D_ * D_ * 2, SZ_WQKV = (size_t)QC_ * D_ * 2, SZ_W13 = (size_t)2 * DFF_ * D_ * 2, SZ_W2 = (size_t)D_ * DFF_ * 2;
constexpr size_t OFF_WIN = 0, OFF_WOUT = OFF_WIN + SZ_WIN, OFF_WQKV = OFF_WOUT + SZ_WSQ, OFF_WO = OFF_WQKV + SZ_WQKV, OFF_W13 = OFF_WO + SZ_WSQ, OFF_W2 = OFF_W13 + 2 * SZ_W13,
                 OFF_WRG = OFF_W2 + 2 * SZ_W2, OFF_XN = OFF_WRG + (size_t)64 * 16384 * 2, OFF_BIG = OFF_XN + (size_t)T_ * D_ * 2, OFF_MIX = OFF_BIG + (size_t)T_ * QC_ * 2,
                 OFF_GATES = OFF_MIX + (size_t)T_ * D_ * 4, OFF_RGSUM = OFF_GATES + (size_t)T_ * 16 * 4, OFF_RGCAR = OFF_RGSUM + (size_t)8 * 64 * 2 * 1024 * 8,
                 OFF_LSE = OFF_RGCAR + (size_t)8 * 64 * 2 * 1024 * 4, OFF_SS = OFF_LSE + (size_t)3 * T_ * 16 * 4, OFF_BAR = OFF_SS + (size_t)4 * T_ * 4, WS_END = OFF_BAR + 16384;

struct Seg { const float* src; u16* dst; const float* gain; int ld, K, nN32, mode, rowoff, ntiles; };
struct Params {
    const float *x, *e_norm, *e_w_in, *e_gate_b, *e_conv_w, *e_conv_b, *e_rg_wa, *e_rg_ba, *e_rg_wx, *e_rg_bx, *e_rg_lam, *e_head_g, *e_w_out, *o_norm, *o_w_qkv, *o_w_o, *f_norm, *f_w1, *f_w3, *f_w2, *final_norm;
    float* out; unsigned char* ws;
    Seg seg[12]; int nseg, total_tiles;
};


typedef const __attribute__((address_space(4))) Params* PP;
__device__ __forceinline__ PP get_params() { auto k = __builtin_amdgcn_kernarg_segment_ptr(); asm volatile("" : "+s"(k)); return (PP)k; }
__device__ __forceinline__ int l_tid() { int t = threadIdx.x; asm volatile("" : "+v"(t)); return t; }
extern __shared__ __attribute__((aligned(16))) unsigned char lds_raw[];
__device__ __forceinline__ int l_bid() { int t = __builtin_amdgcn_readfirstlane(*(volatile LAS int*)((LAS unsigned char*)lds_raw + 139264 + 8)); asm volatile("" : "+s"(t)); return t; }
__device__ __forceinline__ int l_nblk() { int t = gridDim.x; asm volatile("" : "+s"(t)); return t; }
__device__ __forceinline__ unsigned pk2(float lo, float hi) { return pg8::cvt_pk_bf16(lo, hi); }
__device__ __forceinline__ float bflo(unsigned w) { return __uint_as_float(w << 16); }
__device__ __forceinline__ float bfhi(unsigned w) { return __uint_as_float(w & 0xffff0000u); }
__device__ __forceinline__ float wave_sum(float v) {
#pragma unroll
    for (int o = 1; o < 64; o <<= 1) v += __shfl_xor(v, o);
    return v;
}
__device__ __forceinline__ bf16x8 cat8(bf16x4 a, bf16x4 b) { return __builtin_shufflevector(a, b, 0, 1, 2, 3, 4, 5, 6, 7); }
__device__ __forceinline__ bf16x4 lds_tr(LAS unsigned char* p) { return __builtin_amdgcn_ds_read_tr16_b64_v4i16((LAS bf16x4*)p); }
__device__ __forceinline__ bf16x8 lds_r8(LAS unsigned char* p) { return *(LAS bf16x8*)p; }
__device__ __forceinline__ bf16x8 as_bf16x8(u32x4 v) { union { u32x4 u; bf16x8 b; } c; c.u = v; return c.b; }
#define MFMA16(a, b, c) __builtin_amdgcn_mfma_f32_16x16x32_bf16((a), (b), (c), 0, 0, 0)
#define LDSWAIT() asm volatile("s_waitcnt lgkmcnt(0)" ::: "memory")
__device__ __forceinline__ float sigmoidf_(float v) { return __builtin_amdgcn_rcpf(1.0f + __expf(-v)); }

__device__ __forceinline__ void transpose_item(const float* src, const float* gain, int ld, u16* dst, int K, int nN32, int mode, int rowoff, int item, LAS float* scr, int lane) {
    const int nb = item % nN32, kb = item / nN32, k0 = 64 * kb, n0 = 32 * nb;
#pragma unroll 8
    for (int i = 0; i < 32; ++i) { const int kk = 2 * i + (lane >> 5); scr[kk * 33 + (lane & 31)] = src[(size_t)(k0 + kk) * ld + n0 + (lane & 31)]; }
    LDSWAIT();
    const int R0 = mode ? (((n0 >> 7) << 8) + (n0 & 127) + rowoff) : (n0 + rowoff);
    const int c = lane & 7;
    f32x4 g0 = (f32x4){1.f, 1.f, 1.f, 1.f}, g1 = g0;
    if (gain) { g0 = *(const f32x4*)(gain + k0 + 8 * c); g1 = *(const f32x4*)(gain + k0 + 8 * c + 4); }
#pragma unroll
    for (int j = 0; j < 4; ++j) { const int n = (lane >> 3) + 8 * j; const LAS float* s = scr + (8 * c) * 33 + n;
        u32x4 o; o.x = pk2(s[0 * 33] * g0.x, s[1 * 33] * g0.y); o.y = pk2(s[2 * 33] * g0.z, s[3 * 33] * g0.w); o.z = pk2(s[4 * 33] * g1.x, s[5 * 33] * g1.y); o.w = pk2(s[6 * 33] * g1.z, s[7 * 33] * g1.w);
        *(u32x4*)(dst + (size_t)(R0 + n) * K + k0 + 8 * c) = o; }
    LDSWAIT();
}

__device__ __forceinline__ void phase0(LAS unsigned char* L) { PP p = get_params();
    const int tid = l_tid(), lane = tid & 63, wid = tid >> 6;
    const int gw = l_bid() * 8 + wid, NGW = l_nblk() * 8;
    LAS float* scr = (LAS float*)(L + wid * 8704);
    for (int it = gw; it < p->total_tiles; it += NGW) {
        int r = it, si = 0;
        while (r >= p->seg[si].ntiles) { r -= p->seg[si].ntiles; ++si; }
        transpose_item(p->seg[si].src, p->seg[si].gain, p->seg[si].ld, p->seg[si].dst, p->seg[si].K, p->seg[si].nN32, p->seg[si].mode, p->seg[si].rowoff, r, scr, lane);
    }
    for (int it = gw; it < 256; it += NGW) {
        const int mi = it >> 3, sub = it & 7, mat = mi >> 4, dn = mi & 15;
        const float* src = (mat ? p->e_rg_wx : p->e_rg_wa) + (size_t)dn * 16384;
        u16* dst = (u16*)(p->ws + OFF_WRG) + (size_t)((((dn >> 3) * 2 + mat) * 8) + (dn & 7)) * 16384;
        transpose_item(src, nullptr, 128, dst, 128, 4, 0, 0, sub, scr, lane);
    }
    asm volatile("s_waitcnt vmcnt(0)" ::: "memory");
    __syncthreads();
    { float* SSZ = (float*)(p->ws + OFF_SS); for (int i = l_bid() * 512 + tid; i < 4 * T_; i += l_nblk() * 512) SSZ[i] = 0.f; }
    LAS float* WgT = (LAS float*)L;
    for (int k = tid; k < D_; k += 512) {
        const float* s = p->e_w_in + (size_t)k * DIN_ + 3072;
#pragma unroll
        for (int c = 0; c < 4; ++c) { const f32x4 v = *(const f32x4*)(s + 4 * c);
            WgT[(4 * c + 0) * D_ + k] = v.x; WgT[(4 * c + 1) * D_ + k] = v.y; WgT[(4 * c + 2) * D_ + k] = v.z; WgT[(4 * c + 3) * D_ + k] = v.w; }
    }
    __syncthreads();
    u16* XN = (u16*)(p->ws + OFF_XN);
    float* GT = (float*)(p->ws + OFF_GATES);
    f32x4 gk[8];
#pragma unroll
    for (int i = 0; i < 8; ++i) gk[i] = *(const f32x4*)(p->e_norm + 256 * i + 4 * lane);
    const float gb = p->e_gate_b[(lane >> 1) & 15];
    for (int rp = gw; rp < T_ / 2; rp += NGW) {
        const float* x0 = p->x + (size_t)(2 * rp) * D_; const float* x1 = x0 + D_;
        f32x4 a[8], b[8]; float s0 = 0.f, s1 = 0.f;
#pragma unroll
        for (int i = 0; i < 8; ++i) { a[i] = *(const f32x4*)(x0 + 256 * i + 4 * lane); b[i] = *(const f32x4*)(x1 + 256 * i + 4 * lane);
            s0 += a[i].x * a[i].x + a[i].y * a[i].y + a[i].z * a[i].z + a[i].w * a[i].w; s1 += b[i].x * b[i].x + b[i].y * b[i].y + b[i].z * b[i].z + b[i].w * b[i].w; }
        const float r0 = rsqrtf(wave_sum(s0) * (1.0f / D_) + 1e-6f), r1 = rsqrtf(wave_sum(s1) * (1.0f / D_) + 1e-6f);
        u16* o0 = XN + (size_t)(2 * rp) * D_; u16* o1 = o0 + D_;
#pragma unroll
        for (int i = 0; i < 8; ++i) { a[i] = a[i] * r0 * gk[i]; b[i] = b[i] * r1 * gk[i];
            u32x2 w0, w1; w0.x = pk2(a[i].x, a[i].y); w0.y = pk2(a[i].z, a[i].w); w1.x = pk2(b[i].x, b[i].y); w1.y = pk2(b[i].z, b[i].w);
            *(u32x2*)(o0 + 256 * i + 4 * lane) = w0; *(u32x2*)(o1 + 256 * i + 4 * lane) = w1; }
        float v[32];
#pragma unroll
        for (int j = 0; j < 16; ++j) { float c0 = 0.f, c1 = 0.f;
#pragma unroll
            for (int i = 0; i < 8; ++i) { const f32x4 w = *(LAS f32x4*)(WgT + j * D_ + 256 * i + 4 * lane);
                c0 += a[i].x * w.x + a[i].y * w.y + a[i].z * w.z + a[i].w * w.w; c1 += b[i].x * w.x + b[i].y * w.y + b[i].z * w.z + b[i].w * w.w; }
            v[j] = c0; v[16 + j] = c1; }
#pragma unroll
        for (int j = 0; j < 16; ++j) { const bool hi = lane & 32; const float keep = hi ? v[j + 16] : v[j], send = hi ? v[j] : v[j + 16]; v[j] = keep + __shfl_xor(send, 32); }
#pragma unroll
        for (int j = 0; j < 8; ++j) { const bool hi = lane & 16; const float keep = hi ? v[j + 8] : v[j], send = hi ? v[j] : v[j + 8]; v[j] = keep + __shfl_xor(send, 16); }
#pragma unroll
        for (int j = 0; j < 4; ++j) { const bool hi = lane & 8; const float keep = hi ? v[j + 4] : v[j], send = hi ? v[j] : v[j + 4]; v[j] = keep + __shfl_xor(send, 8); }
#pragma unroll
        for (int j = 0; j < 2; ++j) { const bool hi = lane & 4; const float keep = hi ? v[j + 2] : v[j], send = hi ? v[j] : v[j + 2]; v[j] = keep + __shfl_xor(send, 4); }
        { const bool hi = lane & 2; const float keep = hi ? v[1] : v[0], send = hi ? v[0] : v[1]; v[0] = keep + __shfl_xor(send, 2); }
        v[0] += __shfl_xor(v[0], 1);
        if ((lane & 1) == 0) { const int idx = lane >> 1; GT[(size_t)(2 * rp + (idx >> 4)) * 16 + (idx & 15)] = v[0] + gb; }
    }
}

template <bool TO_F32>
__device__ __forceinline__ void norm_phase(const float* X, const float* g, u16* O, float* OF) {
    const int tid = l_tid(), lane = tid & 63, wid = tid >> 6;
    const int gw = l_bid() * 8 + wid, NGW = l_nblk() * 8;
    f32x4 gk[8];
#pragma unroll
    for (int i = 0; i < 8; ++i) gk[i] = *(const f32x4*)(g + 256 * i + 4 * lane);
    for (int row = gw; row < T_; row += NGW) {
        const float* x0 = X + (size_t)row * D_;
        f32x4 a[8]; float s0 = 0.f;
#pragma unroll
        for (int i = 0; i < 8; ++i) { a[i] = *(const f32x4*)(x0 + 256 * i + 4 * lane); s0 += a[i].x * a[i].x + a[i].y * a[i].y + a[i].z * a[i].z + a[i].w * a[i].w; }
        const float r0 = rsqrtf(wave_sum(s0) * (1.0f / D_) + 1e-6f);
#pragma unroll
        for (int i = 0; i < 8; ++i) { a[i] = a[i] * r0 * gk[i];
            if (TO_F32) *(f32x4*)(OF + (size_t)row * D_ + 256 * i + 4 * lane) = a[i];
            else { u32x2 w0; w0.x = pk2(a[i].x, a[i].y); w0.y = pk2(a[i].z, a[i].w); *(u32x2*)(O + (size_t)row * D_ + 256 * i + 4 * lane) = w0; } }
    }
}

__device__ __forceinline__ float scan_add64(float v, int lane) {
#pragma unroll
    for (int d = 1; d < 64; d <<= 1) { const float t = __shfl_up(v, d); if (lane >= d) v += t; }
    return v;
}
__device__ __forceinline__ float scan_max64(float v, int lane) {
#pragma unroll
    for (int d = 1; d < 64; d <<= 1) { const float t = __shfl_up(v, d); if (lane >= d) v = fmaxf(v, t); }
    return v;
}
struct GateV { float a, g, wsrc, winter, mout, decay, mnext; };
__device__ __forceinline__ GateV gate_math(float gi, float gf, float m_carry, int lane) {
    GateV o;
    const float lf = (gf >= 0.f) ? -log1pf(__expf(-gf)) : (gf - log1pf(__expf(gf)));
    const float b = scan_add64(lf, lane);
    o.a = gi - b;
    const float M = scan_max64(o.a, lane);
    o.g = fmaxf(m_carry, M);
    const float bL = __shfl(b, 63), g63 = __shfl(o.g, 63);
    o.wsrc = __expf(o.a - g63); o.decay = __expf(m_carry - g63); o.winter = __expf(m_carry - o.g); o.mout = b + o.g; o.mnext = bL + g63;
    return o;
}

__device__ __forceinline__ void mlstm_phase(LAS unsigned char* L) { PP p = get_params();
    const int tid = l_tid(), lane = tid & 63, wid = __builtin_amdgcn_readfirstlane(tid >> 6), l15 = lane & 15, quad = lane >> 4;
    const u16* Z = (const u16*)(p->ws + OFF_BIG);
    const float* GT = (const float*)(p->ws + OFF_GATES);
    u16* HB = (u16*)(p->ws + OFF_MIX);
    constexpr int QS = 0, KS = 17408, VS = 34816, VW = 46080, CB = 57344, GA = 79104, GB = GA + 16384, GM = GB + 16384, GC = GM + 16384;
    constexpr float QSCALE = 0.08838834764831845f;
    const int r = tid >> 3, pc = tid & 7;
    const int lt = wid & 3, dvh = wid >> 2, lidx = 16 * lt + l15;
    for (int item = l_bid(); item < 256; item += l_nblk()) {
        const int dvq = item & 3, dir = (item >> 2) & 1, hh = (item >> 3) & 3, b = item >> 5;
        const size_t tok0 = (size_t)b * S_;
        u32x4 nq0, nq1, nk0, nk1, nv;
        {   const int pp = r; const int t = dir ? (S_ - 1 - pp) : pp; const u16* zr = Z + (tok0 + t) * ZC_;
            nq0 = *(const u32x4*)(zr + hh * 128 + 8 * pc); nq1 = *(const u32x4*)(zr + hh * 128 + 64 + 8 * pc);
            nk0 = *(const u32x4*)(zr + 512 + hh * 128 + 8 * pc); nk1 = *(const u32x4*)(zr + 512 + hh * 128 + 64 + 8 * pc);
            nv = *(const u32x4*)(zr + 1024 + hh * 256 + dvq * 64 + 8 * pc); }
#pragma unroll 2
        for (int k = 0; k < 8; ++k) { const int c = wid + 8 * k; const int pl = 64 * c + lane; const int tl = dir ? (S_ - 1 - pl) : pl; const float* gr = GT + (tok0 + tl) * 16;
            const float gi = gr[(2 * dir) * 4 + hh], gf = gr[(2 * dir + 1) * 4 + hh];
            const float lf = (gf >= 0.f) ? -log1pf(__expf(-gf)) : (gf - log1pf(__expf(gf)));
            const float bb = scan_add64(lf, lane), aa = gi - bb, MM = scan_max64(aa, lane);
            *(LAS float*)(L + GA + (c * 64 + lane) * 4) = aa; *(LAS float*)(L + GB + (c * 64 + lane) * 4) = bb; *(LAS float*)(L + GM + (c * 64 + lane) * 4) = MM; }
        f32x4 Cacc[5];
#pragma unroll
        for (int i = 0; i < 5; ++i) Cacc[i] = (f32x4){0.f, 0.f, 0.f, 0.f};
        for (int i = tid; i < 1360; i += 512) *(LAS u32x4*)(L + CB + i * 16) = (u32x4){0u, 0u, 0u, 0u};
        __syncthreads();
        if (wid == 0) {
            float m = -1e30f, mine = 0.f;
            for (int c = 0; c < 64; ++c) { const float bL = *(LAS float*)(L + GB + (c * 64 + 63) * 4), M63 = *(LAS float*)(L + GM + (c * 64 + 63) * 4);
                mine = (lane == c) ? m : mine; m = bL + fmaxf(m, M63); }
            *(LAS float*)(L + GC + lane * 4) = mine;
        }
        __syncthreads();
#define MLSTM_STAGE(cs) do { \
            *(LAS u32x4*)(L + QS + r * 272 + pc * 16) = nq0; *(LAS u32x4*)(L + QS + r * 272 + 128 + pc * 16) = nq1; \
            *(LAS u32x4*)(L + KS + r * 272 + pc * 16) = nk0; *(LAS u32x4*)(L + KS + r * 272 + 128 + pc * 16) = nk1; \
            *(LAS u32x4*)(L + VS + r * 176 + pc * 16) = nv; \
            const float g63_ = fmaxf(*(LAS float*)(L + GC + (cs) * 4), *(LAS float*)(L + GM + ((cs) * 64 + 63) * 4)); \
            const float wr_ = __expf(*(LAS float*)(L + GA + ((cs) * 64 + r) * 4) - g63_); u32x4 sv; \
            sv.x = pk2(bflo(nv.x) * wr_, bfhi(nv.x) * wr_); sv.y = pk2(bflo(nv.y) * wr_, bfhi(nv.y) * wr_); sv.z = pk2(bflo(nv.z) * wr_, bfhi(nv.z) * wr_); sv.w = pk2(bflo(nv.w) * wr_, bfhi(nv.w) * wr_); \
            *(LAS u32x4*)(L + VW + r * 176 + pc * 16) = sv; \
            if (pc < 2) { u32x4 one = (u32x4){pc == 0 ? 0x3F80u : 0u, 0u, 0u, 0u}; u32x4 ws_ = (u32x4){pc == 0 ? (pk2(wr_, 0.f) & 0xffffu) : 0u, 0u, 0u, 0u}; \
                *(LAS u32x4*)(L + VS + r * 176 + 128 + pc * 16) = one; *(LAS u32x4*)(L + VW + r * 176 + 128 + pc * 16) = ws_; } \
        } while (0)
        MLSTM_STAGE(0);
        for (int c = 0; c < 64; ++c) {
            if (c + 1 < 64) {
                const int pp = 64 * (c + 1) + r; const int t = dir ? (S_ - 1 - pp) : pp; const u16* zr = Z + (tok0 + t) * ZC_;
                nq0 = *(const u32x4*)(zr + hh * 128 + 8 * pc); nq1 = *(const u32x4*)(zr + hh * 128 + 64 + 8 * pc);
                nk0 = *(const u32x4*)(zr + 512 + hh * 128 + 8 * pc); nk1 = *(const u32x4*)(zr + 512 + hh * 128 + 64 + 8 * pc);
                nv = *(const u32x4*)(zr + 1024 + hh * 256 + dvq * 64 + 8 * pc);
            }
            __syncthreads();
            const float m_c = *(LAS float*)(L + GC + c * 4);
            const float g63 = fmaxf(m_c, *(LAS float*)(L + GM + (c * 64 + 63) * 4));
            const float g_l = fmaxf(m_c, *(LAS float*)(L + GM + (c * 64 + lidx) * 4));
            const float winter_l = __expf(m_c - g_l), mout_l = *(LAS float*)(L + GB + (c * 64 + lidx) * 4) + g_l;
            bf16x8 qf[4];
#pragma unroll
            for (int ks = 0; ks < 4; ++ks) qf[ks] = lds_r8(L + QS + (16 * lt + l15) * 272 + (32 * ks + 8 * quad) * 2);
            f32x4 sacc[4];
#pragma unroll
            for (int st = 0; st < 4; ++st) { sacc[st] = (f32x4){0.f, 0.f, 0.f, 0.f};
                if (st <= lt) {
#pragma unroll
                    for (int ks = 0; ks < 4; ++ks) { const bf16x8 kf = lds_r8(L + KS + (16 * st + l15) * 272 + (32 * ks + 8 * quad) * 2); sacc[st] = MFMA16(kf, qf[ks], sacc[st]); } } }
            float pw[4][4];
#pragma unroll
            for (int st = 0; st < 4; ++st) { const f32x4 a4 = *(LAS f32x4*)(L + GA + (c * 64 + 16 * st + 4 * quad) * 4);
#pragma unroll
                for (int jj = 0; jj < 4; ++jj) { const int sidx = 16 * st + 4 * quad + jj;
                    const float w = (sidx <= lidx) ? __expf(a4[jj] - g_l) * QSCALE : 0.f; pw[st][jj] = sacc[st][jj] * w; } }
            bf16x8 pf[2];
#pragma unroll
            for (int i = 0; i < 2; ++i) { u32x4 t; t.x = pk2(pw[2 * i][0], pw[2 * i][1]); t.y = pk2(pw[2 * i][2], pw[2 * i][3]); t.z = pk2(pw[2 * i + 1][0], pw[2 * i + 1][1]); t.w = pk2(pw[2 * i + 1][2], pw[2 * i + 1][3]); pf[i] = as_bf16x8(t); }
            f32x4 nacc[3];
#pragma unroll
            for (int x = 0; x < 3; ++x) { const int dt = (x < 2) ? (2 * dvh + x) : 4; nacc[x] = (f32x4){0.f, 0.f, 0.f, 0.f};
#pragma unroll
                for (int ks = 0; ks < 4; ++ks) { const bf16x8 cf = lds_r8(L + CB + (16 * dt + l15) * 272 + (32 * ks + 8 * quad) * 2); nacc[x] = MFMA16(cf, qf[ks], nacc[x]); }
                nacc[x] = nacc[x] * (winter_l * QSCALE);
#pragma unroll
                for (int i = 0; i < 2; ++i) {
                    const bf16x4 lo = lds_tr(L + VS + (32 * i + 4 * quad + (l15 >> 2)) * 176 + (16 * dt + 4 * (l15 & 3)) * 2);
                    const bf16x4 hi = lds_tr(L + VS + (32 * i + 16 + 4 * quad + (l15 >> 2)) * 176 + (16 * dt + 4 * (l15 & 3)) * 2);
                    nacc[x] = MFMA16(cat8(lo, hi), pf[i], nacc[x]); } }
            const float den = __shfl(nacc[2][0], l15);
            const float inv = 1.0f / fmaxf(fabsf(den), __expf(-mout_l));
            {   const int pp = 64 * c + lidx; const int t = dir ? (S_ - 1 - pp) : pp;
                u16* hrow = HB + ((size_t)dir * T_ + tok0 + t) * 1024 + hh * 256 + dvq * 64 + 4 * quad;
#pragma unroll
                for (int x = 0; x < 2; ++x) { const f32x4 hv = nacc[x] * inv; u32x2 w; w.x = pk2(hv[0], hv[1]); w.y = pk2(hv[2], hv[3]); *(u32x2*)(hrow + 16 * (2 * dvh + x)) = w; } }
            const float decay = __expf(m_c - g63);
#pragma unroll
            for (int dt = 0; dt < 5; ++dt) Cacc[dt] = Cacc[dt] * decay;
#pragma unroll
            for (int i = 0; i < 2; ++i) {
                const bf16x4 alo = lds_tr(L + KS + (32 * i + 8 * quad + (l15 >> 2)) * 272 + (16 * wid + 4 * (l15 & 3)) * 2);
                const bf16x4 ahi = lds_tr(L + KS + (32 * i + 8 * quad + 4 + (l15 >> 2)) * 272 + (16 * wid + 4 * (l15 & 3)) * 2);
                const bf16x8 kf = cat8(alo, ahi);
#pragma unroll
                for (int dt = 0; dt < 5; ++dt) {
                    const bf16x4 blo = lds_tr(L + VW + (32 * i + 8 * quad + (l15 >> 2)) * 176 + (16 * dt + 4 * (l15 & 3)) * 2);
                    const bf16x4 bhi = lds_tr(L + VW + (32 * i + 8 * quad + 4 + (l15 >> 2)) * 176 + (16 * dt + 4 * (l15 & 3)) * 2);
                    Cacc[dt] = MFMA16(kf, cat8(blo, bhi), Cacc[dt]); } }
            __syncthreads();
#pragma unroll
            for (int dt = 0; dt < 5; ++dt) { u32x2 w; w.x = pk2(Cacc[dt][0], Cacc[dt][1]); w.y = pk2(Cacc[dt][2], Cacc[dt][3]);
                *(LAS u32x2*)(L + CB + (16 * dt + l15) * 272 + (16 * wid + 4 * quad) * 2) = w; }
            if (c + 1 < 64) { MLSTM_STAGE(c + 1); }
        }
        __syncthreads();
    }
#undef MLSTM_STAGE
}

__device__ __forceinline__ void mlstm_combine_phase() { PP p = get_params();
    const int tid = l_tid(), lane = tid & 63, wid = tid >> 6;
    const int gw = l_bid() * 8 + wid, NGW = l_nblk() * 8;
    const u16* Z = (const u16*)(p->ws + OFF_BIG);
    const u16* HB = (const u16*)(p->ws + OFF_MIX);
    u16* Y = (u16*)(p->ws + OFF_XN);
    for (int it = gw; it < T_ * 4; it += NGW) {
        const int t = it >> 2, hh = it & 3;
        const u32x2 fw = *(const u32x2*)(HB + (size_t)t * 1024 + hh * 256 + 4 * lane), bw = *(const u32x2*)(HB + ((size_t)T_ + t) * 1024 + hh * 256 + 4 * lane);
        const f32x4 hm = (f32x4){bflo(fw.x) + bflo(bw.x), bfhi(fw.x) + bfhi(bw.x), bflo(fw.y) + bflo(bw.y), bfhi(fw.y) + bfhi(bw.y)};
        const float ss = wave_sum(hm.x * hm.x + hm.y * hm.y + hm.z * hm.z + hm.w * hm.w);
        const float rs = rsqrtf(ss * (1.0f / 256.f) + 1e-6f);
        const f32x4 hg = *(const f32x4*)(p->e_head_g + hh * 256 + 4 * lane);
        const u32x2 ob = *(const u32x2*)(Z + (size_t)t * ZC_ + 2048 + hh * 256 + 4 * lane);
        u32x2 w; w.x = pk2(hm.x * rs * hg.x * sigmoidf_(bflo(ob.x)), hm.y * rs * hg.y * sigmoidf_(bfhi(ob.x)));
        w.y = pk2(hm.z * rs * hg.z * sigmoidf_(bflo(ob.y)), hm.w * rs * hg.w * sigmoidf_(bfhi(ob.y)));
        *(u32x2*)(Y + (size_t)t * D_ + hh * 256 + 4 * lane) = w;
    }
}

__device__ __forceinline__ float gelu_tanh(float v) { const float u = 0.7978845608028654f * (v + 0.044715f * v * v * v); const float e = __expf(2.0f * u); return 0.5f * v * (1.0f + (1.0f - 2.0f * __builtin_amdgcn_rcpf(e + 1.0f))); }

__device__ __forceinline__ float softplus_neg(float v) { const float x = __expf(-v); return (x < 0.1f) ? x * (1.0f - x * (0.5f - x * (0.33333334f - x * (0.25f - x * 0.2f)))) : __logf(1.0f + x); }
template <bool FINAL>
__device__ __forceinline__ void rglru_phase(LAS unsigned char* L) { PP p = get_params();
    const int tid = l_tid(), lane = tid & 63, wid = __builtin_amdgcn_readfirstlane(tid >> 6), l15 = lane & 15, quad = lane >> 4;
    const u16* Z = (const u16*)(p->ws + OFF_BIG);
    const u16* WRG = (const u16*)(p->ws + OFF_WRG);
    float2* SUM = (float2*)(p->ws + OFF_RGSUM);
    const float* CAR = (const float*)(p->ws + OFF_RGCAR);
    u16* Y = (u16*)(p->ws + OFF_XN);
    const int cgp = tid & 15, tq = tid >> 4;
    for (int grp = l_bid(); grp < 256; grp += l_nblk()) {
        const int b = grp >> 5, n = (grp >> 2) & 7, seg = grp & 3;
        const size_t tok0 = (size_t)b * S_;
        const int chb = n * 128 + 8 * cgp, ch0 = n * 128 + 16 * wid + 4 * quad;
        __syncthreads();
        LAS float* CW = (LAS float*)(L + 34816);
        for (int i = tid; i < 640; i += 512) { const int j = i >> 7, c = i & 127; CW[i] = (j < 4) ? p->e_conv_w[j * 1024 + n * 128 + c] : p->e_conv_b[n * 128 + c]; }
        LAS float* CB2 = CW + 640;
        for (int i = tid; i < 768; i += 512) { const int dir = i / 384, k = (i % 384) >> 7, c = i & 127; const int gi = dir * 1024 + n * 128 + c;
            CB2[i] = (k == 0) ? p->e_rg_ba[gi] : (k == 1) ? p->e_rg_bx[gi] : (-8.0f * softplus_neg(p->e_rg_lam[gi])); }
        u32x4 pre[5];
#define RG_ISSUE(tile_) do { _Pragma("unroll") for (int j = 0; j < 5; ++j) { const int pos = 64 * (tile_) + 2 * tq - 2 + j; pre[j] = (u32x4){0u, 0u, 0u, 0u}; \
            if (pos >= 0 && pos < S_) pre[j] = *(const u32x4*)(Z + (tok0 + pos) * ZC_ + 3072 + chb); } } while (0)
        RG_ISSUE(seg * 16);
        __syncthreads();
        for (int i = 0; i < 16; ++i) {
            const int tile = seg * 16 + i;
            LAS unsigned char* Xb = L + (i & 1) * 17408;
#pragma unroll
            for (int hh = 0; hh < 2; ++hh) { const int tl = 2 * tq + hh;
                float acc[8];
                { const f32x4 c0 = *(LAS f32x4*)(CW + 512 + 8 * cgp), c1 = *(LAS f32x4*)(CW + 512 + 8 * cgp + 4);
                  acc[0] = c0.x; acc[1] = c0.y; acc[2] = c0.z; acc[3] = c0.w; acc[4] = c1.x; acc[5] = c1.y; acc[6] = c1.z; acc[7] = c1.w; }
#pragma unroll
                for (int j = 0; j < 4; ++j) { const u32x4 v = pre[hh + j]; const f32x4 w0 = *(LAS f32x4*)(CW + j * 128 + 8 * cgp), w1 = *(LAS f32x4*)(CW + j * 128 + 8 * cgp + 4);
                    acc[0] += bflo(v.x) * w0.x; acc[1] += bfhi(v.x) * w0.y; acc[2] += bflo(v.y) * w0.z; acc[3] += bfhi(v.y) * w0.w;
                    acc[4] += bflo(v.z) * w1.x; acc[5] += bfhi(v.z) * w1.y; acc[6] += bflo(v.w) * w1.z; acc[7] += bfhi(v.w) * w1.w; }
                u32x4 o; o.x = pk2(acc[0], acc[1]); o.y = pk2(acc[2], acc[3]); o.z = pk2(acc[4], acc[5]); o.w = pk2(acc[6], acc[7]);
                *(LAS u32x4*)(Xb + (16 * (tl & 3) + (tl >> 2)) * 272 + cgp * 16) = o; }
            __syncthreads();
            if (i + 1 < 16) RG_ISSUE(tile + 1);
            float cin[2][4];
            if (FINAL) {
#pragma unroll
                for (int dir = 0; dir < 2; ++dir) { const f32x4 c4 = *(const f32x4*)(CAR + ((size_t)((b * 64 + tile) * 2 + dir)) * 1024 + ch0); cin[dir][0] = c4.x; cin[dir][1] = c4.y; cin[dir][2] = c4.z; cin[dir][3] = c4.w; }
            }
            float hsum[4][4];
#pragma unroll
            for (int tt = 0; tt < 4; ++tt)
#pragma unroll
                for (int jj = 0; jj < 4; ++jj) hsum[tt][jj] = 0.f;
#pragma unroll
            for (int dir = 0; dir < 2; ++dir) {
                bf16x8 wa[4], wx[4];
                {   const u16* wb = WRG + (size_t)(((dir * 2 + 0) * 8) + n) * 16384 + (16 * wid + l15) * 128 + 8 * quad;
#pragma unroll
                    for (int ks = 0; ks < 4; ++ks) { wa[ks] = *(const bf16x8*)(wb + 32 * ks); wx[ks] = *(const bf16x8*)(wb + (size_t)8 * 16384 + 32 * ks); } }
                const f32x4 ba4v = *(LAS f32x4*)(CB2 + dir * 384 + 16 * wid + 4 * quad), bx4v = *(LAS f32x4*)(CB2 + dir * 384 + 128 + 16 * wid + 4 * quad), cf4v = *(LAS f32x4*)(CB2 + dir * 384 + 256 + 16 * wid + 4 * quad);
                float av[4][4], uv[4][4];
#pragma unroll
                for (int tt = 0; tt < 4; ++tt) {
                    f32x4 pa = (f32x4){0.f, 0.f, 0.f, 0.f}, px = (f32x4){0.f, 0.f, 0.f, 0.f};
#pragma unroll
                    for (int ks = 0; ks < 4; ++ks) { const bf16x8 xf = lds_r8(Xb + (16 * tt + l15) * 272 + (32 * ks + 8 * quad) * 2); pa = MFMA16(wa[ks], xf, pa); px = MFMA16(wx[ks], xf, px); }
                    const u32x2 xc = *(LAS u32x2*)(Xb + (16 * tt + l15) * 272 + (16 * wid + 4 * quad) * 2);
                    const float xv[4] = {bflo(xc.x), bfhi(xc.x), bflo(xc.y), bfhi(xc.y)};
#pragma unroll
                    for (int jj = 0; jj < 4; ++jj) { const float rr = sigmoidf_(pa[jj] + ba4v[jj]), ii = sigmoidf_(px[jj] + bx4v[jj]); const float la = cf4v[jj] * rr, x2 = 2.0f * la;
                        const float em = -x2 * (1.0f + x2 * (0.5f + x2 * (0.16666667f + x2 * (0.041666668f + x2 * 0.0083333333f))));
                        av[tt][jj] = __expf(la); uv[tt][jj] = __builtin_amdgcn_sqrtf(fmaxf(em, 0.f)) * ii * xv[jj]; }
                }
#pragma unroll
                for (int jj = 0; jj < 4; ++jj) {
                    const float a0 = av[dir ? 3 : 0][jj], a1 = av[dir ? 2 : 1][jj], a2 = av[dir ? 1 : 2][jj], a3 = av[dir ? 0 : 3][jj];
                    const float u0 = uv[dir ? 3 : 0][jj], u1 = uv[dir ? 2 : 1][jj], u2 = uv[dir ? 1 : 2][jj], u3 = uv[dir ? 0 : 3][jj];
                    float A = a0 * a1 * a2 * a3, U = ((u0 * a1 + u1) * a2 + u2) * a3 + u3;
#pragma unroll
                    for (int d = 1; d < 16; d <<= 1) {
                        const float Ap = dir ? __shfl_down(A, d, 16) : __shfl_up(A, d, 16), Up = dir ? __shfl_down(U, d, 16) : __shfl_up(U, d, 16);
                        const bool ok = dir ? (l15 + d < 16) : (l15 >= d);
                        if (ok) { U = A * Up + U; A = A * Ap; } }
                    if (FINAL) {
                        float Ae = dir ? __shfl_down(A, 1, 16) : __shfl_up(A, 1, 16), Ue = dir ? __shfl_down(U, 1, 16) : __shfl_up(U, 1, 16);
                        const bool edge = dir ? (l15 == 15) : (l15 == 0);
                        if (edge) { Ae = 1.f; Ue = 0.f; }
                        const float hin = Ae * cin[dir][jj] + Ue;
                        const float h0 = a0 * hin + u0, h1 = a1 * h0 + u1, h2 = a2 * h1 + u2, h3 = a3 * h2 + u3;
                        hsum[dir ? 3 : 0][jj] += h0; hsum[dir ? 2 : 1][jj] += h1; hsum[dir ? 1 : 2][jj] += h2; hsum[dir ? 0 : 3][jj] += h3;
                    } else {
                        const int el = dir ? 0 : 15;
                        if (l15 == el) SUM[((size_t)((b * 64 + tile) * 2 + dir)) * 1024 + ch0 + jj] = make_float2(A, U);
                    }
                }
            }
            if (FINAL) {
                u32x2 gr[4];
#pragma unroll
                for (int tt = 0; tt < 4; ++tt) gr[tt] = *(const u32x2*)(Z + (tok0 + 64 * tile + 4 * l15 + tt) * ZC_ + 4096 + ch0);
#pragma unroll
                for (int tt = 0; tt < 4; ++tt) { const int t = 64 * tile + 4 * l15 + tt;
                    u32x2 w; w.x = pk2(hsum[tt][0] * gelu_tanh(bflo(gr[tt].x)), hsum[tt][1] * gelu_tanh(bfhi(gr[tt].x))); w.y = pk2(hsum[tt][2] * gelu_tanh(bflo(gr[tt].y)), hsum[tt][3] * gelu_tanh(bfhi(gr[tt].y)));
                    *(u32x2*)(Y + (tok0 + t) * D_ + 1024 + ch0) = w; }
            }
        }
        __syncthreads();
#undef RG_ISSUE
    }
}

__device__ __forceinline__ void rglru_carry_phase() { PP p = get_params();
    const int tid = l_tid(), lane = tid & 63, wid = tid >> 6;
    const float2* SUM = (const float2*)(p->ws + OFF_RGSUM);
    float* CAR = (float*)(p->ws + OFF_RGCAR);
    if (wid == 0) {
        for (int chain = l_bid() * 64 + lane; chain < 16384; chain += l_nblk() * 64) {
            const int ch = chain & 1023, dir = (chain >> 10) & 1, b = chain >> 11;
            float h = 0.f;
#pragma unroll 8
            for (int k = 0; k < 64; ++k) { const int tile = dir ? (63 - k) : k; const size_t idx = ((size_t)((b * 64 + tile) * 2 + dir)) * 1024 + ch;
                const float2 s = SUM[idx]; CAR[idx] = h; h = s.x * h + s.y; }
        }
    }
}

struct AttnItem { int g, head, b, dil, sp, r, nb; };
__device__ __forceinline__ AttnItem attn_decode(int it0, int nblk) {
    int item = it0;
    if (nblk == 256) { const int k = it0 >> 8, w = it0 & 255, xcd = w & 7, slot = w >> 3; item = (((k / 3) * 8 + xcd) * 3 + (k % 3)) * 32 + slot; }
    AttnItem a; const int blk32 = item & 31, bh = item / 96; a.g = (item >> 5) % 3; a.head = bh & 15; a.b = bh >> 4;
    const int lg = 2 * a.g; a.dil = 1 << lg; a.sp = S_ >> lg; a.r = blk32 & (a.dil - 1); a.nb = blk32 >> lg;
    return a;
}
__device__ __forceinline__ void attn_phase(LAS unsigned char* L) { PP p = get_params();
    const int tid = l_tid(), lane = tid & 63, wid = __builtin_amdgcn_readfirstlane(tid >> 6), l15 = lane & 15, quad = lane >> 4;
    const u16* QKV = (const u16*)(p->ws + OFF_BIG);
    float* LSE = (float*)(p->ws + OFF_LSE);
    constexpr int KS = 0, VS = 65536;
    constexpr float SCALE = 0.08838834764831845f;
    const int pc = tid & 15, rb = tid >> 4;
    const int nblk = l_nblk();
    bf16x8 qf[4];
#define ATT_DMA(A_, which, BASE, ISV) do { _Pragma("unroll") for (int it = 0; it < 8; ++it) { const int lam = rb + 32 * it, x_ = lam & 15; \
        const int lr = (ISV) ? ((lam & ~15) + 8 * ((x_ >> 2) & 1) + 4 * (x_ >> 3) + (x_ & 3)) : lam; \
        const int cx = (ISV) ? (((lam & 3) << 2) | ((lam >> 2) & 3)) : x_; \
        const int i = 128 * (A_).nb - 64 + lr; const int ic = i < 0 ? 0 : (i >= (A_).sp ? (A_).sp - 1 : i);     \
        const unsigned bo_ = ((unsigned)(((which) * 128 + (A_).b * 16 + (A_).head) * S_ + (A_).r + ic * (A_).dil) * 128u + (unsigned)(8 * (pc ^ cx))) * 2u; \
        __builtin_amdgcn_global_load_lds((const unsigned*)((const char*)QKV + bo_), (LAS unsigned*)(L + (BASE) + (4 * wid + 32 * it) * 256), 16, 0, 0); } } while (0)
#define ATT_LOADQ(A_) do { const unsigned qb_ = ((unsigned)(((A_).b * 16 + (A_).head) * S_ + (A_).r + (128 * (A_).nb + 16 * wid + l15) * (A_).dil) * 128u + (unsigned)(8 * quad)) * 2u; \
        _Pragma("unroll") for (int ks = 0; ks < 4; ++ks) qf[ks] = *(const bf16x8*)((const char*)QKV + qb_ + 64 * ks); } while (0)
    int it0 = l_bid();
    AttnItem cur = attn_decode(it0 < 12288 ? it0 : 0, nblk);
    __syncthreads();
    if (it0 < 12288) { ATT_DMA(cur, 1, KS, 0); ATT_LOADQ(cur); }
    u32x2 pend[8]; u16* pend_ptr = nullptr; float pend_lse = 0.f; float* pend_lse_ptr = nullptr; bool have_pend = false;
    for (; it0 < 12288; it0 += nblk) {
        asm volatile("s_waitcnt vmcnt(0)" ::: "memory");
        __syncthreads();
        ATT_DMA(cur, 2, VS, 1);
        if (have_pend) {
#pragma unroll
            for (int dt = 0; dt < 8; ++dt) *(u32x2*)(pend_ptr + 16 * dt) = pend[dt];
            if (quad == 0) *pend_lse_ptr = pend_lse;
        }
        const int qi = 128 * cur.nb + 16 * wid + l15;
        const size_t qrow = (size_t)cur.b * S_ + cur.r + (size_t)qi * cur.dil;
        f32x4 sacc[9];
#pragma unroll
        for (int kt = 0; kt < 9; ++kt) { sacc[kt] = (f32x4){0.f, 0.f, 0.f, 0.f};
#pragma unroll
            for (int ks = 0; ks < 4; ++ks) { const bf16x8 kf = lds_r8(L + KS + (16 * wid + 16 * kt + l15) * 256 + (((4 * ks + quad) ^ l15) << 4)); sacc[kt] = MFMA16(kf, qf[ks], sacc[kt]); }
            if (kt % 3 == 2) __builtin_amdgcn_sched_barrier(0); }
        const float pen2 = exp2f(-0.5f * (float)(cur.head + 1)) * (float)cur.dil * 1.4426950408889634f, sc2 = SCALE * 1.4426950408889634f;
        float mx = -1e30f;
        int rel0 = 4 * quad - l15; asm volatile("" : "+v"(rel0));
        const float relf = (float)rel0;
        const bool seq_edge = (cur.nb == 0) || (cur.nb == (cur.sp >> 7) - 1);
        if (seq_edge) {
#pragma unroll
            for (int kt = 0; kt < 9; ++kt)
#pragma unroll
                for (int jj = 0; jj < 4; ++jj) { const int rel = 16 * kt + jj - 64 + rel0, ki = qi + rel; const int arel = rel < 0 ? -rel : rel;
                    const bool valid = (arel <= 64) && (ki >= 0) && (ki < cur.sp);
                    const float sc = valid ? (sacc[kt][jj] * sc2 - pen2 * (float)arel) : -1e30f; sacc[kt][jj] = sc; mx = fmaxf(mx, sc); }
        } else {
#pragma unroll
            for (int kt = 0; kt < 9; ++kt)
#pragma unroll
                for (int jj = 0; jj < 4; ++jj) { const float rr = relf + (float)(16 * kt + jj - 64);
                    float sc = __builtin_fmaf(sacc[kt][jj], sc2, -(pen2 * fabsf(rr)));
                    if (kt == 0) sc = (rel0 + jj >= 0) ? sc : -1e30f;
                    if (kt == 8) sc = (rel0 + jj <= 0) ? sc : -1e30f;
                    sacc[kt][jj] = sc; mx = fmaxf(mx, sc); }
        }
        mx = fmaxf(mx, __shfl_xor(mx, 16)); mx = fmaxf(mx, __shfl_xor(mx, 32));
        float lsum = 0.f;
#pragma unroll
        for (int kt = 0; kt < 9; ++kt)
#pragma unroll
            for (int jj = 0; jj < 4; ++jj) { const float pv = __builtin_amdgcn_exp2f(sacc[kt][jj] - mx); sacc[kt][jj] = pv; lsum += pv; }
        lsum += __shfl_xor(lsum, 16); lsum += __shfl_xor(lsum, 32);
        bf16x8 pf[5];
#pragma unroll
        for (int i = 0; i < 5; ++i) { u32x4 t; t.x = pk2(sacc[2 * i][0], sacc[2 * i][1]); t.y = pk2(sacc[2 * i][2], sacc[2 * i][3]);
            if (i < 4) { t.z = pk2(sacc[2 * i + 1][0], sacc[2 * i + 1][1]); t.w = pk2(sacc[2 * i + 1][2], sacc[2 * i + 1][3]); } else { t.z = 0u; t.w = 0u; }
            pf[i] = as_bf16x8(t); }
        asm volatile("s_waitcnt vmcnt(0)" ::: "memory");
        __syncthreads();
        const AttnItem cur0 = cur;
        if (it0 + nblk < 12288) { cur = attn_decode(it0 + nblk, nblk); ATT_DMA(cur, 1, KS, 0); ATT_LOADQ(cur); }
        f32x4 oacc[8];
        const int vrow = 16 * wid + 8 * (quad & 1) + 4 * (quad >> 1) + (l15 >> 2), vx = ((l15 >> 2) << 2) | ((2 * (quad & 1) + (quad >> 1)) & 3);
#pragma unroll
        for (int dt = 0; dt < 8; ++dt) { oacc[dt] = (f32x4){0.f, 0.f, 0.f, 0.f};
#pragma unroll
            for (int i = 0; i < 5; ++i) {
                const int vch = ((2 * dt + ((l15 & 3) >> 1)) ^ vx) * 16 + 8 * (l15 & 1);
                const bf16x4 lo = lds_tr(L + VS + 256 * (vrow + 32 * i) + vch);
                bf16x4 hi = (bf16x4){0, 0, 0, 0};
                if (i < 4) hi = lds_tr(L + VS + 256 * (vrow + 32 * i + 16) + vch);
                oacc[dt] = MFMA16(cat8(lo, hi), pf[i], oacc[dt]); }
            if (dt & 1) __builtin_amdgcn_sched_barrier(0); }
        const float inv = 1.0f / lsum;
        u16* OB = (cur0.g < 2) ? ((u16*)(p->out) + (size_t)cur0.g * T_ * D_) : (u16*)(p->ws + OFF_XN);
        pend_ptr = OB + qrow * D_ + cur0.head * 128 + 4 * quad;
#pragma unroll
        for (int dt = 0; dt < 8; ++dt) { pend[dt].x = pk2(oacc[dt][0] * inv, oacc[dt][1] * inv); pend[dt].y = pk2(oacc[dt][2] * inv, oacc[dt][3] * inv); }
        pend_lse = (mx + __log2f(lsum)) * 0.6931471805599453f; pend_lse_ptr = LSE + ((size_t)cur0.g * T_ + qrow) * 16 + cur0.head; have_pend = true;
    }
    if (have_pend) {
#pragma unroll
        for (int dt = 0; dt < 8; ++dt) *(u32x2*)(pend_ptr + 16 * dt) = pend[dt];
        if (quad == 0) *pend_lse_ptr = pend_lse;
    }
    __syncthreads();
#undef ATT_DMA
#undef ATT_LOADQ
}

__device__ __forceinline__ void attn_merge_phase() { PP p = get_params();
    const u16* O0 = (const u16*)(p->out); const u16* O1 = O0 + (size_t)T_ * D_; u16* O2 = (u16*)(p->ws + OFF_XN);
    const float* LSE = (const float*)(p->ws + OFF_LSE);
    for (size_t gi = (size_t)l_bid() * 512 + l_tid(); gi < (size_t)T_ * 256; gi += (size_t)l_nblk() * 512) {
        const size_t t = gi >> 8; const int c8 = (int)(gi & 255), head = c8 >> 4;
        const float l0 = LSE[t * 16 + head], l1 = LSE[((size_t)T_ + t) * 16 + head], l2 = LSE[((size_t)2 * T_ + t) * 16 + head];
        const float mx = fmaxf(l0, fmaxf(l1, l2));
        float w0 = __expf(l0 - mx), w1 = __expf(l1 - mx), w2 = __expf(l2 - mx); const float inv = 1.0f / (w0 + w1 + w2); w0 *= inv; w1 *= inv; w2 *= inv;
        const u32x4 a = *(const u32x4*)(O0 + t * D_ + 8 * c8), bq = *(const u32x4*)(O1 + t * D_ + 8 * c8), c = *(const u32x4*)(O2 + t * D_ + 8 * c8);
        u32x4 o;
        o.x = pk2(w0 * bflo(a.x) + w1 * bflo(bq.x) + w2 * bflo(c.x), w0 * bfhi(a.x) + w1 * bfhi(bq.x) + w2 * bfhi(c.x));
        o.y = pk2(w0 * bflo(a.y) + w1 * bflo(bq.y) + w2 * bflo(c.y), w0 * bfhi(a.y) + w1 * bfhi(bq.y) + w2 * bfhi(c.y));
        o.z = pk2(w0 * bflo(a.z) + w1 * bflo(bq.z) + w2 * bflo(c.z), w0 * bfhi(a.z) + w1 * bfhi(bq.z) + w2 * bfhi(c.z));
        o.w = pk2(w0 * bflo(a.w) + w1 * bflo(bq.w) + w2 * bflo(c.w), w0 * bfhi(a.w) + w1 * bfhi(bq.w) + w2 * bfhi(c.w));
        *(u32x4*)(O2 + t * D_ + 8 * c8) = o;
    }
}

#define XB_TMO      128
#define XB_XCNT(j)  (256  + 64 * (j))
#define XB_XSUB(j)  (1280 + 64 * (j))
#define XB_XGEN(j)  (2304 + 64 * (j))
#define XB_TOP      3328
#define XB_TOPGEN   3392
#define XCD_BAR_WORDS 3456
#define XB_SPIN_CAP (1u << 18)
__device__ __forceinline__ unsigned xb_ld(unsigned* p)              { return __hip_atomic_load(p, __ATOMIC_RELAXED, __HIP_MEMORY_SCOPE_AGENT); }
__device__ __forceinline__ unsigned xb_add(unsigned* p, unsigned v) { return __hip_atomic_fetch_add(p, v, __ATOMIC_RELAXED, __HIP_MEMORY_SCOPE_AGENT); }
__device__ __forceinline__ unsigned xb_xcc_id() { return (unsigned)__builtin_amdgcn_s_getreg((3 << 11) | 20) & 0xFu; }
#define XB_SPIN(cond, bar) do { unsigned _sp = 0; while (cond) { __builtin_amdgcn_s_sleep(1); \
    if ((++_sp & 255u) == 0u) { if (xb_ld(&(bar)[XB_TMO])) break; if (_sp > XB_SPIN_CAP) { atomicAdd(&(bar)[XB_TMO], 1u); break; } } } } while (0)

struct XcdBarrier {
    unsigned* bar; unsigned x;
    volatile LAS unsigned* st;
};

__device__ __forceinline__ XcdBarrier xcd_barrier_post(unsigned* bar, volatile LAS unsigned* st) {
    XcdBarrier b; b.bar = bar; b.x = xb_xcc_id(); b.st = st;
    if (threadIdx.x == 0) (void)xb_add(&bar[XB_XCNT(b.x)], 1u);
    return b;
}
__device__ __forceinline__ void xcd_barrier_complete(unsigned* bar, unsigned x, unsigned& nloc, unsigned& nx) {
    const unsigned G = gridDim.x * gridDim.y * gridDim.z;
    unsigned sum, cnt, mine, sp = 0u;
    for (;;) {
        sum = 0u; cnt = 0u; mine = 0u;
#pragma unroll
        for (unsigned j = 0; j < 16; ++j) { const unsigned c = xb_ld(&bar[XB_XCNT(j)]); sum += c; cnt += (c > 0u) ? 1u : 0u; mine = (j == x) ? c : mine; }
        if (sum == G) break;
        __builtin_amdgcn_s_sleep(1);
        if ((++sp & 255u) == 0u) { if (xb_ld(&bar[XB_TMO])) break; if (sp > XB_SPIN_CAP) { atomicAdd(&bar[XB_TMO], 1u); break; } }
    }
    nloc = mine > 0u ? mine : 1u; nx = cnt > 0u ? cnt : 1u;
}

__device__ __forceinline__ void xcd_barrier(const XcdBarrier& b) {
    asm volatile("s_waitcnt vmcnt(0)" ::: "memory");
    __syncthreads();
    if (threadIdx.x == 0) {
        unsigned* bar = b.bar;
        __builtin_amdgcn_s_waitcnt(0);
        unsigned nloc = b.st[0], nx = b.st[1];
        if (nloc == 0u) { xcd_barrier_complete(bar, b.x, nloc, nx); b.st[0] = nloc; b.st[1] = nx; }
        const unsigned old = xb_add(&bar[XB_XSUB(b.x)], 1u);
        const unsigned gen = old / nloc;
        if (old + 1u == (gen + 1u) * nloc) {
            __builtin_amdgcn_fence(__ATOMIC_RELEASE, "agent");
            asm volatile("s_waitcnt vmcnt(0)" ::: "memory");
            const unsigned og = xb_add(&bar[XB_TOP], 1u);
            const unsigned tg = og / nx;
            if (og + 1u == (tg + 1u) * nx) xb_add(&bar[XB_TOPGEN], 1u);
            else XB_SPIN(xb_ld(&bar[XB_TOPGEN]) == tg, bar);
            __builtin_amdgcn_fence(__ATOMIC_ACQUIRE, "agent");
            xb_add(&bar[XB_XGEN(b.x)], 1u);
            asm volatile("s_waitcnt vmcnt(0)" ::: "memory");
        } else {
            XB_SPIN(xb_ld(&bar[XB_XGEN(b.x)]) == gen, bar);
            __builtin_amdgcn_fence(__ATOMIC_ACQUIRE, "agent");
            asm volatile("s_waitcnt vmcnt(0)" ::: "memory");
        }
    }
    __syncthreads();
}


template <class Epi>
__device__ __forceinline__ void run_gemm(LAS unsigned char* L, const u16* A, const u16* Bt, int N, int K, const Epi& E) {
    pg8::Gemm g; g.A = A; g.Bt = Bt; g.M = T_; g.N = N; g.K = K;
    pg8::StaticOrder S; S.init(T_, N, l_nblk(), l_bid());
    pg8::gemm_phase<Epi, pg8::StaticOrder, false>(L, g, S, E, nullptr);
}
__device__ __forceinline__ void gemm_zin(LAS unsigned char* L) { PP p = get_params(); unsigned char* ws = p->ws;
    run_gemm(L, (const u16*)(ws + OFF_XN), (const u16*)(ws + OFF_WIN), ZC_, D_, pg8::EpiStoreBf16{(u16*)(ws + OFF_BIG), ZC_, nullptr, 0}); }
__device__ __forceinline__ void gemm_qkv(LAS unsigned char* L) { PP p = get_params(); unsigned char* ws = p->ws;
    run_gemm(L, (const u16*)(ws + OFF_MIX), (const u16*)(ws + OFF_WQKV), QC_, D_, pg8::EpiStoreBf16{(u16*)(ws + OFF_BIG), QC_, (const float*)(ws + OFF_SS) + T_, 1}); }
__device__ __forceinline__ void gemm_res0(LAS unsigned char* L) { PP p = get_params(); unsigned char* ws = p->ws;
    run_gemm(L, (const u16*)(ws + OFF_XN), (const u16*)(ws + OFF_WOUT), D_, D_,
             pg8::EpiRes<false, false, true>{(const void*)p->x, nullptr, (u16*)(ws + OFF_MIX), (float*)(ws + OFF_SS), D_}); }
__device__ __forceinline__ void gemm_res1(LAS unsigned char* L) { PP p = get_params(); unsigned char* ws = p->ws;
    run_gemm(L, (const u16*)(ws + OFF_XN), (const u16*)(ws + OFF_WO), D_, D_,
             pg8::EpiRes<true, false, true>{(const void*)(ws + OFF_MIX), nullptr, (u16*)(ws + OFF_MIX), (float*)(ws + OFF_SS) + 2 * T_, D_}); }
__device__ __forceinline__ void gemm_up(LAS unsigned char* L, int l) { PP p = get_params(); unsigned char* ws = p->ws;
    run_gemm(L, (const u16*)(ws + OFF_MIX), (const u16*)(ws + OFF_W13) + (size_t)l * 2 * DFF_ * D_, 2 * DFF_, D_, pg8::EpiSwiGLU{(u16*)(ws + OFF_BIG), DFF_, (const float*)(ws + OFF_SS) + (l ? 2 * T_ : 0)}); }
__device__ __forceinline__ void gemm_down0(LAS unsigned char* L) { PP p = get_params(); unsigned char* ws = p->ws;
    run_gemm(L, (const u16*)(ws + OFF_BIG), (const u16*)(ws + OFF_W2), D_, DFF_,
             pg8::EpiRes<true, false, true>{(const void*)(ws + OFF_MIX), nullptr, (u16*)(ws + OFF_MIX), (float*)(ws + OFF_SS) + T_, D_}); }
__device__ __forceinline__ void gemm_down1(LAS unsigned char* L) { PP p = get_params(); unsigned char* ws = p->ws;
    run_gemm(L, (const u16*)(ws + OFF_BIG), (const u16*)(ws + OFF_W2) + (size_t)D_ * DFF_, D_, DFF_,
             pg8::EpiRes<true, false, true>{(const void*)(ws + OFF_MIX), nullptr, (u16*)(ws + OFF_MIX), (float*)(ws + OFF_SS) + 3 * T_, D_}); }
__device__ __forceinline__ void norm_final() { PP p = get_params();
    const u16* XBp = (const u16*)(p->ws + OFF_MIX); const float* ss = (const float*)(p->ws + OFF_SS) + 3 * T_; float* out = p->out; const float* g = p->final_norm;
    for (size_t gi = (size_t)l_bid() * 512 + l_tid(); gi < (size_t)T_ * 256; gi += (size_t)l_nblk() * 512) {
        const size_t t = gi >> 8; const int c8 = (int)(gi & 255);
        const float rs = rsqrtf(ss[t] * (1.0f / D_) + 1e-6f);
        const u32x4 w = *(const u32x4*)(XBp + t * D_ + 8 * c8);
        const f32x4 g0 = *(const f32x4*)(g + 8 * c8), g1 = *(const f32x4*)(g + 8 * c8 + 4);
        f32x4 o0, o1;
        o0.x = bflo(w.x) * rs * g0.x; o0.y = bfhi(w.x) * rs * g0.y; o0.z = bflo(w.y) * rs * g0.z; o0.w = bfhi(w.y) * rs * g0.w;
        o1.x = bflo(w.z) * rs * g1.x; o1.y = bfhi(w.z) * rs * g1.y; o1.z = bflo(w.w) * rs * g1.z; o1.w = bfhi(w.w) * rs * g1.w;
        *(f32x4*)(out + t * D_ + 8 * c8) = o0; *(f32x4*)(out + t * D_ + 8 * c8 + 4) = o1;
    }
}

__global__ __launch_bounds__(512, 2) void mega_fwd(Params pdummy) {
    LAS unsigned char* L = (LAS unsigned char*)lds_raw;
    cg::grid_group grid = cg::this_grid();
    volatile LAS unsigned* xst = (volatile LAS unsigned*)(L + LDS_MAIN);
    if (threadIdx.x < 4) xst[threadIdx.x] = (threadIdx.x == 2) ? blockIdx.x : 0u;
    __syncthreads();
    unsigned* barw = (unsigned*)(get_params()->ws + OFF_BAR);
    XcdBarrier xb = xcd_barrier_post(barw, xst);
    if (threadIdx.x == 0) xst[3] = xb_add(&barw[3520 + 64 * xb.x], 1u);
    phase0(L);
    grid.sync();
    if (threadIdx.x == 0) {
        bool ok = (gridDim.x == 256) && (xb.x < 8u);
        for (int j = 0; j < 8; ++j) ok = ok && (xb_ld(&barw[3520 + 64 * j]) == 32u);
        if (ok) xst[2] = xst[3] * 8u + xb.x;
    }
    __syncthreads();
    gemm_zin(L);
    xcd_barrier(xb);
    mlstm_phase(L);
    asm volatile("s_waitcnt vmcnt(0)" ::: "memory");
    rglru_phase<false>(L);
    xcd_barrier(xb);
    rglru_carry_phase();
    asm volatile("s_waitcnt vmcnt(0)" ::: "memory");
    mlstm_combine_phase();
    xcd_barrier(xb);
    rglru_phase<true>(L);
    xcd_barrier(xb);
    gemm_res0(L);
    xcd_barrier(xb);
    gemm_up(L, 0);
    xcd_barrier(xb);
    gemm_down0(L);
    xcd_barrier(xb);
    gemm_qkv(L);
    xcd_barrier(xb);
    attn_phase(L);
    xcd_barrier(xb);
    attn_merge_phase();
    xcd_barrier(xb);
    gemm_res1(L);
    xcd_barrier(xb);
    gemm_up(L, 1);
    xcd_barrier(xb);
    gemm_down1(L);
    xcd_barrier(xb);
    norm_final();
}

extern "C" void kernel_launch(void* const* d_in, const int* in_sizes, int n_in, void* d_out, int out_size, void* d_ws, size_t ws_size, hipStream_t stream) {
    static int grid_blocks = 0;
    if (!grid_blocks) {
        int dev = 0, cus = 0, per_cu = 0;
        hipGetDevice(&dev);
        hipDeviceGetAttribute(&cus, hipDeviceAttributeMultiprocessorCount, dev);
        hipFuncSetAttribute((const void*)mega_fwd, hipFuncAttributeMaxDynamicSharedMemorySize, LDS_BYTES);
        hipOccupancyMaxActiveBlocksPerMultiprocessor(&per_cu, (const void*)mega_fwd, 512, LDS_BYTES);
        if (per_cu < 1) per_cu = 1;
        grid_blocks = cus * per_cu;
        if (ws_size < WS_END) fprintf(stderr, "workspace too small: %zu < %zu\n", ws_size, (size_t)WS_END);
    }
    Params p; memset(&p, 0, sizeof(p));
    const float** ptrs = (const float**)&p;
    for (int i = 0; i < 21; ++i) ptrs[i] = (const float*)d_in[i];
    p.out = (float*)d_out; p.ws = (unsigned char*)d_ws;
    unsigned char* ws = (unsigned char*)d_ws;
    int ns = 0, tot = 0;
    auto add = [&](const float* src, size_t dst_off, int ld, int K, int N, int mode, int rowoff, const float* gain) {
        Seg& s = p.seg[ns++]; s.src = src; s.dst = (u16*)(ws + dst_off); s.gain = gain; s.ld = ld; s.K = K; s.nN32 = N / 32; s.mode = mode; s.rowoff = rowoff; s.ntiles = (K / 64) * (N / 32); tot += s.ntiles; };
    add(p.e_w_in, OFF_WIN, DIN_, D_, 3072, 0, 0, nullptr);
    add(p.e_w_in + 3088, OFF_WIN, DIN_, D_, 2048, 0, 3072, nullptr);
    add(p.e_w_out, OFF_WOUT, D_, D_, D_, 0, 0, nullptr);
    add(p.o_w_qkv, OFF_WQKV, QC_, D_, QC_, 0, 0, p.o_norm);
    add(p.o_w_o, OFF_WO, D_, D_, D_, 0, 0, nullptr);
    for (int l = 0; l < 2; ++l) {
        add(p.f_w1 + (size_t)l * D_ * DFF_, OFF_W13 + l * SZ_W13, DFF_, D_, DFF_, 1, 0, p.f_norm + l * D_);
        add(p.f_w3 + (size_t)l * D_ * DFF_, OFF_W13 + l * SZ_W13, DFF_, D_, DFF_, 1, 128, p.f_norm + l * D_);
        add(p.f_w2 + (size_t)l * DFF_ * D_, OFF_W2 + l * SZ_W2, D_, DFF_, D_, 0, 0, nullptr);
    }
    p.nseg = ns; p.total_tiles = tot;
    hipMemsetAsync((unsigned char*)d_ws + OFF_BAR, 0, 16384, stream);
    void* args[] = {&p};
    hipError_t e = hipLaunchCooperativeKernel((const void*)mega_fwd, dim3(grid_blocks), dim3(512), args, LDS_BYTES, stream);
    if (e != hipSuccess) fprintf(stderr, "cooperative launch failed: %s (grid %d)\n", hipGetErrorString(e), grid_blocks);
}
```

```cpp
#include <hip/hip_runtime.h>
#include <hip/hip_cooperative_groups.h>
#include <cstdio>
#include <cstring>
namespace cg = cooperative_groups;
namespace pg8 {
#define PG8_LAS __attribute__((address_space(3)))
typedef unsigned short bf16_t;
typedef short bf16x8 __attribute__((ext_vector_type(8)));
typedef float f32x4 __attribute__((ext_vector_type(4)));
typedef unsigned u32x4 __attribute__((ext_vector_type(4)));
constexpr int BM = 256, BK = 64, HALF = 128, HTB = HALF * BK * 2  , STAGE_BYTES = 8 * HTB, NXCD = 8, WGM = 4;

__host__ __device__ __forceinline__ int lds_byte(int r, int c) { const int st = (r >> 4) * 2 + (c >> 5), rr = r & 15, cc = c & 31, ob = rr * 64 + cc * 2; return st * 1024 + (ob ^ (((ob >> 9) & 1) << 5)); }
__host__ __device__ __forceinline__ void stage_rc(int b, int& R, int& C) { const int st = b / 1024, sb = b % 1024, swz = sb ^ (((sb >> 9) & 1) << 5); R = (st >> 1) * 16 + swz / 64; C = (st & 1) * 32 + (swz % 64) / 2; }
__host__ __device__ __forceinline__ int perm32(int rho) { const int n = rho >> 4, i = rho & 15; return 8 * (i >> 2) + 4 * n + (i & 3); }

struct Unit { int pm, pn; };
struct Gemm { const bf16_t* A; const bf16_t* Bt; int M, N, K; };

struct StaticOrder {
    int nM, nN, nwg, G, c;
    __host__ __device__ void init(int M, int N, int G_, int c_) { nM = M / BM; nN = N / BM; nwg = nM * nN; G = G_; c = c_; }
    __host__ __device__ bool next(int i, Unit& u) const {
        const long L = (long)i * G + c; if (L >= nwg) return false;
        int wgid = (int)L; { const int q = nwg / NXCD, r = nwg % NXCD, xcd = wgid % NXCD, off = wgid / NXCD; wgid = (xcd < r ? xcd * (q + 1) : r * (q + 1) + (xcd - r) * q) + off; }
        const int nig = WGM * nN, gid = wgid / nig, fm = gid * WGM, gsz = (nM - fm) < WGM ? (nM - fm) : WGM;
        u.pm = fm + ((wgid % nig) % gsz); u.pn = (wgid % nig) / gsz; return true;
    }
    __device__ __forceinline__ void a_ready(const Unit&) const {}
    __device__ __forceinline__ void done(const Unit&) const {}
};
__device__ __forceinline__ unsigned cvt_pk_bf16(float lo, float hi) { unsigned r; asm volatile("v_cvt_pk_bf16_f32 %0, %1, %2" : "=v"(r) : "v"(lo), "v"(hi)); return r; }
typedef float f32x2 __attribute__((ext_vector_type(2)));
typedef unsigned u32x4 __attribute__((ext_vector_type(4)));
typedef unsigned u32x2 __attribute__((ext_vector_type(2)));
struct EpiStoreBf16 {
    static constexpr bool PERM = true, AFTER_DRAIN = false;
    bf16_t* O; int ldc; const float* ss; int headmajor;
    __device__ __forceinline__ void operator()(const f32x4 (&acc)[2][2][4][2], const Unit& u, int wr, int wc, int fr, int fq) const {
        const int row0 = u.pm * BM + wr * 64 + fr, col0 = u.pn * BM + wc * 32 + 8 * fq;
        float rs[2][4];
#pragma unroll
        for (int ai = 0; ai < 2; ++ai)
#pragma unroll
            for (int m = 0; m < 4; ++m) rs[ai][m] = ss ? ss[row0 + ai * HALF + m * 16] : 0.f;
#pragma unroll
        for (int ai = 0; ai < 2; ++ai)
#pragma unroll
            for (int m = 0; m < 4; ++m) rs[ai][m] = ss ? rsqrtf(rs[ai][m] * (1.0f / 2048.0f) + 1e-6f) : 1.0f;
#pragma unroll
        for (int ai = 0; ai < 2; ++ai)
#pragma unroll
            for (int m = 0; m < 4; ++m) { const int row = row0 + ai * HALF + m * 16;
                bf16_t* rowp = headmajor ? O + ((size_t)((col0 >> 11) * 128 + (row >> 12) * 16 + ((col0 >> 7) & 15)) * 4096 + (row & 4095)) * 128 + (col0 & 127)
                                         : O + (size_t)row * ldc + col0;
                const size_t bjstep = headmajor ? (size_t)4096 * 128 : (size_t)HALF;
#pragma unroll
                for (int bj = 0; bj < 2; ++bj) { const f32x4 v0 = acc[ai][bj][m][0] * rs[ai][m], v1 = acc[ai][bj][m][1] * rs[ai][m];
                    u32x4 w; w.x = cvt_pk_bf16(v0[0], v0[1]); w.y = cvt_pk_bf16(v0[2], v0[3]); w.z = cvt_pk_bf16(v1[0], v1[1]); w.w = cvt_pk_bf16(v1[2], v1[3]);
                    *(u32x4*)(rowp + bj * bjstep) = w; } }
    }
};
struct EpiResF32 {
    static constexpr bool PERM = false, AFTER_DRAIN = false;
    float* C; const float* base; int ldc; bf16_t* XB; float* ss;
    __device__ __forceinline__ void operator()(const f32x4 (&acc)[2][2][4][2], const Unit& u, int wr, int wc, int fr, int fq) const {
        const int row0 = u.pm * BM + wr * 64 + fr, col0 = u.pn * BM + wc * 32 + 4 * fq;
        float sq[2][4];
#pragma unroll
        for (int ai = 0; ai < 2; ++ai)
#pragma unroll
            for (int m = 0; m < 4; ++m) sq[ai][m] = 0.f;
#pragma unroll
        for (int bj = 0; bj < 2; ++bj)
#pragma unroll
          for (int ai = 0; ai < 2; ++ai) {
            f32x4 bv[4][2];
#pragma unroll
            for (int m = 0; m < 4; ++m)
#pragma unroll
                for (int n = 0; n < 2; ++n) bv[m][n] = *(const f32x4*)(base + (size_t)(row0 + ai * HALF + m * 16) * ldc + col0 + bj * HALF + n * 16);
#pragma unroll
            for (int m = 0; m < 4; ++m)
#pragma unroll
                for (int n = 0; n < 2; ++n) { const size_t off = (size_t)(row0 + ai * HALF + m * 16) * ldc + col0 + bj * HALF + n * 16;
                    const f32x4 r = acc[ai][bj][m][n] + bv[m][n];
                    *(f32x4*)(C + off) = r;
                    if (XB) { sq[ai][m] += r[0] * r[0] + r[1] * r[1] + r[2] * r[2] + r[3] * r[3]; u32x2 w; w.x = cvt_pk_bf16(r[0], r[1]); w.y = cvt_pk_bf16(r[2], r[3]); *(u32x2*)(XB + off) = w; } }
          }
        if (XB) {
#pragma unroll
            for (int ai = 0; ai < 2; ++ai)
#pragma unroll
                for (int m = 0; m < 4; ++m) { float s = sq[ai][m]; s += __shfl_xor(s, 16); s += __shfl_xor(s, 32); if (fq == 0) unsafeAtomicAdd(ss + row0 + ai * HALF + m * 16, s); } }
    }
};
__device__ __forceinline__ float silu_mul(float a, float b) { return a * __builtin_amdgcn_rcpf(1.0f + __expf(-a)) * b; }
struct EpiSwiGLU {
    static constexpr bool PERM = true, AFTER_DRAIN = false;
    bf16_t* O; int ldc; const float* ss;
    __device__ __forceinline__ void operator()(const f32x4 (&acc)[2][2][4][2], const Unit& u, int wr, int wc, int fr, int fq) const {
        const int row0 = u.pm * BM + wr * 64 + fr, col0 = u.pn * HALF + wc * 32 + 8 * fq;
        float rs[2][4];
#pragma unroll
        for (int ai = 0; ai < 2; ++ai)
#pragma unroll
            for (int m = 0; m < 4; ++m) rs[ai][m] = ss[row0 + ai * HALF + m * 16];
#pragma unroll
        for (int ai = 0; ai < 2; ++ai)
#pragma unroll
            for (int m = 0; m < 4; ++m) rs[ai][m] = rsqrtf(rs[ai][m] * (1.0f / 2048.0f) + 1e-6f);
#pragma unroll
        for (int ai = 0; ai < 2; ++ai)
#pragma unroll
            for (int m = 0; m < 4; ++m) { bf16_t* rowp = O + (size_t)(row0 + ai * HALF + m * 16) * ldc + col0;
                const f32x4 a0 = acc[ai][0][m][0] * rs[ai][m], a1 = acc[ai][0][m][1] * rs[ai][m], b0 = acc[ai][1][m][0] * rs[ai][m], b1 = acc[ai][1][m][1] * rs[ai][m];
                u32x4 w; w.x = cvt_pk_bf16(silu_mul(a0[0], b0[0]), silu_mul(a0[1], b0[1])); w.y = cvt_pk_bf16(silu_mul(a0[2], b0[2]), silu_mul(a0[3], b0[3]));
                w.z = cvt_pk_bf16(silu_mul(a1[0], b1[0]), silu_mul(a1[1], b1[1])); w.w = cvt_pk_bf16(silu_mul(a1[2], b1[2]), silu_mul(a1[3], b1[3]));
                *(u32x4*)rowp = w; }
    }
};

template <bool BASE_BF16, bool OUT_F32, bool OUT_BF16>
struct EpiRes {
    static constexpr bool PERM = true, AFTER_DRAIN = false;
    const void* base; float* C; bf16_t* XB; float* ss; int ldc;
    __device__ __forceinline__ void operator()(const f32x4 (&acc)[2][2][4][2], const Unit& u, int wr, int wc, int fr, int fq) const {
        const int row0 = u.pm * BM + wr * 64 + fr, col0 = u.pn * BM + wc * 32 + 8 * fq;
        constexpr int NA = BASE_BF16 ? 2 : 1;
        float sq[2][4];
#pragma unroll
        for (int ai = 0; ai < 2; ++ai)
#pragma unroll
            for (int m = 0; m < 4; ++m) sq[ai][m] = 0.f;
#pragma unroll
        for (int bj = 0; bj < 2; ++bj)
#pragma unroll
          for (int a0 = 0; a0 < 2; a0 += NA) {
            u32x4 raw[NA][4]; f32x4 f0[NA][4], f1[NA][4];
#pragma unroll
            for (int da = 0; da < NA; ++da)
#pragma unroll
                for (int m = 0; m < 4; ++m) { const size_t off = (size_t)(row0 + (a0 + da) * HALF + m * 16) * ldc + col0 + bj * HALF;
                    if (BASE_BF16) raw[da][m] = *(const u32x4*)((const bf16_t*)base + off);
                    else { f0[da][m] = *(const f32x4*)((const float*)base + off); f1[da][m] = *(const f32x4*)((const float*)base + off + 4); } }
#pragma unroll
            for (int da = 0; da < NA; ++da)
#pragma unroll
                for (int m = 0; m < 4; ++m) { const int ai = a0 + da; const size_t off = (size_t)(row0 + ai * HALF + m * 16) * ldc + col0 + bj * HALF;
                    f32x4 b0, b1;
                    if (BASE_BF16) { const u32x4 w = raw[da][m];
                        b0 = (f32x4){__uint_as_float(w.x << 16), __uint_as_float(w.x & 0xffff0000u), __uint_as_float(w.y << 16), __uint_as_float(w.y & 0xffff0000u)};
                        b1 = (f32x4){__uint_as_float(w.z << 16), __uint_as_float(w.z & 0xffff0000u), __uint_as_float(w.w << 16), __uint_as_float(w.w & 0xffff0000u)}; }
                    else { b0 = f0[da][m]; b1 = f1[da][m]; }
                    const f32x4 r0 = acc[ai][bj][m][0] + b0, r1 = acc[ai][bj][m][1] + b1;
                    if (OUT_F32) { *(f32x4*)(C + off) = r0; *(f32x4*)(C + off + 4) = r1; }
                    if (OUT_BF16) { sq[ai][m] += (r0[0] * r0[0] + r0[1] * r0[1] + r0[2] * r0[2] + r0[3] * r0[3]) + (r1[0] * r1[0] + r1[1] * r1[1] + r1[2] * r1[2] + r1[3] * r1[3]);
                        u32x4 w; w.x = cvt_pk_bf16(r0[0], r0[1]); w.y = cvt_pk_bf16(r0[2], r0[3]); w.z = cvt_pk_bf16(r1[0], r1[1]); w.w = cvt_pk_bf16(r1[2], r1[3]);
                        *(u32x4*)(XB + off) = w; } }
          }
        if (OUT_BF16) {
#pragma unroll
            for (int ai = 0; ai < 2; ++ai)
#pragma unroll
                for (int m = 0; m < 4; ++m) { float s = sq[ai][m]; s += __shfl_xor(s, 16); s += __shfl_xor(s, 32); if (fq == 0) unsafeAtomicAdd(ss + row0 + ai * HALF + m * 16, s); } }
    }
};
template <class Epi, class Sched, bool STAMP = false>
__device__ __forceinline__ void gemm_phase(PG8_LAS unsigned char* lds, const Gemm g, const Sched& S, const Epi& E, unsigned long long* stamps) {
    int tid_ = threadIdx.x; asm volatile("" : "+v"(tid_)); const int tid = tid_, wid = __builtin_amdgcn_readfirstlane(tid >> 6), lane = tid & 63, wr = wid >> 2, wc = wid & 3, fr = lane & 15, fq = lane >> 4;
    const int K = g.K, nt = K / BK;
    int ts_lo = 0, ts_hi = 0, nts = 0; const unsigned long long rt_entry = STAMP ? (unsigned long long)wall_clock64() : 0ull;
#define PG8_STAMP() do { if (STAMP && wid == 0 && nts < 64) { const unsigned long long _c = (unsigned long long)clock64(); \
        ts_lo = (lane == nts) ? (int)(unsigned)_c : ts_lo; ts_hi = (lane == nts) ? (int)(unsigned)(_c >> 32) : ts_hi; ++nts; } } while (0)
    PG8_STAMP();
    unsigned voffA[2], voffB[2];
#pragma unroll
    for (int i = 0; i < 2; ++i) { int R, C; stage_rc(tid * 16 + i * 8192, R, C); const int Rb = Epi::PERM ? ((R & ~31) + perm32(R & 31)) : R;
        voffA[i] = (unsigned)(R * K + C) * 2u; voffB[i] = (unsigned)(Rb * K + C) * 2u; }
    const size_t kstep = (size_t)(BK * 2);
    const size_t hstep = (size_t)HALF * K * 2;
    const size_t tstep = 2 * hstep;
    const unsigned ldsw = (unsigned)wid * 1024u;
    const int aoff = lds_byte(wr * 64 + fr, fq * 8), boff = lds_byte(wc * 32 + fr, fq * 8);
#define PG8_SA(b, h) (((b) * 2 + (h)) * HTB)
#define PG8_SB(b, h) ((4 + (b) * 2 + (h)) * HTB)
#define PG8_STAGE(bufoff, gbase, voff) do { _Pragma("unroll") for (int _i = 0; _i < 2; ++_i) \
        __builtin_amdgcn_global_load_lds((const unsigned*)((const char*)(gbase) + (voff)[_i]), (PG8_LAS unsigned*)(lds + (bufoff) + ldsw + _i * 8192), 16, 0, 0); } while (0)
#define PG8_LDA(dst, b, h) do { _Pragma("unroll") for (int m = 0; m < 4; ++m) _Pragma("unroll") for (int k = 0; k < 2; ++k) dst[m][k] = *(const PG8_LAS bf16x8*)(lds + PG8_SA(b, h) + aoff + m * 2048 + k * 1024); } while (0)
#define PG8_LDB(dst, b, h) do { _Pragma("unroll") for (int n = 0; n < 2; ++n) _Pragma("unroll") for (int k = 0; k < 2; ++k) dst[n][k] = *(const PG8_LAS bf16x8*)(lds + PG8_SB(b, h) + boff + n * 2048 + k * 1024); } while (0)
#define PG8_MMA(ai, bj, At, Bt) do { __builtin_amdgcn_s_setprio(1); _Pragma("unroll") for (int m = 0; m < 4; ++m) _Pragma("unroll") for (int n = 0; n < 2; ++n) _Pragma("unroll") for (int k = 0; k < 2; ++k) \
        acc[ai][bj][m][n] = __builtin_amdgcn_mfma_f32_16x16x32_bf16(Bt[n][k], At[m][k], acc[ai][bj][m][n], 0, 0, 0); __builtin_amdgcn_s_setprio(0); } while (0)
#define PG8_WAIT_V(n) asm volatile("s_waitcnt vmcnt(" #n ")" ::: "memory")
#define PG8_WAIT_L(n) asm volatile("s_waitcnt lgkmcnt(" #n ")" ::: "memory")
#define PG8_BAR __builtin_amdgcn_s_barrier()
#define PG8_SCHED __builtin_amdgcn_sched_barrier(0)
    Unit cur, nxt; int ui = 0;
    if (!S.next(0, cur)) return;
    f32x4 acc[2][2][4][2];
#pragma unroll
    for (int a = 0; a < 2; ++a)
#pragma unroll
        for (int b = 0; b < 2; ++b)
#pragma unroll
            for (int m = 0; m < 4; ++m)
#pragma unroll
                for (int n = 0; n < 2; ++n) acc[a][b][m][n] = (f32x4){0.f, 0.f, 0.f, 0.f};
    bf16x8 At[4][2], B0[2][2], B1[2][2];
    const char* cA = (const char*)g.A + (size_t)cur.pm * tstep; const char* cB = (const char*)g.Bt + (size_t)cur.pn * tstep;
    S.a_ready(cur);
    PG8_STAGE(PG8_SB(0, 0), cB, voffB); PG8_STAGE(PG8_SA(0, 0), cA, voffA); PG8_STAGE(PG8_SB(0, 1), cB + hstep, voffB); PG8_STAGE(PG8_SA(0, 1), cA + hstep, voffA);
    if (wr == 1) PG8_BAR;
    PG8_WAIT_V(4); PG8_BAR;
    PG8_STAGE(PG8_SB(1, 0), cB + kstep, voffB); PG8_STAGE(PG8_SA(1, 0), cA + kstep, voffA); PG8_STAGE(PG8_SB(1, 1), cB + hstep + kstep, voffB);
    PG8_WAIT_V(6); PG8_BAR;
    PG8_STAMP();
    for (;;) {
        const bool has_next = S.next(ui + 1, nxt);
        const char* nA = has_next ? (const char*)g.A + (size_t)nxt.pm * tstep : cA; const char* nB = has_next ? (const char*)g.Bt + (size_t)nxt.pn * tstep : cB;
        for (int t = 0; t < nt; t += 2) {
            const bool last = (t == nt - 2);
            const char* a1 = cA + (size_t)(t + 1) * kstep;
            const char* a2 = last ? nA : cA + (size_t)(t + 2) * kstep; const char* b2 = last ? nB : cB + (size_t)(t + 2) * kstep;
            const char* a3 = a2 + kstep; const char* b3 = b2 + kstep;
            if (last && has_next) S.a_ready(nxt);
            PG8_LDB(B0, 0, 0); PG8_SCHED; PG8_LDA(At, 0, 0); PG8_STAGE(PG8_SA(1, 1), a1 + hstep, voffA);
            PG8_WAIT_L(8); PG8_BAR; PG8_WAIT_L(0); PG8_MMA(0, 0, At, B0); PG8_BAR; PG8_SCHED;
            PG8_LDB(B1, 0, 1); PG8_STAGE(PG8_SB(0, 0), b2, voffB);
            PG8_BAR; PG8_WAIT_L(0); PG8_MMA(0, 1, At, B1); PG8_BAR;
            PG8_LDA(At, 0, 1); PG8_STAGE(PG8_SA(0, 0), a2, voffA);
            PG8_BAR; PG8_WAIT_L(0); PG8_MMA(1, 0, At, B0); PG8_BAR; PG8_SCHED;
            PG8_STAGE(PG8_SB(0, 1), b2 + hstep, voffB);
            PG8_WAIT_V(6); PG8_BAR; PG8_MMA(1, 1, At, B1); PG8_BAR;
            PG8_LDB(B0, 1, 0); PG8_SCHED; PG8_LDA(At, 1, 0); PG8_STAGE(PG8_SA(0, 1), a2 + hstep, voffA);
            PG8_WAIT_L(8); PG8_BAR; PG8_WAIT_L(0); PG8_MMA(0, 0, At, B0); PG8_BAR; PG8_SCHED;
            PG8_LDB(B1, 1, 1); PG8_STAGE(PG8_SB(1, 0), b3, voffB);
            PG8_BAR; PG8_WAIT_L(0); PG8_MMA(0, 1, At, B1); PG8_BAR;
            PG8_LDA(At, 1, 1); PG8_STAGE(PG8_SA(1, 0), a3, voffA);
            PG8_BAR; PG8_WAIT_L(0); PG8_MMA(1, 0, At, B0); PG8_BAR; PG8_SCHED;
            PG8_STAGE(PG8_SB(1, 1), b3 + hstep, voffB);
            PG8_WAIT_V(6); PG8_BAR; PG8_MMA(1, 1, At, B1); PG8_BAR;
        }
        PG8_STAMP();
        if constexpr (!Epi::AFTER_DRAIN) { E(acc, cur, wr, wc, fr, fq); S.done(cur); }
        PG8_STAMP();
        if (!has_next) break;
#pragma unroll
        for (int a = 0; a < 2; ++a)
#pragma unroll
            for (int b = 0; b < 2; ++b)
#pragma unroll
                for (int m = 0; m < 4; ++m)
#pragma unroll
                    for (int n = 0; n < 2; ++n) acc[a][b][m][n] = (f32x4){0.f, 0.f, 0.f, 0.f};
        cur = nxt; cA = nA; cB = nB; ++ui;
    }
    PG8_WAIT_V(0);
    if (wr == 0) PG8_BAR;
    PG8_BAR;
    if constexpr (Epi::AFTER_DRAIN) { E.fused(acc, cur, wr, wc, fr, fq, lds, wid, lane); S.done(cur); }
    PG8_STAMP();
    if (STAMP && wid == 0) { stamps[lane] = lane < nts ? (((unsigned long long)(unsigned)ts_hi << 32) | (unsigned)ts_lo) : 0ull;
        if (lane == 62) stamps[62] = rt_entry; if (lane == 63) stamps[63] = (unsigned long long)wall_clock64(); }
#undef PG8_STAMP
#undef PG8_SA
#undef PG8_SB
#undef PG8_STAGE
#undef PG8_LDA
#undef PG8_LDB
#undef PG8_MMA
#undef PG8_WAIT_V
#undef PG8_WAIT_L
#undef PG8_BAR
#undef PG8_SCHED
}
}

#define LAS __attribute__((address_space(3)))
typedef unsigned short u16;
typedef short bf16x8 __attribute__((ext_vector_type(8)));
typedef short bf16x4 __attribute__((ext_vector_type(4)));
typedef float f32x4 __attribute__((ext_vector_type(4)));
typedef unsigned u32x4 __attribute__((ext_vector_type(4)));
typedef unsigned u32x2 __attribute__((ext_vector_type(2)));

constexpr int T_ = 32768, S_ = 4096, D_ = 2048, DFF_ = 5632, DIN_ = 5136, ZC_ = 5120, QC_ = 6144;
constexpr int LDS_MAIN = 139264, LDS_BYTES = LDS_MAIN + 16;
constexpr size_t SZ_WIN = (size_t)ZC_ * D_ * 2, SZ_WSQ = (size_t)D_ * D_ * 2, SZ_WQKV = (size_t)QC_ * D_ * 2, SZ_W13 = (size_t)2 * DFF_ * D_ * 2, SZ_W2 = (size_t)D_ * DFF_ * 2;
constexpr size_t OFF_WIN = 0, OFF_WOUT = OFF_WIN + SZ_WIN, OFF_WQKV = OFF_WOUT + SZ_WSQ, OFF_WO = OFF_WQKV + SZ_WQKV, OFF_W13 = OFF_WO + SZ_WSQ, OFF_W2 = OFF_W13 + 2 * SZ_W13,
                 OFF_WRG = OFF_W2 + 2 * SZ_W2, OFF_XN = OFF_WRG + (size_t)64 * 16384 * 2, OFF_BIG = OFF_XN + (size_t)T_ * D_ * 2, OFF_MIX = OFF_BIG + (size_t)T_ * QC_ * 2,
                 OFF_GATES = OFF_MIX + (size_t)T_ * D_ * 4, OFF_RGSUM = OFF_GATES + (size_t)T_ * 16 * 4, OFF_RGCAR = OFF_RGSUM + (size_t)8 * 64 * 2 * 1024 * 8,
                 OFF_LSE = OFF_RGCAR + (size_t)8 * 64 * 2 * 1024 * 4, OFF_SS = OFF_LSE + (size_t)3 * T_ * 16 * 4, OFF_BAR = OFF_SS + (size_t)4 * T_ * 4, WS_END = OFF_BAR + 16384;

struct Seg { const float* src; u16* dst; const float* gain; int ld, K, nN32, mode, rowoff, ntiles; };
struct Params {
    const float *x, *e_norm, *e_w_in, *e_gate_b, *e_conv_w, *e_conv_b, *e_rg_wa, *e_rg_ba, *e_rg_wx, *e_rg_bx, *e_rg_lam, *e_head_g, *e_w_out, *o_norm, *o_w_qkv, *o_w_o, *f_norm, *f_w1, *f_w3, *f_w2, *final_norm;
    float* out; unsigned char* ws;
    Seg seg[12]; int nseg, total_tiles;
};


typedef const __attribute__((address_space(4))) Params* PP;
__device__ __forceinline__ PP get_params() { auto k = __builtin_amdgcn_kernarg_segment_ptr(); asm volatile("" : "+s"(k)); return (PP)k; }
__device__ __forceinline__ int l_tid() { int t = threadIdx.x; asm volatile("" : "+v"(t)); return t; }
extern __shared__ __attribute__((aligned(16))) unsigned char lds_raw[];
__device__ __forceinline__ int l_bid() { int t = __builtin_amdgcn_readfirstlane(*(volatile LAS int*)((LAS unsigned char*)lds_raw + 139264 + 8)); asm volatile("" : "+s"(t)); return t; }
__device__ __forceinline__ int l_nblk() { int t = gridDim.x; asm volatile("" : "+s"(t)); return t; }
__device__ __forceinline__ unsigned pk2(float lo, float hi) { return pg8::cvt_pk_bf16(lo, hi); }
__device__ __forceinline__ float bflo(unsigned w) { return __uint_as_float(w << 16); }
__device__ __forceinline__ float bfhi(unsigned w) { return __uint_as_float(w & 0xffff0000u); }
__device__ __forceinline__ float wave_sum(float v) {
#pragma unroll
    for (int o = 1; o < 64; o <<= 1) v += __shfl_xor(v, o);
    return v;
}
__device__ __forceinline__ bf16x8 cat8(bf16x4 a, bf16x4 b) { return __builtin_shufflevector(a, b, 0, 1, 2, 3, 4, 5, 6, 7); }
__device__ __forceinline__ bf16x4 lds_tr(LAS unsigned char* p) { return __builtin_amdgcn_ds_read_tr16_b64_v4i16((LAS bf16x4*)p); }
__device__ __forceinline__ bf16x8 lds_r8(LAS unsigned char* p) { return *(LAS bf16x8*)p; }
__device__ __forceinline__ bf16x8 as_bf16x8(u32x4 v) { union { u32x4 u; bf16x8 b; } c; c.u = v; return c.b; }
#define MFMA16(a, b, c) __builtin_amdgcn_mfma_f32_16x16x32_bf16((a), (b), (c), 0, 0, 0)
#define LDSWAIT() asm volatile("s_waitcnt lgkmcnt(0)" ::: "memory")
__device__ __forceinline__ float sigmoidf_(float v) { return __builtin_amdgcn_rcpf(1.0f + __expf(-v)); }

__device__ __forceinline__ void transpose_item(const float* src, const float* gain, int ld, u16* dst, int K, int nN32, int mode, int rowoff, int item, LAS float* scr, int lane) {
    const int nb = item % nN32, kb = item / nN32, k0 = 64 * kb, n0 = 32 * nb;
#pragma unroll 8
    for (int i = 0; i < 32; ++i) { const int kk = 2 * i + (lane >> 5); scr[kk * 33 + (lane & 31)] = __builtin_nontemporal_load(src + (size_t)(k0 + kk) * ld + n0 + (lane & 31)); }
    LDSWAIT();
    const int R0 = mode ? (((n0 >> 7) << 8) + (n0 & 127) + rowoff) : (n0 + rowoff);
    const int c = lane & 7;
    f32x4 g0 = (f32x4){1.f, 1.f, 1.f, 1.f}, g1 = g0;
    if (gain) { g0 = *(const f32x4*)(gain + k0 + 8 * c); g1 = *(const f32x4*)(gain + k0 + 8 * c + 4); }
#pragma unroll
    for (int j = 0; j < 4; ++j) { const int n = (lane >> 3) + 8 * j; const LAS float* s = scr + (8 * c) * 33 + n;
        u32x4 o; o.x = pk2(s[0 * 33] * g0.x, s[1 * 33] * g0.y); o.y = pk2(s[2 * 33] * g0.z, s[3 * 33] * g0.w); o.z = pk2(s[4 * 33] * g1.x, s[5 * 33] * g1.y); o.w = pk2(s[6 * 33] * g1.z, s[7 * 33] * g1.w);
        *(u32x4*)(dst + (size_t)(R0 + n) * K + k0 + 8 * c) = o; }
    LDSWAIT();
}

__device__ __forceinline__ void phase0(LAS unsigned char* L) { PP p = get_params();
    const int tid = l_tid(), lane = tid & 63, wid = tid >> 6;
    const int gw = l_bid() * 8 + wid, NGW = l_nblk() * 8;
    LAS float* scr = (LAS float*)(L + wid * 8704);
    for (int it = gw; it < p->total_tiles; it += NGW) {
        int r = it, si = 0;
        while (r >= p->seg[si].ntiles) { r -= p->seg[si].ntiles; ++si; }
        transpose_item(p->seg[si].src, p->seg[si].gain, p->seg[si].ld, p->seg[si].dst, p->seg[si].K, p->seg[si].nN32, p->seg[si].mode, p->seg[si].rowoff, r, scr, lane);
    }
    for (int it = gw; it < 256; it += NGW) {
        const int mi = it >> 3, sub = it & 7, mat = mi >> 4, dn = mi & 15;
        const float* src = (mat ? p->e_rg_wx : p->e_rg_wa) + (size_t)dn * 16384;
        u16* dst = (u16*)(p->ws + OFF_WRG) + (size_t)((((dn >> 3) * 2 + mat) * 8) + (dn & 7)) * 16384;
        transpose_item(src, nullptr, 128, dst, 128, 4, 0, 0, sub, scr, lane);
    }
    asm volatile("s_waitcnt vmcnt(0)" ::: "memory");
    __syncthreads();
    { float* SSZ = (float*)(p->ws + OFF_SS); for (int i = l_bid() * 512 + tid; i < 4 * T_; i += l_nblk() * 512) SSZ[i] = 0.f; }
    LAS float* WgT = (LAS float*)L;
    for (int k = tid; k < D_; k += 512) {
        const float* s = p->e_w_in + (size_t)k * DIN_ + 3072;
#pragma unroll
        for (int c = 0; c < 4; ++c) { const f32x4 v = *(const f32x4*)(s + 4 * c);
            WgT[(4 * c + 0) * D_ + k] = v.x; WgT[(4 * c + 1) * D_ + k] = v.y; WgT[(4 * c + 2) * D_ + k] = v.z; WgT[(4 * c + 3) * D_ + k] = v.w; }
    }
    __syncthreads();
    u16* XN = (u16*)(p->ws + OFF_XN);
    float* GT = (float*)(p->ws + OFF_GATES);
    f32x4 gk[8];
#pragma unroll
    for (int i = 0; i < 8; ++i) gk[i] = *(const f32x4*)(p->e_norm + 256 * i + 4 * lane);
    const float gb = p->e_gate_b[(lane >> 1) & 15];
    for (int rp = gw; rp < T_ / 2; rp += NGW) {
        const float* x0 = p->x + (size_t)(2 * rp) * D_; const float* x1 = x0 + D_;
        f32x4 a[8], b[8]; float s0 = 0.f, s1 = 0.f;
#pragma unroll
        for (int i = 0; i < 8; ++i) { a[i] = __builtin_nontemporal_load((const f32x4*)(x0 + 256 * i + 4 * lane)); b[i] = __builtin_nontemporal_load((const f32x4*)(x1 + 256 * i + 4 * lane));
            s0 += a[i].x * a[i].x + a[i].y * a[i].y + a[i].z * a[i].z + a[i].w * a[i].w; s1 += b[i].x * b[i].x + b[i].y * b[i].y + b[i].z * b[i].z + b[i].w * b[i].w; }
        const float r0 = rsqrtf(wave_sum(s0) * (1.0f / D_) + 1e-6f), r1 = rsqrtf(wave_sum(s1) * (1.0f / D_) + 1e-6f);
        u16* o0 = XN + (size_t)(2 * rp) * D_; u16* o1 = o0 + D_;
#pragma unroll
        for (int i = 0; i < 8; ++i) { a[i] = a[i] * r0 * gk[i]; b[i] = b[i] * r1 * gk[i];
            u32x2 w0, w1; w0.x = pk2(a[i].x, a[i].y); w0.y = pk2(a[i].z, a[i].w); w1.x = pk2(b[i].x, b[i].y); w1.y = pk2(b[i].z, b[i].w);
            *(u32x2*)(o0 + 256 * i + 4 * lane) = w0; *(u32x2*)(o1 + 256 * i + 4 * lane) = w1; }
        float v[32];
#pragma unroll
        for (int j = 0; j < 16; ++j) { float c0 = 0.f, c1 = 0.f;
#pragma unroll
            for (int i = 0; i < 8; ++i) { const f32x4 w = *(LAS f32x4*)(WgT + j * D_ + 256 * i + 4 * lane);
                c0 += a[i].x * w.x + a[i].y * w.y + a[i].z * w.z + a[i].w * w.w; c1 += b[i].x * w.x + b[i].y * w.y + b[i].z * w.z + b[i].w * w.w; }
            v[j] = c0; v[16 + j] = c1; }
#pragma unroll
        for (int j = 0; j < 16; ++j) { const bool hi = lane & 32; const float keep = hi ? v[j + 16] : v[j], send = hi ? v[j] : v[j + 16]; v[j] = keep + __shfl_xor(send, 32); }
#pragma unroll
        for (int j = 0; j < 8; ++j) { const bool hi = lane & 16; const float keep = hi ? v[j + 8] : v[j], send = hi ? v[j] : v[j + 8]; v[j] = keep + __shfl_xor(send, 16); }
#pragma unroll
        for (int j = 0; j < 4; ++j) { const bool hi = lane & 8; const float keep = hi ? v[j + 4] : v[j], send = hi ? v[j] : v[j + 4]; v[j] = keep + __shfl_xor(send, 8); }
#pragma unroll
        for (int j = 0; j < 2; ++j) { const bool hi = lane & 4; const float keep = hi ? v[j + 2] : v[j], send = hi ? v[j] : v[j + 2]; v[j] = keep + __shfl_xor(send, 4); }
        { const bool hi = lane & 2; const float keep = hi ? v[1] : v[0], send = hi ? v[0] : v[1]; v[0] = keep + __shfl_xor(send, 2); }
        v[0] += __shfl_xor(v[0], 1);
        if ((lane & 1) == 0) { const int idx = lane >> 1; GT[(size_t)(2 * rp + (idx >> 4)) * 16 + (idx & 15)] = v[0] + gb; }
    }
}

template <bool TO_F32>
__device__ __forceinline__ void norm_phase(const float* X, const float* g, u16* O, float* OF) {
    const int tid = l_tid(), lane = tid & 63, wid = tid >> 6;
    const int gw = l_bid() * 8 + wid, NGW = l_nblk() * 8;
    f32x4 gk[8];
#pragma unroll
    for (int i = 0; i < 8; ++i) gk[i] = *(const f32x4*)(g + 256 * i + 4 * lane);
    for (int row = gw; row < T_; row += NGW) {
        const float* x0 = X + (size_t)row * D_;
        f32x4 a[8]; float s0 = 0.f;
#pragma unroll
        for (int i = 0; i < 8; ++i) { a[i] = *(const f32x4*)(x0 + 256 * i + 4 * lane); s0 += a[i].x * a[i].x + a[i].y * a[i].y + a[i].z * a[i].z + a[i].w * a[i].w; }
        const float r0 = rsqrtf(wave_sum(s0) * (1.0f / D_) + 1e-6f);
#pragma unroll
        for (int i = 0; i < 8; ++i) { a[i] = a[i] * r0 * gk[i];
            if (TO_F32) *(f32x4*)(OF + (size_t)row * D_ + 256 * i + 4 * lane) = a[i];
            else { u32x2 w0; w0.x = pk2(a[i].x, a[i].y); w0.y = pk2(a[i].z, a[i].w); *(u32x2*)(O + (size_t)row * D_ + 256 * i + 4 * lane) = w0; } }
    }
}

__device__ __forceinline__ float scan_add64(float v, int lane) {
#pragma unroll
    for (int d = 1; d < 64; d <<= 1) { const float t = __shfl_up(v, d); if (lane >= d) v += t; }
    return v;
}
__device__ __forceinline__ float scan_max64(float v, int lane) {
#pragma unroll
    for (int d = 1; d < 64; d <<= 1) { const float t = __shfl_up(v, d); if (lane >= d) v = fmaxf(v, t); }
    return v;
}
struct GateV { float a, g, wsrc, winter, mout, decay, mnext; };
__device__ __forceinline__ GateV gate_math(float gi, float gf, float m_carry, int lane) {
    GateV o;
    const float lf = (gf >= 0.f) ? -log1pf(__expf(-gf)) : (gf - log1pf(__expf(gf)));
    const float b = scan_add64(lf, lane);
    o.a = gi - b;
    const float M = scan_max64(o.a, lane);
    o.g = fmaxf(m_carry, M);
    const float bL = __shfl(b, 63), g63 = __shfl(o.g, 63);
    o.wsrc = __expf(o.a - g63); o.decay = __expf(m_carry - g63); o.winter = __expf(m_carry - o.g); o.mout = b + o.g; o.mnext = bL + g63;
    return o;
}

__device__ __forceinline__ void mlstm_phase(LAS unsigned char* L) { PP p = get_params();
    const int tid = l_tid(), lane = tid & 63, wid = __builtin_amdgcn_readfirstlane(tid >> 6), l15 = lane & 15, quad = lane >> 4;
    const u16* Z = (const u16*)(p->ws + OFF_BIG);
    const float* GT = (const float*)(p->ws + OFF_GATES);
    u16* HB = (u16*)(p->ws + OFF_MIX);
    constexpr int QS = 0, KS = 17408, VS = 34816, VW = 46080, CB = 57344, GA = 79104, GB = GA + 16384, GM = GB + 16384, GC = GM + 16384;
    constexpr float QSCALE = 0.08838834764831845f;
    const int r = tid >> 3, pc = tid & 7;
    const int lt = wid & 3, dvh = wid >> 2, lidx = 16 * lt + l15;
    for (int item = l_bid(); item < 256; item += l_nblk()) {
        const int dvq = item & 3, dir = (item >> 2) & 1, hh = (item >> 3) & 3, b = item >> 5;
        const size_t tok0 = (size_t)b * S_;
        u32x4 nq0, nq1, nk0, nk1, nv;
        {   const int pp = r; const int t = dir ? (S_ - 1 - pp) : pp; const u16* zr = Z + (tok0 + t) * ZC_;
            nq0 = *(const u32x4*)(zr + hh * 128 + 8 * pc); nq1 = *(const u32x4*)(zr + hh * 128 + 64 + 8 * pc);
            nk0 = *(const u32x4*)(zr + 512 + hh * 128 + 8 * pc); nk1 = *(const u32x4*)(zr + 512 + hh * 128 + 64 + 8 * pc);
            nv = *(const u32x4*)(zr + 1024 + hh * 256 + dvq * 64 + 8 * pc); }
#pragma unroll 2
        for (int k = 0; k < 8; ++k) { const int c = wid + 8 * k; const int pl = 64 * c + lane; const int tl = dir ? (S_ - 1 - pl) : pl; const float* gr = GT + (tok0 + tl) * 16;
            const float gi = gr[(2 * dir) * 4 + hh], gf = gr[(2 * dir + 1) * 4 + hh];
            const float lf = (gf >= 0.f) ? -log1pf(__expf(-gf)) : (gf - log1pf(__expf(gf)));
            const float bb = scan_add64(lf, lane), aa = gi - bb, MM = scan_max64(aa, lane);
            *(LAS float*)(L + GA + (c * 64 + lane) * 4) = aa; *(LAS float*)(L + GB + (c * 64 + lane) * 4) = bb; *(LAS float*)(L + GM + (c * 64 + lane) * 4) = MM; }
        f32x4 Cacc[5];
#pragma unroll
        for (int i = 0; i < 5; ++i) Cacc[i] = (f32x4){0.f, 0.f, 0.f, 0.f};
        for (int i = tid; i < 1360; i += 512) *(LAS u32x4*)(L + CB + i * 16) = (u32x4){0u, 0u, 0u, 0u};
        __syncthreads();
        if (wid == 0) {
            float m = -1e30f, mine = 0.f;
            for (int c = 0; c < 64; ++c) { const float bL = *(LAS float*)(L + GB + (c * 64 + 63) * 4), M63 = *(LAS float*)(L + GM + (c * 64 + 63) * 4);
                mine = (lane == c) ? m : mine; m = bL + fmaxf(m, M63); }
            *(LAS float*)(L + GC + lane * 4) = mine;
        }
        __syncthreads();
#define MLSTM_STAGE(cs) do { \
            *(LAS u32x4*)(L + QS + r * 272 + pc * 16) = nq0; *(LAS u32x4*)(L + QS + r * 272 + 128 + pc * 16) = nq1; \
            *(LAS u32x4*)(L + KS + r * 272 + pc * 16) = nk0; *(LAS u32x4*)(L + KS + r * 272 + 128 + pc * 16) = nk1; \
            *(LAS u32x4*)(L + VS + r * 176 + pc * 16) = nv; \
            const float g63_ = fmaxf(*(LAS float*)(L + GC + (cs) * 4), *(LAS float*)(L + GM + ((cs) * 64 + 63) * 4)); \
            const float wr_ = __expf(*(LAS float*)(L + GA + ((cs) * 64 + r) * 4) - g63_); u32x4 sv; \
            sv.x = pk2(bflo(nv.x) * wr_, bfhi(nv.x) * wr_); sv.y = pk2(bflo(nv.y) * wr_, bfhi(nv.y) * wr_); sv.z = pk2(bflo(nv.z) * wr_, bfhi(nv.z) * wr_); sv.w = pk2(bflo(nv.w) * wr_, bfhi(nv.w) * wr_); \
            *(LAS u32x4*)(L + VW + r * 176 + pc * 16) = sv; \
            if (pc < 2) { u32x4 one = (u32x4){pc == 0 ? 0x3F80u : 0u, 0u, 0u, 0u}; u32x4 ws_ = (u32x4){pc == 0 ? (pk2(wr_, 0.f) & 0xffffu) : 0u, 0u, 0u, 0u}; \
                *(LAS u32x4*)(L + VS + r * 176 + 128 + pc * 16) = one; *(LAS u32x4*)(L + VW + r * 176 + 128 + pc * 16) = ws_; } \
        } while (0)
        MLSTM_STAGE(0);
        for (int c = 0; c < 64; ++c) {
            if (c + 1 < 64) {
                const int pp = 64 * (c + 1) + r; const int t = dir ? (S_ - 1 - pp) : pp; const u16* zr = Z + (tok0 + t) * ZC_;
                nq0 = *(const u32x4*)(zr + hh * 128 + 8 * pc); nq1 = *(const u32x4*)(zr + hh * 128 + 64 + 8 * pc);
                nk0 = *(const u32x4*)(zr + 512 + hh * 128 + 8 * pc); nk1 = *(const u32x4*)(zr + 512 + hh * 128 + 64 + 8 * pc);
                nv = *(const u32x4*)(zr + 1024 + hh * 256 + dvq * 64 + 8 * pc);
            }
            __syncthreads();
            const float m_c = *(LAS float*)(L + GC + c * 4);
            const float g63 = fmaxf(m_c, *(LAS float*)(L + GM + (c * 64 + 63) * 4));
            const float g_l = fmaxf(m_c, *(LAS float*)(L + GM + (c * 64 + lidx) * 4));
            const float winter_l = __expf(m_c - g_l), mout_l = *(LAS float*)(L + GB + (c * 64 + lidx) * 4) + g_l;
            bf16x8 qf[4];
#pragma unroll
            for (int ks = 0; ks < 4; ++ks) qf[ks] = lds_r8(L + QS + (16 * lt + l15) * 272 + (32 * ks + 8 * quad) * 2);
            f32x4 sacc[4];
#pragma unroll
            for (int st = 0; st < 4; ++st) { sacc[st] = (f32x4){0.f, 0.f, 0.f, 0.f};
                if (st <= lt) {
#pragma unroll
                    for (int ks = 0; ks < 4; ++ks) { const bf16x8 kf = lds_r8(L + KS + (16 * st + l15) * 272 + (32 * ks + 8 * quad) * 2); sacc[st] = MFMA16(kf, qf[ks], sacc[st]); } } }
            float pw[4][4];
#pragma unroll
            for (int st = 0; st < 4; ++st) { const f32x4 a4 = *(LAS f32x4*)(L + GA + (c * 64 + 16 * st + 4 * quad) * 4);
#pragma unroll
                for (int jj = 0; jj < 4; ++jj) { const int sidx = 16 * st + 4 * quad + jj;
                    const float w = (sidx <= lidx) ? __expf(a4[jj] - g_l) * QSCALE : 0.f; pw[st][jj] = sacc[st][jj] * w; } }
            bf16x8 pf[2];
#pragma unroll
            for (int i = 0; i < 2; ++i) { u32x4 t; t.x = pk2(pw[2 * i][0], pw[2 * i][1]); t.y = pk2(pw[2 * i][2], pw[2 * i][3]); t.z = pk2(pw[2 * i + 1][0], pw[2 * i + 1][1]); t.w = pk2(pw[2 * i + 1][2], pw[2 * i + 1][3]); pf[i] = as_bf16x8(t); }
            f32x4 nacc[3];
#pragma unroll
            for (int x = 0; x < 3; ++x) { const int dt = (x < 2) ? (2 * dvh + x) : 4; nacc[x] = (f32x4){0.f, 0.f, 0.f, 0.f};
#pragma unroll
                for (int ks = 0; ks < 4; ++ks) { const bf16x8 cf = lds_r8(L + CB + (16 * dt + l15) * 272 + (32 * ks + 8 * quad) * 2); nacc[x] = MFMA16(cf, qf[ks], nacc[x]); }
                nacc[x] = nacc[x] * (winter_l * QSCALE);
#pragma unroll
                for (int i = 0; i < 2; ++i) {
                    const bf16x4 lo = lds_tr(L + VS + (32 * i + 4 * quad + (l15 >> 2)) * 176 + (16 * dt + 4 * (l15 & 3)) * 2);
                    const bf16x4 hi = lds_tr(L + VS + (32 * i + 16 + 4 * quad + (l15 >> 2)) * 176 + (16 * dt + 4 * (l15 & 3)) * 2);
                    nacc[x] = MFMA16(cat8(lo, hi), pf[i], nacc[x]); } }
            const float den = __shfl(nacc[2][0], l15);
            const float inv = 1.0f / fmaxf(fabsf(den), __expf(-mout_l));
            {   const int pp = 64 * c + lidx; const int t = dir ? (S_ - 1 - pp) : pp;
                u16* hrow = HB + ((size_t)dir * T_ + tok0 + t) * 1024 + hh * 256 + dvq * 64 + 4 * quad;
#pragma unroll
                for (int x = 0; x < 2; ++x) { const f32x4 hv = nacc[x] * inv; u32x2 w; w.x = pk2(hv[0], hv[1]); w.y = pk2(hv[2], hv[3]); *(u32x2*)(hrow + 16 * (2 * dvh + x)) = w; } }
            const float decay = __expf(m_c - g63);
#pragma unroll
            for (int dt = 0; dt < 5; ++dt) Cacc[dt] = Cacc[dt] * decay;
#pragma unroll
            for (int i = 0; i < 2; ++i) {
                const bf16x4 alo = lds_tr(L + KS + (32 * i + 8 * quad + (l15 >> 2)) * 272 + (16 * wid + 4 * (l15 & 3)) * 2);
                const bf16x4 ahi = lds_tr(L + KS + (32 * i + 8 * quad + 4 + (l15 >> 2)) * 272 + (16 * wid + 4 * (l15 & 3)) * 2);
                const bf16x8 kf = cat8(alo, ahi);
#pragma unroll
                for (int dt = 0; dt < 5; ++dt) {
                    const bf16x4 blo = lds_tr(L + VW + (32 * i + 8 * quad + (l15 >> 2)) * 176 + (16 * dt + 4 * (l15 & 3)) * 2);
                    const bf16x4 bhi = lds_tr(L + VW + (32 * i + 8 * quad + 4 + (l15 >> 2)) * 176 + (16 * dt + 4 * (l15 & 3)) * 2);
                    Cacc[dt] = MFMA16(kf, cat8(blo, bhi), Cacc[dt]); } }
            __syncthreads();
#pragma unroll
            for (int dt = 0; dt < 5; ++dt) { u32x2 w; w.x = pk2(Cacc[dt][0], Cacc[dt][1]); w.y = pk2(Cacc[dt][2], Cacc[dt][3]);
                *(LAS u32x2*)(L + CB + (16 * dt + l15) * 272 + (16 * wid + 4 * quad) * 2) = w; }
            if (c + 1 < 64) { MLSTM_STAGE(c + 1); }
        }
        __syncthreads();
    }
#undef MLSTM_STAGE
}

__device__ __forceinline__ void mlstm_combine_phase() { PP p = get_params();
    const int tid = l_tid(), lane = tid & 63, wid = tid >> 6;
    const int gw = l_bid() * 8 + wid, NGW = l_nblk() * 8;
    const u16* Z = (const u16*)(p->ws + OFF_BIG);
    const u16* HB = (const u16*)(p->ws + OFF_MIX);
    u16* Y = (u16*)(p->ws + OFF_XN);
    for (int it = gw; it < T_ * 4; it += NGW) {
        const int t = it >> 2, hh = it & 3;
        const u32x2 fw = *(const u32x2*)(HB + (size_t)t * 1024 + hh * 256 + 4 * lane), bw = *(const u32x2*)(HB + ((size_t)T_ + t) * 1024 + hh * 256 + 4 * lane);
        const f32x4 hm = (f32x4){bflo(fw.x) + bflo(bw.x), bfhi(fw.x) + bfhi(bw.x), bflo(fw.y) + bflo(bw.y), bfhi(fw.y) + bfhi(bw.y)};
        const float ss = wave_sum(hm.x * hm.x + hm.y * hm.y + hm.z * hm.z + hm.w * hm.w);
        const float rs = rsqrtf(ss * (1.0f / 256.f) + 1e-6f);
        const f32x4 hg = *(const f32x4*)(p->e_head_g + hh * 256 + 4 * lane);
        const u32x2 ob = *(const u32x2*)(Z + (size_t)t * ZC_ + 2048 + hh * 256 + 4 * lane);
        u32x2 w; w.x = pk2(hm.x * rs * hg.x * sigmoidf_(bflo(ob.x)), hm.y * rs * hg.y * sigmoidf_(bfhi(ob.x)));
        w.y = pk2(hm.z * rs * hg.z * sigmoidf_(bflo(ob.y)), hm.w * rs * hg.w * sigmoidf_(bfhi(ob.y)));
        *(u32x2*)(Y + (size_t)t * D_ + hh * 256 + 4 * lane) = w;
    }
}

__device__ __forceinline__ float gelu_tanh(float v) { const float u = 0.7978845608028654f * (v + 0.044715f * v * v * v); const float e = __expf(2.0f * u); return 0.5f * v * (1.0f + (1.0f - 2.0f * __builtin_amdgcn_rcpf(e + 1.0f))); }

__device__ __forceinline__ float softplus_neg(float v) { const float x = __expf(-v); return (x < 0.1f) ? x * (1.0f - x * (0.5f - x * (0.33333334f - x * (0.25f - x * 0.2f)))) : __logf(1.0f + x); }
template <bool FINAL>
__device__ __forceinline__ void rglru_phase(LAS unsigned char* L) { PP p = get_params();
    const int tid = l_tid(), lane = tid & 63, wid = __builtin_amdgcn_readfirstlane(tid >> 6), l15 = lane & 15, quad = lane >> 4;
    const u16* Z = (const u16*)(p->ws + OFF_BIG);
    const u16* WRG = (const u16*)(p->ws + OFF_WRG);
    float2* SUM = (float2*)(p->ws + OFF_RGSUM);
    const float* CAR = (const float*)(p->ws + OFF_RGCAR);
    u16* Y = (u16*)(p->ws + OFF_XN);
    const int cgp = tid & 15, tq = tid >> 4;
    for (int grp = l_bid(); grp < 256; grp += l_nblk()) {
        const int b = grp >> 5, n = (grp >> 2) & 7, seg = grp & 3;
        const size_t tok0 = (size_t)b * S_;
        const int chb = n * 128 + 8 * cgp, ch0 = n * 128 + 16 * wid + 4 * quad;
        __syncthreads();
        LAS float* CW = (LAS float*)(L + 34816);
        for (int i = tid; i < 640; i += 512) { const int j = i >> 7, c = i & 127; CW[i] = (j < 4) ? p->e_conv_w[j * 1024 + n * 128 + c] : p->e_conv_b[n * 128 + c]; }
        LAS float* CB2 = CW + 640;
        for (int i = tid; i < 768; i += 512) { const int dir = i / 384, k = (i % 384) >> 7, c = i & 127; const int gi = dir * 1024 + n * 128 + c;
            CB2[i] = (k == 0) ? p->e_rg_ba[gi] : (k == 1) ? p->e_rg_bx[gi] : (-8.0f * softplus_neg(p->e_rg_lam[gi])); }
        u32x4 pre[5];
#define RG_ISSUE(tile_) do { _Pragma("unroll") for (int j = 0; j < 5; ++j) { const int pos = 64 * (tile_) + 2 * tq - 2 + j; pre[j] = (u32x4){0u, 0u, 0u, 0u}; \
            if (pos >= 0 && pos < S_) pre[j] = *(const u32x4*)(Z + (tok0 + pos) * ZC_ + 3072 + chb); } } while (0)
        RG_ISSUE(seg * 16);
        __syncthreads();
        for (int i = 0; i < 16; ++i) {
            const int tile = seg * 16 + i;
            LAS unsigned char* Xb = L + (i & 1) * 17408;
#pragma unroll
            for (int hh = 0; hh < 2; ++hh) { const int tl = 2 * tq + hh;
                float acc[8];
                { const f32x4 c0 = *(LAS f32x4*)(CW + 512 + 8 * cgp), c1 = *(LAS f32x4*)(CW + 512 + 8 * cgp + 4);
                  acc[0] = c0.x; acc[1] = c0.y; acc[2] = c0.z; acc[3] = c0.w; acc[4] = c1.x; acc[5] = c1.y; acc[6] = c1.z; acc[7] = c1.w; }
#pragma unroll
                for (int j = 0; j < 4; ++j) { const u32x4 v = pre[hh + j]; const f32x4 w0 = *(LAS f32x4*)(CW + j * 128 + 8 * cgp), w1 = *(LAS f32x4*)(CW + j * 128 + 8 * cgp + 4);
                    acc[0] += bflo(v.x) * w0.x; acc[1] += bfhi(v.x) * w0.y; acc[2] += bflo(v.y) * w0.z; acc[3] += bfhi(v.y) * w0.w;
                    acc[4] += bflo(v.z) * w1.x; acc[5] += bfhi(v.z) * w1.y; acc[6] += bflo(v.w) * w1.z; acc[7] += bfhi(v.w) * w1.w; }
                u32x4 o; o.x = pk2(acc[0], acc[1]); o.y = pk2(acc[2], acc[3]); o.z = pk2(acc[4], acc[5]); o.w = pk2(acc[6], acc[7]);
                *(LAS u32x4*)(Xb + (16 * (tl & 3) + (tl >> 2)) * 272 + cgp * 16) = o; }
            __syncthreads();
            if (i + 1 < 16) RG_ISSUE(tile + 1);
            float cin[2][4];
            if (FINAL) {
#pragma unroll
                for (int dir = 0; dir < 2; ++dir) { const f32x4 c4 = *(const f32x4*)(CAR + ((size_t)((b * 64 + tile) * 2 + dir)) * 1024 + ch0); cin[dir][0] = c4.x; cin[dir][1] = c4.y; cin[dir][2] = c4.z; cin[dir][3] = c4.w; }
            }
            float hsum[4][4];
#pragma unroll
            for (int tt = 0; tt < 4; ++tt)
#pragma unroll
                for (int jj = 0; jj < 4; ++jj) hsum[tt][jj] = 0.f;
#pragma unroll
            for (int dir = 0; dir < 2; ++dir) {
                bf16x8 wa[4], wx[4];
                {   const u16* wb = WRG + (size_t)(((dir * 2 + 0) * 8) + n) * 16384 + (16 * wid + l15) * 128 + 8 * quad;
#pragma unroll
                    for (int ks = 0; ks < 4; ++ks) { wa[ks] = *(const bf16x8*)(wb + 32 * ks); wx[ks] = *(const bf16x8*)(wb + (size_t)8 * 16384 + 32 * ks); } }
                const f32x4 ba4v = *(LAS f32x4*)(CB2 + dir * 384 + 16 * wid + 4 * quad), bx4v = *(LAS f32x4*)(CB2 + dir * 384 + 128 + 16 * wid + 4 * quad), cf4v = *(LAS f32x4*)(CB2 + dir * 384 + 256 + 16 * wid + 4 * quad);
                float av[4][4], uv[4][4];
#pragma unroll
                for (int tt = 0; tt < 4; ++tt) {
                    f32x4 pa = (f32x4){0.f, 0.f, 0.f, 0.f}, px = (f32x4){0.f, 0.f, 0.f, 0.f};
#pragma unroll
                    for (int ks = 0; ks < 4; ++ks) { const bf16x8 xf = lds_r8(Xb + (16 * tt + l15) * 272 + (32 * ks + 8 * quad) * 2); pa = MFMA16(wa[ks], xf, pa); px = MFMA16(wx[ks], xf, px); }
                    const u32x2 xc = *(LAS u32x2*)(Xb + (16 * tt + l15) * 272 + (16 * wid + 4 * quad) * 2);
                    const float xv[4] = {bflo(xc.x), bfhi(xc.x), bflo(xc.y), bfhi(xc.y)};
#pragma unroll
                    for (int jj = 0; jj < 4; ++jj) { const float rr = sigmoidf_(pa[jj] + ba4v[jj]), ii = sigmoidf_(px[jj] + bx4v[jj]); const float la = cf4v[jj] * rr, x2 = 2.0f * la;
                        const float em = -x2 * (1.0f + x2 * (0.5f + x2 * (0.16666667f + x2 * (0.041666668f + x2 * 0.0083333333f))));
                        av[tt][jj] = __expf(la); uv[tt][jj] = __builtin_amdgcn_sqrtf(fmaxf(em, 0.f)) * ii * xv[jj]; }
                }
#pragma unroll
                for (int jj = 0; jj < 4; ++jj) {
                    const float a0 = av[dir ? 3 : 0][jj], a1 = av[dir ? 2 : 1][jj], a2 = av[dir ? 1 : 2][jj], a3 = av[dir ? 0 : 3][jj];
                    const float u0 = uv[dir ? 3 : 0][jj], u1 = uv[dir ? 2 : 1][jj], u2 = uv[dir ? 1 : 2][jj], u3 = uv[dir ? 0 : 3][jj];
                    float A = a0 * a1 * a2 * a3, U = ((u0 * a1 + u1) * a2 + u2) * a3 + u3;
#pragma unroll
                    for (int d = 1; d < 16; d <<= 1) {
                        const float Ap = dir ? __shfl_down(A, d, 16) : __shfl_up(A, d, 16), Up = dir ? __shfl_down(U, d, 16) : __shfl_up(U, d, 16);
                        const bool ok = dir ? (l15 + d < 16) : (l15 >= d);
                        if (ok) { U = A * Up + U; A = A * Ap; } }
                    if (FINAL) {
                        float Ae = dir ? __shfl_down(A, 1, 16) : __shfl_up(A, 1, 16), Ue = dir ? __shfl_down(U, 1, 16) : __shfl_up(U, 1, 16);
                        const bool edge = dir ? (l15 == 15) : (l15 == 0);
                        if (edge) { Ae = 1.f; Ue = 0.f; }
                        const float hin = Ae * cin[dir][jj] + Ue;
                        const float h0 = a0 * hin + u0, h1 = a1 * h0 + u1, h2 = a2 * h1 + u2, h3 = a3 * h2 + u3;
                        hsum[dir ? 3 : 0][jj] += h0; hsum[dir ? 2 : 1][jj] += h1; hsum[dir ? 1 : 2][jj] += h2; hsum[dir ? 0 : 3][jj] += h3;
                    } else {
                        const int el = dir ? 0 : 15;
                        if (l15 == el) SUM[((size_t)((b * 64 + tile) * 2 + dir)) * 1024 + ch0 + jj] = make_float2(A, U);
                    }
                }
            }
            if (FINAL) {
                u32x2 gr[4];
#pragma unroll
                for (int tt = 0; tt < 4; ++tt) gr[tt] = *(const u32x2*)(Z + (tok0 + 64 * tile + 4 * l15 + tt) * ZC_ + 4096 + ch0);
#pragma unroll
                for (int tt = 0; tt < 4; ++tt) { const int t = 64 * tile + 4 * l15 + tt;
                    u32x2 w; w.x = pk2(hsum[tt][0] * gelu_tanh(bflo(gr[tt].x)), hsum[tt][1] * gelu_tanh(bfhi(gr[tt].x))); w.y = pk2(hsum[tt][2] * gelu_tanh(bflo(gr[tt].y)), hsum[tt][3] * gelu_tanh(bfhi(gr[tt].y)));
                    *(u32x2*)(Y + (tok0 + t) * D_ + 1024 + ch0) = w; }
            }
        }
        __syncthreads();
#undef RG_ISSUE
    }
}

__device__ __forceinline__ void rglru_carry_phase() { PP p = get_params();
    const int tid = l_tid(), lane = tid & 63, wid = tid >> 6;
    const float2* SUM = (const float2*)(p->ws + OFF_RGSUM);
    float* CAR = (float*)(p->ws + OFF_RGCAR);
    if (wid == 0) {
        for (int chain = l_bid() * 64 + lane; chain < 16384; chain += l_nblk() * 64) {
            const int ch = chain & 1023, dir = (chain >> 10) & 1, b = chain >> 11;
            float h = 0.f;
#pragma unroll 8
            for (int k = 0; k < 64; ++k) { const int tile = dir ? (63 - k) : k; const size_t idx = ((size_t)((b * 64 + tile) * 2 + dir)) * 1024 + ch;
                const float2 s = SUM[idx]; CAR[idx] = h; h = s.x * h + s.y; }
        }
    }
}

struct AttnItem { int g, head, b, dil, sp, r, nb; };
__device__ __forceinline__ AttnItem attn_decode(int it0, int nblk) {
    int item = it0;
    if (nblk == 256) { const int k = it0 >> 8, w = it0 & 255, xcd = w & 7, slot = w >> 3; item = (((k / 3) * 8 + xcd) * 3 + (k % 3)) * 32 + slot; }
    AttnItem a; const int blk32 = item & 31, bh = item / 96; a.g = (item >> 5) % 3; a.head = bh & 15; a.b = bh >> 4;
    const int lg = 2 * a.g; a.dil = 1 << lg; a.sp = S_ >> lg; a.r = blk32 & (a.dil - 1); a.nb = blk32 >> lg;
    return a;
}
__device__ __forceinline__ void attn_phase(LAS unsigned char* L) { PP p = get_params();
    const int tid = l_tid(), lane = tid & 63, wid = __builtin_amdgcn_readfirstlane(tid >> 6), l15 = lane & 15, quad = lane >> 4;
    const u16* QKV = (const u16*)(p->ws + OFF_BIG);
    float* LSE = (float*)(p->ws + OFF_LSE);
    constexpr int KS = 0, VS = 65536;
    constexpr float SCALE = 0.08838834764831845f;
    const int pc = tid & 15, rb = tid >> 4;
    const int nblk = l_nblk();
    bf16x8 qf[4];
#define ATT_DMA(A_, which, BASE, ISV) do { _Pragma("unroll") for (int it = 0; it < 8; ++it) { const int lam = rb + 32 * it, x_ = lam & 15; \
        const int lr = (ISV) ? ((lam & ~15) + 8 * ((x_ >> 2) & 1) + 4 * (x_ >> 3) + (x_ & 3)) : lam; \
        const int cx = (ISV) ? (((lam & 3) << 2) | ((lam >> 2) & 3)) : x_; \
        const int i = 128 * (A_).nb - 64 + lr; const int ic = i < 0 ? 0 : (i >= (A_).sp ? (A_).sp - 1 : i);     \
        const unsigned bo_ = ((unsigned)(((which) * 128 + (A_).b * 16 + (A_).head) * S_ + (A_).r + ic * (A_).dil) * 128u + (unsigned)(8 * (pc ^ cx))) * 2u; \
        __builtin_amdgcn_global_load_lds((const unsigned*)((const char*)QKV + bo_), (LAS unsigned*)(L + (BASE) + (4 * wid + 32 * it) * 256), 16, 0, 0); } } while (0)
#define ATT_LOADQ(A_) do { const unsigned qb_ = ((unsigned)(((A_).b * 16 + (A_).head) * S_ + (A_).r + (128 * (A_).nb + 16 * wid + l15) * (A_).dil) * 128u + (unsigned)(8 * quad)) * 2u; \
        _Pragma("unroll") for (int ks = 0; ks < 4; ++ks) qf[ks] = *(const bf16x8*)((const char*)QKV + qb_ + 64 * ks); } while (0)
    int it0 = l_bid();
    AttnItem cur = attn_decode(it0 < 12288 ? it0 : 0, nblk);
    __syncthreads();
    if (it0 < 12288) { ATT_DMA(cur, 1, KS, 0); ATT_LOADQ(cur); }
    u32x2 pend[8]; u16* pend_ptr = nullptr; float pend_lse = 0.f; float* pend_lse_ptr = nullptr; bool have_pend = false;
    for (; it0 < 12288; it0 += nblk) {
        asm volatile("s_waitcnt vmcnt(0)" ::: "memory");
        __syncthreads();
        ATT_DMA(cur, 2, VS, 1);
        if (have_pend) {
#pragma unroll
            for (int dt = 0; dt < 8; ++dt) *(u32x2*)(pend_ptr + 16 * dt) = pend[dt];
            if (quad == 0) *pend_lse_ptr = pend_lse;
        }
        const int qi = 128 * cur.nb + 16 * wid + l15;
        const size_t qrow = (size_t)cur.b * S_ + cur.r + (size_t)qi * cur.dil;
        f32x4 sacc[9];
#pragma unroll
        for (int kt = 0; kt < 9; ++kt) { sacc[kt] = (f32x4){0.f, 0.f, 0.f, 0.f};
#pragma unroll
            for (int ks = 0; ks < 4; ++ks) { const bf16x8 kf = lds_r8(L + KS + (16 * wid + 16 * kt + l15) * 256 + (((4 * ks + quad) ^ l15) << 4)); sacc[kt] = MFMA16(kf, qf[ks], sacc[kt]); }
            if (kt % 3 == 2) __builtin_amdgcn_sched_barrier(0); }
        const float pen2 = exp2f(-0.5f * (float)(cur.head + 1)) * (float)cur.dil * 1.4426950408889634f, sc2 = SCALE * 1.4426950408889634f;
        float mx = -1e30f;
        int rel0 = 4 * quad - l15; asm volatile("" : "+v"(rel0));
        const float relf = (float)rel0;
        const bool seq_edge = (cur.nb == 0) || (cur.nb == (cur.sp >> 7) - 1);
        if (seq_edge) {
#pragma unroll
            for (int kt = 0; kt < 9; ++kt)
#pragma unroll
                for (int jj = 0; jj < 4; ++jj) { const int rel = 16 * kt + jj - 64 + rel0, ki = qi + rel; const int arel = rel < 0 ? -rel : rel;
                    const bool valid = (arel <= 64) && (ki >= 0) && (ki < cur.sp);
                    const float sc = valid ? (sacc[kt][jj] * sc2 - pen2 * (float)arel) : -1e30f; sacc[kt][jj] = sc; mx = fmaxf(mx, sc); }
        } else {
#pragma unroll
            for (int kt = 0; kt < 9; ++kt)
#pragma unroll
                for (int jj = 0; jj < 4; ++jj) { const float rr = relf + (float)(16 * kt + jj - 64);
                    float sc = __builtin_fmaf(sacc[kt][jj], sc2, -(pen2 * fabsf(rr)));
                    if (kt == 0) sc = (rel0 + jj >= 0) ? sc : -1e30f;
                    if (kt == 8) sc = (rel0 + jj <= 0) ? sc : -1e30f;
                    sacc[kt][jj] = sc; mx = fmaxf(mx, sc); }
        }
        mx = fmaxf(mx, __shfl_xor(mx, 16)); mx = fmaxf(mx, __shfl_xor(mx, 32));
        float lsum = 0.f;
#pragma unroll
        for (int kt = 0; kt < 9; ++kt)
#pragma unroll
            for (int jj = 0; jj < 4; ++jj) { const float pv = __builtin_amdgcn_exp2f(sacc[kt][jj] - mx); sacc[kt][jj] = pv; lsum += pv; }
        lsum += __shfl_xor(lsum, 16); lsum += __shfl_xor(lsum, 32);
        bf16x8 pf[5];
#pragma unroll
        for (int i = 0; i < 5; ++i) { u32x4 t; t.x = pk2(sacc[2 * i][0], sacc[2 * i][1]); t.y = pk2(sacc[2 * i][2], sacc[2 * i][3]);
            if (i < 4) { t.z = pk2(sacc[2 * i + 1][0], sacc[2 * i + 1][1]); t.w = pk2(sacc[2 * i + 1][2], sacc[2 * i + 1][3]); } else { t.z = 0u; t.w = 0u; }
            pf[i] = as_bf16x8(t); }
        asm volatile("s_waitcnt vmcnt(0)" ::: "memory");
        __syncthreads();
        const AttnItem cur0 = cur;
        if (it0 + nblk < 12288) { cur = attn_decode(it0 + nblk, nblk); ATT_DMA(cur, 1, KS, 0); ATT_LOADQ(cur); }
        f32x4 oacc[8];
        const int vrow = 16 * wid + 8 * (quad & 1) + 4 * (quad >> 1) + (l15 >> 2), vx = ((l15 >> 2) << 2) | ((2 * (quad & 1) + (quad >> 1)) & 3);
#pragma unroll
        for (int dt = 0; dt < 8; ++dt) { oacc[dt] = (f32x4){0.f, 0.f, 0.f, 0.f};
#pragma unroll
            for (int i = 0; i < 5; ++i) {
                const int vch = ((2 * dt + ((l15 & 3) >> 1)) ^ vx) * 16 + 8 * (l15 & 1);
                const bf16x4 lo = lds_tr(L + VS + 256 * (vrow + 32 * i) + vch);
                bf16x4 hi = (bf16x4){0, 0, 0, 0};
                if (i < 4) hi = lds_tr(L + VS + 256 * (vrow + 32 * i + 16) + vch);
                oacc[dt] = MFMA16(cat8(lo, hi), pf[i], oacc[dt]); }
            if (dt & 1) __builtin_amdgcn_sched_barrier(0); }
        const float inv = 1.0f / lsum;
        u16* OB = (cur0.g < 2) ? ((u16*)(p->out) + (size_t)cur0.g * T_ * D_) : (u16*)(p->ws + OFF_XN);
        pend_ptr = OB + qrow * D_ + cur0.head * 128 + 4 * quad;
#pragma unroll
        for (int dt = 0; dt < 8; ++dt) { pend[dt].x = pk2(oacc[dt][0] * inv, oacc[dt][1] * inv); pend[dt].y = pk2(oacc[dt][2] * inv, oacc[dt][3] * inv); }
        pend_lse = (mx + __log2f(lsum)) * 0.6931471805599453f; pend_lse_ptr = LSE + ((size_t)cur0.g * T_ + qrow) * 16 + cur0.head; have_pend = true;
    }
    if (have_pend) {
#pragma unroll
        for (int dt = 0; dt < 8; ++dt) *(u32x2*)(pend_ptr + 16 * dt) = pend[dt];
        if (quad == 0) *pend_lse_ptr = pend_lse;
    }
    __syncthreads();
#undef ATT_DMA
#undef ATT_LOADQ
}

__device__ __forceinline__ void attn_merge_phase() { PP p = get_params();
    const u16* O0 = (const u16*)(p->out); const u16* O1 = O0 + (size_t)T_ * D_; u16* O2 = (u16*)(p->ws + OFF_XN);
    const float* LSE = (const float*)(p->ws + OFF_LSE);
    for (size_t gi = (size_t)l_bid() * 512 + l_tid(); gi < (size_t)T_ * 256; gi += (size_t)l_nblk() * 512) {
        const size_t t = gi >> 8; const int c8 = (int)(gi & 255), head = c8 >> 4;
        const float l0 = LSE[t * 16 + head], l1 = LSE[((size_t)T_ + t) * 16 + head], l2 = LSE[((size_t)2 * T_ + t) * 16 + head];
        const float mx = fmaxf(l0, fmaxf(l1, l2));
        float w0 = __expf(l0 - mx), w1 = __expf(l1 - mx), w2 = __expf(l2 - mx); const float inv = 1.0f / (w0 + w1 + w2); w0 *= inv; w1 *= inv; w2 *= inv;
        const u32x4 a = *(const u32x4*)(O0 + t * D_ + 8 * c8), bq = *(const u32x4*)(O1 + t * D_ + 8 * c8), c = *(const u32x4*)(O2 + t * D_ + 8 * c8);
        u32x4 o;
        o.x = pk2(w0 * bflo(a.x) + w1 * bflo(bq.x) + w2 * bflo(c.x), w0 * bfhi(a.x) + w1 * bfhi(bq.x) + w2 * bfhi(c.x));
        o.y = pk2(w0 * bflo(a.y) + w1 * bflo(bq.y) + w2 * bflo(c.y), w0 * bfhi(a.y) + w1 * bfhi(bq.y) + w2 * bfhi(c.y));
        o.z = pk2(w0 * bflo(a.z) + w1 * bflo(bq.z) + w2 * bflo(c.z), w0 * bfhi(a.z) + w1 * bfhi(bq.z) + w2 * bfhi(c.z));
        o.w = pk2(w0 * bflo(a.w) + w1 * bflo(bq.w) + w2 * bflo(c.w), w0 * bfhi(a.w) + w1 * bfhi(bq.w) + w2 * bfhi(c.w));
        *(u32x4*)(O2 + t * D_ + 8 * c8) = o;
    }
}

#define XB_TMO      128
#define XB_XCNT(j)  (256  + 64 * (j))
#define XB_XSUB(j)  (1280 + 64 * (j))
#define XB_XGEN(j)  (2304 + 64 * (j))
#define XB_TOP      3328
#define XB_TOPGEN   3392
#define XCD_BAR_WORDS 3456
#define XB_SPIN_CAP (1u << 18)
__device__ __forceinline__ unsigned xb_ld(unsigned* p)              { return __hip_atomic_load(p, __ATOMIC_RELAXED, __HIP_MEMORY_SCOPE_AGENT); }
__device__ __forceinline__ unsigned xb_add(unsigned* p, unsigned v) { return __hip_atomic_fetch_add(p, v, __ATOMIC_RELAXED, __HIP_MEMORY_SCOPE_AGENT); }
__device__ __forceinline__ unsigned xb_xcc_id() { return (unsigned)__builtin_amdgcn_s_getreg((3 << 11) | 20) & 0xFu; }
#define XB_SPIN(cond, bar) do { unsigned _sp = 0; while (cond) { __builtin_amdgcn_s_sleep(1); \
    if ((++_sp & 255u) == 0u) { if (xb_ld(&(bar)[XB_TMO])) break; if (_sp > XB_SPIN_CAP) { atomicAdd(&(bar)[XB_TMO], 1u); break; } } } } while (0)

struct XcdBarrier {
    unsigned* bar; unsigned x;
    volatile LAS unsigned* st;
};

__device__ __forceinline__ XcdBarrier xcd_barrier_post(unsigned* bar, volatile LAS unsigned* st) {
    XcdBarrier b; b.bar = bar; b.x = xb_xcc_id(); b.st = st;
    if (threadIdx.x == 0) (void)xb_add(&bar[XB_XCNT(b.x)], 1u);
    return b;
}
__device__ __forceinline__ void xcd_barrier_complete(unsigned* bar, unsigned x, unsigned& nloc, unsigned& nx) {
    const unsigned G = gridDim.x * gridDim.y * gridDim.z;
    unsigned sum, cnt, mine, sp = 0u;
    for (;;) {
        sum = 0u; cnt = 0u; mine = 0u;
#pragma unroll
        for (unsigned j = 0; j < 16; ++j) { const unsigned c = xb_ld(&bar[XB_XCNT(j)]); sum += c; cnt += (c > 0u) ? 1u : 0u; mine = (j == x) ? c : mine; }
        if (sum == G) break;
        __builtin_amdgcn_s_sleep(1);
        if ((++sp & 255u) == 0u) { if (xb_ld(&bar[XB_TMO])) break; if (sp > XB_SPIN_CAP) { atomicAdd(&bar[XB_TMO], 1u); break; } }
    }
    nloc = mine > 0u ? mine : 1u; nx = cnt > 0u ? cnt : 1u;
}

__device__ __forceinline__ void xcd_barrier(const XcdBarrier& b) {
    asm volatile("s_waitcnt vmcnt(0)" ::: "memory");
    __syncthreads();
    if (threadIdx.x == 0) {
        unsigned* bar = b.bar;
        __builtin_amdgcn_s_waitcnt(0);
        unsigned nloc = b.st[0], nx = b.st[1];
        if (nloc == 0u) { xcd_barrier_complete(bar, b.x, nloc, nx); b.st[0] = nloc; b.st[1] = nx; }
        const unsigned old = xb_add(&bar[XB_XSUB(b.x)], 1u);
        const unsigned gen = old / nloc;
        if (old + 1u == (gen + 1u) * nloc) {
            __builtin_amdgcn_fence(__ATOMIC_RELEASE, "agent");
            asm volatile("s_waitcnt vmcnt(0)" ::: "memory");
            const unsigned og = xb_add(&bar[XB_TOP], 1u);
            const unsigned tg = og / nx;
            if (og + 1u == (tg + 1u) * nx) xb_add(&bar[XB_TOPGEN], 1u);
            else XB_SPIN(xb_ld(&bar[XB_TOPGEN]) == tg, bar);
            __builtin_amdgcn_fence(__ATOMIC_ACQUIRE, "agent");
            xb_add(&bar[XB_XGEN(b.x)], 1u);
            asm volatile("s_waitcnt vmcnt(0)" ::: "memory");
        } else {
            XB_SPIN(xb_ld(&bar[XB_XGEN(b.x)]) == gen, bar);
            __builtin_amdgcn_fence(__ATOMIC_ACQUIRE, "agent");
            asm volatile("s_waitcnt vmcnt(0)" ::: "memory");
        }
    }
    __syncthreads();
}


template <class Epi>
__device__ __forceinline__ void run_gemm(LAS unsigned char* L, const u16* A, const u16* Bt, int N, int K, const Epi& E) {
    pg8::Gemm g; g.A = A; g.Bt = Bt; g.M = T_; g.N = N; g.K = K;
    pg8::StaticOrder S; S.init(T_, N, l_nblk(), l_bid());
    pg8::gemm_phase<Epi, pg8::StaticOrder, false>(L, g, S, E, nullptr);
}
__device__ __forceinline__ void gemm_zin(LAS unsigned char* L) { PP p = get_params(); unsigned char* ws = p->ws;
    run_gemm(L, (const u16*)(ws + OFF_XN), (const u16*)(ws + OFF_WIN), ZC_, D_, pg8::EpiStoreBf16{(u16*)(ws + OFF_BIG), ZC_, nullptr, 0}); }
__device__ __forceinline__ void gemm_qkv(LAS unsigned char* L) { PP p = get_params(); unsigned char* ws = p->ws;
    run_gemm(L, (const u16*)(ws + OFF_MIX), (const u16*)(ws + OFF_WQKV), QC_, D_, pg8::EpiStoreBf16{(u16*)(ws + OFF_BIG), QC_, (const float*)(ws + OFF_SS) + T_, 1}); }
__device__ __forceinline__ void gemm_res0(LAS unsigned char* L) { PP p = get_params(); unsigned char* ws = p->ws;
    run_gemm(L, (const u16*)(ws + OFF_XN), (const u16*)(ws + OFF_WOUT), D_, D_,
             pg8::EpiRes<false, false, true>{(const void*)p->x, nullptr, (u16*)(ws + OFF_MIX), (float*)(ws + OFF_SS), D_}); }
__device__ __forceinline__ void gemm_res1(LAS unsigned char* L) { PP p = get_params(); unsigned char* ws = p->ws;
    run_gemm(L, (const u16*)(ws + OFF_XN), (const u16*)(ws + OFF_WO), D_, D_,
             pg8::EpiRes<true, false, true>{(const void*)(ws + OFF_MIX), nullptr, (u16*)(ws + OFF_MIX), (float*)(ws + OFF_SS) + 2 * T_, D_}); }
__device__ __forceinline__ void gemm_up(LAS unsigned char* L, int l) { PP p = get_params(); unsigned char* ws = p->ws;
    run_gemm(L, (const u16*)(ws + OFF_MIX), (const u16*)(ws + OFF_W13) + (size_t)l * 2 * DFF_ * D_, 2 * DFF_, D_, pg8::EpiSwiGLU{(u16*)(ws + OFF_BIG), DFF_, (const float*)(ws + OFF_SS) + (l ? 2 * T_ : 0)}); }
__device__ __forceinline__ void gemm_down0(LAS unsigned char* L) { PP p = get_params(); unsigned char* ws = p->ws;
    run_gemm(L, (const u16*)(ws + OFF_BIG), (const u16*)(ws + OFF_W2), D_, DFF_,
             pg8::EpiRes<true, false, true>{(const void*)(ws + OFF_MIX), nullptr, (u16*)(ws + OFF_MIX), (float*)(ws + OFF_SS) + T_, D_}); }
__device__ __forceinline__ void gemm_down1(LAS unsigned char* L) { PP p = get_params(); unsigned char* ws = p->ws;
    run_gemm(L, (const u16*)(ws + OFF_BIG), (const u16*)(ws + OFF_W2) + (size_t)D_ * DFF_, D_, DFF_,
             pg8::EpiRes<true, false, true>{(const void*)(ws + OFF_MIX), nullptr, (u16*)(ws + OFF_MIX), (float*)(ws + OFF_SS) + 3 * T_, D_}); }
__device__ __forceinline__ void norm_final() { PP p = get_params();
    const u16* XBp = (const u16*)(p->ws + OFF_MIX); const float* ss = (const float*)(p->ws + OFF_SS) + 3 * T_; float* out = p->out; const float* g = p->final_norm;
    for (size_t gi = (size_t)l_bid() * 512 + l_tid(); gi < (size_t)T_ * 256; gi += (size_t)l_nblk() * 512) {
        const size_t t = gi >> 8; const int c8 = (int)(gi & 255);
        const float rs = rsqrtf(ss[t] * (1.0f / D_) + 1e-6f);
        const u32x4 w = *(const u32x4*)(XBp + t * D_ + 8 * c8);
        const f32x4 g0 = *(const f32x4*)(g + 8 * c8), g1 = *(const f32x4*)(g + 8 * c8 + 4);
        f32x4 o0, o1;
        o0.x = bflo(w.x) * rs * g0.x; o0.y = bfhi(w.x) * rs * g0.y; o0.z = bflo(w.y) * rs * g0.z; o0.w = bfhi(w.y) * rs * g0.w;
        o1.x = bflo(w.z) * rs * g1.x; o1.y = bfhi(w.z) * rs * g1.y; o1.z = bflo(w.w) * rs * g1.z; o1.w = bfhi(w.w) * rs * g1.w;
        *(f32x4*)(out + t * D_ + 8 * c8) = o0; *(f32x4*)(out + t * D_ + 8 * c8 + 4) = o1;
    }
}

__global__ __launch_bounds__(512, 2) void mega_fwd(Params pdummy) {
    LAS unsigned char* L = (LAS unsigned char*)lds_raw;
    cg::grid_group grid = cg::this_grid();
    volatile LAS unsigned* xst = (volatile LAS unsigned*)(L + LDS_MAIN);
    if (threadIdx.x < 4) xst[threadIdx.x] = (threadIdx.x == 2) ? blockIdx.x : 0u;
    __syncthreads();
    unsigned* barw = (unsigned*)(get_params()->ws + OFF_BAR);
    XcdBarrier xb = xcd_barrier_post(barw, xst);
    if (threadIdx.x == 0) xst[3] = xb_add(&barw[3520 + 64 * xb.x], 1u);
    phase0(L);
    grid.sync();
    if (threadIdx.x == 0) {
        bool ok = (gridDim.x == 256) && (xb.x < 8u);
        for (int j = 0; j < 8; ++j) ok = ok && (xb_ld(&barw[3520 + 64 * j]) == 32u);
        if (ok) xst[2] = xst[3] * 8u + xb.x;
    }
    __syncthreads();
    gemm_zin(L);
    xcd_barrier(xb);
    mlstm_phase(L);
    asm volatile("s_waitcnt vmcnt(0)" ::: "memory");
    rglru_phase<false>(L);
    xcd_barrier(xb);
    rglru_carry_phase();
    asm volatile("s_waitcnt vmcnt(0)" ::: "memory");
    mlstm_combine_phase();
    xcd_barrier(xb);
    rglru_phase<true>(L);
    xcd_barrier(xb);
    gemm_res0(L);
    xcd_barrier(xb);
    gemm_up(L, 0);
    xcd_barrier(xb);
    gemm_down0(L);
    xcd_barrier(xb);
    gemm_qkv(L);
    xcd_barrier(xb);
    attn_phase(L);
    xcd_barrier(xb);
    attn_merge_phase();
    xcd_barrier(xb);
    gemm_res1(L);
    xcd_barrier(xb);
    gemm_up(L, 1);
    xcd_barrier(xb);
    gemm_down1(L);
    xcd_barrier(xb);
    norm_final();
}

extern "C" void kernel_launch(void* const* d_in, const int* in_sizes, int n_in, void* d_out, int out_size, void* d_ws, size_t ws_size, hipStream_t stream) {
    static int grid_blocks = 0;
    if (!grid_blocks) {
        int dev = 0, cus = 0, per_cu = 0;
        hipGetDevice(&dev);
        hipDeviceGetAttribute(&cus, hipDeviceAttributeMultiprocessorCount, dev);
        hipFuncSetAttribute((const void*)mega_fwd, hipFuncAttributeMaxDynamicSharedMemorySize, LDS_BYTES);
        hipOccupancyMaxActiveBlocksPerMultiprocessor(&per_cu, (const void*)mega_fwd, 512, LDS_BYTES);
        if (per_cu < 1) per_cu = 1;
        grid_blocks = cus * per_cu;
        if (ws_size < WS_END) fprintf(stderr, "workspace too small: %zu < %zu\n", ws_size, (size_t)WS_END);
    }
    Params p; memset(&p, 0, sizeof(p));
    const float** ptrs = (const float**)&p;
    for (int i = 0; i < 21; ++i) ptrs[i] = (const float*)d_in[i];
    p.out = (float*)d_out; p.ws = (unsigned char*)d_ws;
    unsigned char* ws = (unsigned char*)d_ws;
    int ns = 0, tot = 0;
    auto add = [&](const float* src, size_t dst_off, int ld, int K, int N, int mode, int rowoff, const float* gain) {
        Seg& s = p.seg[ns++]; s.src = src; s.dst = (u16*)(ws + dst_off); s.gain = gain; s.ld = ld; s.K = K; s.nN32 = N / 32; s.mode = mode; s.rowoff = rowoff; s.ntiles = (K / 64) * (N / 32); tot += s.ntiles; };
    add(p.e_w_in, OFF_WIN, DIN_, D_, 3072, 0, 0, nullptr);
    add(p.e_w_in + 3088, OFF_WIN, DIN_, D_, 2048, 0, 3072, nullptr);
    add(p.e_w_out, OFF_WOUT, D_, D_, D_, 0, 0, nullptr);
    add(p.o_w_qkv, OFF_WQKV, QC_, D_, QC_, 0, 0, p.o_norm);
    add(p.o_w_o, OFF_WO, D_, D_, D_, 0, 0, nullptr);
    for (int l = 0; l < 2; ++l) {
        add(p.f_w1 + (size_t)l * D_ * DFF_, OFF_W13 + l * SZ_W13, DFF_, D_, DFF_, 1, 0, p.f_norm + l * D_);
        add(p.f_w3 + (size_t)l * D_ * DFF_, OFF_W13 + l * SZ_W13, DFF_, D_, DFF_, 1, 128, p.f_norm + l * D_);
        add(p.f_w2 + (size_t)l * DFF_ * D_, OFF_W2 + l * SZ_W2, D_, DFF_, D_, 0, 0, nullptr);
    }
    p.nseg = ns; p.total_tiles = tot;
    hipMemsetAsync((unsigned char*)d_ws + OFF_BAR, 0, 16384, stream);
    void* args[] = {&p};
    hipError_t e = hipLaunchCooperativeKernel((const void*)mega_fwd, dim3(grid_blocks), dim3(512), args, LDS_BYTES, stream);
    if (e != hipSuccess) fprintf(stderr, "cooperative launch failed: %s (grid %d)\n", hipGetErrorString(e), grid_blocks);
}
```
